# Optimizing an MI355X kernel written in HIP

```python
import numpy as np
import jax
import jax.numpy as jnp
from jax import lax

D_MODEL = 1024
BATCH = 32
SEQ = 2048
DEPTH = 2

HEAD_DIM = 64
GRID_W = 64
ROPE_THETA = 10000.0
EPS = 1e-6
NEG_INF = -1e30

A_HEADS = 8
NA_WIN_ROWS = 8
NA_WIN_COLS = 16
NA_Q_COLS = 16
NA_KEY_COLS = NA_Q_COLS + NA_WIN_COLS

B_HEADS = 8
B_KV_HEADS = 2
B_WINDOW = 128
B_BLOCK = 128

C_HEADS = 16
C_KV_HEADS = 4
C_BLOCK = 128

N_EXPERTS = 16
EC_CAPACITY_FACTOR = 2
D_FF = 2048

N_EVEN = (DEPTH + 1) // 2
N_ODD = DEPTH // 2

A_W = A_HEADS * HEAD_DIM
B_QW = B_HEADS * HEAD_DIM
B_KVW = B_KV_HEADS * HEAD_DIM
EVEN_IN = 3 * A_W + B_QW + 2 * B_KVW
EVEN_OUT = A_W + B_QW
C_QW = C_HEADS * HEAD_DIM
C_KVW = C_KV_HEADS * HEAD_DIM
ODD_IN = C_QW + 2 * C_KVW
ODD_OUT = C_QW

kernel_name = "hybrid_na_swa_axial_ec_moe_encoder"


def rms_norm(x, gain):
    xf = x.astype(jnp.float32)
    y = xf * lax.rsqrt(jnp.mean(xf * xf, axis=-1, keepdims=True) + EPS)
    return (y * gain.astype(jnp.float32)).astype(x.dtype)


def rope(x, pos):
    d = x.shape[-1]
    inv_freq = jnp.power(jnp.float32(ROPE_THETA), -jnp.arange(0, d, 2, dtype=jnp.float32) / d)
    ang = pos.astype(jnp.float32)[:, None] * inv_freq[None, :]
    cos = jnp.cos(ang)[None, :, None, :]
    sin = jnp.sin(ang)[None, :, None, :]
    x1, x2 = jnp.split(x.astype(jnp.float32), 2, axis=-1)
    return jnp.concatenate([x1 * cos - x2 * sin, x1 * sin + x2 * cos], axis=-1).astype(x.dtype)


def axial_rope(x, t):
    half = x.shape[-1] // 2
    return jnp.concatenate([rope(x[..., :half], t // GRID_W), rope(x[..., half:], t % GRID_W)], axis=-1)


def _na_column_tables():
    n_chunks = GRID_W // NA_Q_COLS
    j = np.arange(n_chunks)
    kc0 = np.clip(j * NA_Q_COLS - NA_WIN_COLS // 2, 0, GRID_W - NA_KEY_COLS)
    key_cols = kc0[:, None] + np.arange(NA_KEY_COLS)[None, :]
    q_cols = j[:, None] * NA_Q_COLS + np.arange(NA_Q_COLS)[None, :]
    start = np.clip(q_cols - NA_WIN_COLS // 2, 0, GRID_W - NA_WIN_COLS)
    rel = key_cols[:, None, :] - start[:, :, None]
    in_win = (rel >= 0) & (rel < NA_WIN_COLS)
    assert np.all(in_win.sum(-1) == NA_WIN_COLS)
    dc = key_cols[:, None, :] - q_cols[:, :, None]
    dc_idx = np.clip(dc, -(NA_WIN_COLS - 1), NA_WIN_COLS - 1) + NA_WIN_COLS - 1
    return key_cols, in_win, dc_idx


def neighbourhood_attention(q, k, v, rel_bias):
    b, s, h, d = q.shape
    rows = s // GRID_W
    wr = min(NA_WIN_ROWS, rows)
    key_cols, in_win, dc_idx = _na_column_tables()
    nc = key_cols.shape[0]
    qg = q.reshape(b, rows, GRID_W, h, d)
    kg = k.reshape(b, rows, GRID_W, h, d)
    vg = v.reshape(b, rows, GRID_W, h, d)
    col_bias = rel_bias[:, :, dc_idx]
    mask = jnp.asarray(in_win)[:, :, None, :]
    scale = HEAD_DIM ** -0.5

    def one_row(r):
        rs = jnp.clip(r - wr // 2, 0, rows - wr)
        k_rows = lax.dynamic_slice_in_dim(kg, rs, wr, axis=1)
        v_rows = lax.dynamic_slice_in_dim(vg, rs, wr, axis=1)
        kb = k_rows[:, :, key_cols]
        vb = v_rows[:, :, key_cols]
        qb = lax.dynamic_index_in_dim(qg, r, axis=1, keepdims=False).reshape(b, nc, NA_Q_COLS, h, d)
        sc = jnp.einsum('bjqhd,brjkhd->bhjqrk', qb, kb, preferred_element_type=jnp.float32) * scale
        dr_idx = rs + jnp.arange(wr) - r + NA_WIN_ROWS - 1
        bias = jnp.take(col_bias, dr_idx, axis=1).transpose(0, 2, 3, 1, 4)
        sc = jnp.where(mask, sc + bias[None].astype(jnp.float32), NEG_INF)
        p = jax.nn.softmax(sc, axis=(-2, -1))
        o = jnp.einsum('bhjqrk,brjkhd->bjqhd', p.astype(v.dtype), vb)
        return o.reshape(b, GRID_W, h * d)

    out = lax.map(one_row, jnp.arange(rows))
    return jnp.transpose(out, (1, 0, 2, 3)).reshape(b, s, h * d)


def windowed_sink_attention(q, k, v, sink):
    b, s, hq, d = q.shape
    hkv = k.shape[2]
    g = hq // hkv
    nb = s // B_BLOCK
    pad = ((0, 0), (B_BLOCK, B_BLOCK), (0, 0), (0, 0))
    kp = jnp.pad(k, pad)
    vp = jnp.pad(v, pad)
    sink_hg = sink.astype(jnp.float32).reshape(hkv, g)[None, :, :, None, None]
    scale = HEAD_DIM ** -0.5

    def one_block(i):
        q_blk = lax.dynamic_slice_in_dim(q, i * B_BLOCK, B_BLOCK, axis=1).reshape(b, B_BLOCK, hkv, g, d)
        k_blk = lax.dynamic_slice_in_dim(kp, i * B_BLOCK, 3 * B_BLOCK, axis=1)
        v_blk = lax.dynamic_slice_in_dim(vp, i * B_BLOCK, 3 * B_BLOCK, axis=1)
        sc = jnp.einsum('bqhgd,bkhd->bhgqk', q_blk, k_blk, preferred_element_type=jnp.float32) * scale
        qpos = i * B_BLOCK + jnp.arange(B_BLOCK)
        kpos = (i - 1) * B_BLOCK + jnp.arange(3 * B_BLOCK)
        valid = (kpos[None, :] >= 0) & (kpos[None, :] < s) & (jnp.abs(qpos[:, None] - kpos[None, :]) <= B_WINDOW)
        sc = jnp.where(valid, sc, NEG_INF)
        m = jnp.maximum(jnp.max(sc, axis=-1, keepdims=True), sink_hg)
        e = jnp.exp(sc - m)
        p = e / (jnp.sum(e, axis=-1, keepdims=True) + jnp.exp(sink_hg - m))
        o = jnp.einsum('bhgqk,bkhd->bqhgd', p.astype(v.dtype), v_blk)
        return o.reshape(b, B_BLOCK, hq * d)

    out = lax.map(one_block, jnp.arange(nb))
    return jnp.transpose(out, (1, 0, 2, 3)).reshape(b, s, hq * d)


def dense_block_attention(q, k, v):
    b, s, hq, d = q.shape
    hkv = k.shape[2]
    g = hq // hkv
    nb = s // C_BLOCK
    scale = HEAD_DIM ** -0.5

    def one_block(i):
        q_blk = lax.dynamic_slice_in_dim(q, i * C_BLOCK, C_BLOCK, axis=1).reshape(b, C_BLOCK, hkv, g, d)
        sc = jnp.einsum('bqhgd,bkhd->bhgqk', q_blk, k, preferred_element_type=jnp.float32) * scale
        p = jax.nn.softmax(sc, axis=-1)
        o = jnp.einsum('bhgqk,bkhd->bqhgd', p.astype(v.dtype), v)
        return o.reshape(b, C_BLOCK, hq * d)

    out = lax.map(one_block, jnp.arange(nb))
    return jnp.transpose(out, (1, 0, 2, 3)).reshape(b, s, hq * d)


def expert_choice_moe(x, w_router, w_gate, w_up, w_down):
    b, s, dm = x.shape
    cap = EC_CAPACITY_FACTOR * s // N_EXPERTS
    logits = jnp.einsum('bsd,de->bse', x, w_router, preferred_element_type=jnp.float32)
    affinity = jax.nn.softmax(logits, axis=-1)
    gate, idx = lax.top_k(jnp.swapaxes(affinity, 1, 2), cap)

    def run_expert(args):
        wg, wu, wd, ids, gt = args
        xe = jax.vmap(lambda xb, ib: xb[ib])(x, ids)
        hdn = jax.nn.silu(xe @ wg) * (xe @ wu)
        return (hdn @ wd) * gt[..., None].astype(x.dtype)

    ye = lax.map(run_expert, (w_gate, w_up, w_down, jnp.swapaxes(idx, 0, 1), jnp.swapaxes(gate, 0, 1)))
    ye = jnp.swapaxes(ye, 0, 1).reshape(b, N_EXPERTS * cap, dm)
    flat_idx = idx.reshape(b, N_EXPERTS * cap)
    return jax.vmap(lambda ib, yb: jnp.zeros((s, dm), yb.dtype).at[ib].add(yb))(flat_idx, ye)


def setup_inputs(seed: int = 0) -> dict:
    key = jax.random.key(seed)
    ks = jax.random.split(key, 20)
    nrm = jax.random.normal
    f32 = jnp.float32
    return {
        "x": nrm(ks[0], (BATCH, SEQ, D_MODEL), f32),
        "attn_norm_even": 1.0 + 0.02 * nrm(ks[1], (N_EVEN, D_MODEL), f32),
        "w_in_even": nrm(ks[2], (N_EVEN, D_MODEL, EVEN_IN), f32) * D_MODEL ** -0.5,
        "q_norm_a": 1.0 + 0.02 * nrm(ks[3], (N_EVEN, HEAD_DIM), f32),
        "k_norm_a": 1.0 + 0.02 * nrm(ks[4], (N_EVEN, HEAD_DIM), f32),
        "rel_bias_a": 0.1 * nrm(ks[5], (N_EVEN, A_HEADS, 2 * NA_WIN_ROWS - 1, 2 * NA_WIN_COLS - 1), f32),
        "q_norm_b": 1.0 + 0.02 * nrm(ks[6], (N_EVEN, HEAD_DIM), f32),
        "k_norm_b": 1.0 + 0.02 * nrm(ks[7], (N_EVEN, HEAD_DIM), f32),
        "sink_b": 0.5 * nrm(ks[8], (N_EVEN, B_HEADS), f32),
        "w_out_even": nrm(ks[9], (N_EVEN, EVEN_OUT, D_MODEL), f32) * EVEN_OUT ** -0.5,
        "attn_norm_odd": 1.0 + 0.02 * nrm(ks[10], (N_ODD, D_MODEL), f32),
        "w_in_odd": nrm(ks[11], (N_ODD, D_MODEL, ODD_IN), f32) * D_MODEL ** -0.5,
        "q_norm_c": 1.0 + 0.02 * nrm(ks[12], (N_ODD, HEAD_DIM), f32),
        "k_norm_c": 1.0 + 0.02 * nrm(ks[13], (N_ODD, HEAD_DIM), f32),
        "w_out_odd": nrm(ks[14], (N_ODD, ODD_OUT, D_MODEL), f32) * ODD_OUT ** -0.5,
        "ffn_norm": 1.0 + 0.02 * nrm(ks[15], (DEPTH, D_MODEL), f32),
        "w_router": nrm(ks[16], (DEPTH, D_MODEL, N_EXPERTS), f32) * D_MODEL ** -0.5,
        "w_gate": nrm(ks[17], (DEPTH, N_EXPERTS, D_MODEL, D_FF), f32) * D_MODEL ** -0.5,
        "w_up": nrm(ks[18], (DEPTH, N_EXPERTS, D_MODEL, D_FF), f32) * D_MODEL ** -0.5,
        "w_down": nrm(ks[19], (DEPTH, N_EXPERTS, D_FF, D_MODEL), f32) * D_FF ** -0.5,
    }


def reference(x, attn_norm_even, w_in_even, q_norm_a, k_norm_a, rel_bias_a, q_norm_b, k_norm_b, sink_b,
              w_out_even, attn_norm_odd, w_in_odd, q_norm_c, k_norm_c, w_out_odd,
              ffn_norm, w_router, w_gate, w_up, w_down):
    b, s, _ = x.shape
    t = jnp.arange(s)
    even_splits = [A_W, 2 * A_W, 3 * A_W, 3 * A_W + B_QW, 3 * A_W + B_QW + B_KVW]
    odd_splits = [C_QW, C_QW + C_KVW]
    for layer in range(DEPTH):
        i = layer // 2
        if layer % 2 == 0:
            h = rms_norm(x, attn_norm_even[i])
            proj = h @ w_in_even[i]
            qa, ka, va, qb, kb, vb = jnp.split(proj, even_splits, axis=-1)
            qa = rms_norm(qa.reshape(b, s, A_HEADS, HEAD_DIM), q_norm_a[i])
            ka = rms_norm(ka.reshape(b, s, A_HEADS, HEAD_DIM), k_norm_a[i])
            va = va.reshape(b, s, A_HEADS, HEAD_DIM)
            out_a = neighbourhood_attention(qa, ka, va, rel_bias_a[i])
            qb = rope(rms_norm(qb.reshape(b, s, B_HEADS, HEAD_DIM), q_norm_b[i]), t)
            kb = rope(rms_norm(kb.reshape(b, s, B_KV_HEADS, HEAD_DIM), k_norm_b[i]), t)
            vb = vb.reshape(b, s, B_KV_HEADS, HEAD_DIM)
            out_b = windowed_sink_attention(qb, kb, vb, sink_b[i])
            x = x + jnp.concatenate([out_a, out_b], axis=-1) @ w_out_even[i]
        else:
            h = rms_norm(x, attn_norm_odd[i])
            proj = h @ w_in_odd[i]
            qc, kc, vc = jnp.split(proj, odd_splits, axis=-1)
            qc = axial_rope(rms_norm(qc.reshape(b, s, C_HEADS, HEAD_DIM), q_norm_c[i]), t)
            kc = axial_rope(rms_norm(kc.reshape(b, s, C_KV_HEADS, HEAD_DIM), k_norm_c[i]), t)
            vc = vc.reshape(b, s, C_KV_HEADS, HEAD_DIM)
            x = x + dense_block_attention(qc, kc, vc) @ w_out_odd[i]
        x = x + expert_choice_moe(rms_norm(x, ffn_norm[layer]), w_router[layer], w_gate[layer],
                                  w_up[layer], w_down[layer])
    return x
```

```cpp
#include <hip/hip_runtime.h>
#include <hip/hip_bf16.h>
#include <cstdio>
#include <cstdint>
#include <cmath>
#ifndef PROBE
#define PROBE 0
#endif
namespace pg8 {
#define PG8_LAS __attribute__((address_space(3)))
typedef unsigned short bf16_t;
typedef short bf16x8 __attribute__((ext_vector_type(8)));
typedef float f32x4 __attribute__((ext_vector_type(4)));
typedef unsigned u32x4 __attribute__((ext_vector_type(4)));
typedef int i32x4 __attribute__((ext_vector_type(4)));
typedef int i32x8 __attribute__((ext_vector_type(8)));
typedef unsigned u32x2 __attribute__((ext_vector_type(2)));
constexpr int BM = 256, BK = 64, HALF = 128, HTB = HALF * BK * 2  , STAGE_BYTES = 8 * HTB, NXCD = 8, WGM = 8;

__host__ __device__ __forceinline__ int lds_byte(int r, int c) { const int st = (r >> 4) * 2 + (c >> 5), rr = r & 15, cc = c & 31, ob = rr * 64 + cc * 2; return st * 1024 + (ob ^ (((ob >> 9) & 1) << 5)); }
__host__ __device__ __forceinline__ void stage_rc(int b, int& R, int& C) { const int st = b / 1024, sb = b % 1024, swz = sb ^ (((sb >> 9) & 1) << 5); R = (st >> 1) * 16 + swz / 64; C = (st & 1) * 32 + (swz % 64) / 2; }
__host__ __device__ __forceinline__ int perm32(int rho) { const int n = rho >> 4, i = rho & 15; return 8 * (i >> 2) + 4 * n + (i & 3); }

struct Unit { int pm, pn, bt, am; };
struct Gemm { const bf16_t* A; const bf16_t* Bt; int K; const int* gidx; int scx = 0x7f7f7f7f; };

struct StaticOrder {
    int nM, nN, nwg, G, c, ediv, amul, aoff, rev;
    __device__ void init(int M, int N, int G_, int c_, int ediv_ = (1 << 30), int amul_ = 0, int aoff_ = 0, int rev_ = 0) { nM = M / BM; nN = N / BM; nwg = nM * nN; G = G_; c = c_; ediv = ediv_; amul = amul_; aoff = aoff_; rev = rev_; }
    __device__ bool next(int i, Unit& u) const {
        const long L = (long)i * G + c; if (L >= nwg) return false;
        int wgid = (int)L; { const int q = nwg / NXCD, r = nwg % NXCD, xcd = wgid % NXCD, off = wgid / NXCD; wgid = (xcd < r ? xcd * (q + 1) : r * (q + 1) + (xcd - r) * q) + off; }
        const int nig = WGM * nN, gid = wgid / nig, fm = gid * WGM, gsz = (nM - fm) < WGM ? (nM - fm) : WGM;
        u.pm = fm + ((wgid % nig) % gsz); u.pn = (wgid % nig) / gsz; if (rev) u.pm = nM - 1 - u.pm;
        const int e = u.pm / ediv, bl = u.pm - e * ediv; u.bt = e * nN + u.pn; u.am = e * amul + aoff + bl;
        return true;
    }
};

__device__ __forceinline__ unsigned cvt_pk_bf16(float lo, float hi) { unsigned r; asm volatile("v_cvt_pk_bf16_f32 %0, %1, %2" : "=v"(r) : "v"(lo), "v"(hi)); return r; }

__device__ __forceinline__ unsigned pk4_fp8(float a, float b, float c, float d) { int w = 0; w = __builtin_amdgcn_cvt_pk_fp8_f32(a, b, w, false); w = __builtin_amdgcn_cvt_pk_fp8_f32(c, d, w, true); return (unsigned)w; }
struct EpiBf16 {
    static constexpr bool PERM = true;
    bf16_t* O; int ldc;
    __device__ __forceinline__ void operator()(const f32x4 (&acc)[2][2][4][2], const Unit& u, int wr, int wc, int fr, int fq) const {
        const int row0 = u.pm * BM + wr * 64 + fr, col0 = u.pn * BM + wc * 32 + 8 * fq;
#pragma unroll
        for (int ai = 0; ai < 2; ++ai)
#pragma unroll
            for (int m = 0; m < 4; ++m) { bf16_t* rowp = O + (size_t)(row0 + ai * HALF + m * 16) * ldc + col0;
#pragma unroll
                for (int bj = 0; bj < 2; ++bj) { const f32x4 v0 = acc[ai][bj][m][0], v1 = acc[ai][bj][m][1];
                    u32x4 w; w.x = cvt_pk_bf16(v0[0], v0[1]); w.y = cvt_pk_bf16(v0[2], v0[3]); w.z = cvt_pk_bf16(v1[0], v1[1]); w.w = cvt_pk_bf16(v1[2], v1[3]);
                    *(u32x4*)(rowp + bj * HALF) = w; } }
    }
};
template <int LAYER> struct EpiQKV {
    static constexpr bool PERM = true;
    bf16_t* O; int ldc; const float* tab; const float* g0; const float* g1; const float* g2; const float* g3; float qscale;
    template <int KIND, bool F8OUT> __device__ __forceinline__ void body(const f32x4 (&acc)[2][2][4][2], const Unit& u, int wr, int wc, int fr, int fq, const float* gp, const float sc, const int f8col = 0) const {
        const int d0 = LAYER == 0 ? 8 * fq : 32 * (fq >> 1) + 8 * (fq & 1), dstep = LAYER == 0 ? 32 : 16;
        const int row0 = u.pm * BM + wr * 64 + fr, col0 = u.pn * BM + wc * 64 + d0;
        f32x4 gv[2][2];
        if (KIND != 0) {
#pragma unroll
            for (int bj = 0; bj < 2; ++bj)
#pragma unroll
                for (int n = 0; n < 2; ++n) gv[bj][n] = *(const f32x4*)(gp + d0 + dstep * bj + 4 * n) * sc;
        }
        u32x4 tq[4][2][2]; u32x4 w[8][2];
#define QKV_LOADT(ch) do { if (KIND == 2) { _Pragma("unroll") for (int r_ = 0; r_ < 2; ++r_) { const int mm_ = (ch) * 2 + r_; const int s_ = (row0 + (mm_ >> 2) * HALF + (mm_ & 3) * 16) & 2047; const unsigned* tcp; \
            if (LAYER == 0) { tcp = (const unsigned*)tab + s_ * 32 + 8 * fq; } else { const int pos_ = (fq >> 1) ? (s_ & 63) : (s_ >> 6); tcp = (const unsigned*)tab + 65536 + pos_ * 16 + 8 * (fq & 1); } \
            _Pragma("unroll") for (int n = 0; n < 2; ++n) tq[ch][r_][n] = *(const u32x4*)(tcp + 4 * n); } } } while (0)
#define QKV_STORE(mm) do { if constexpr (F8OUT) { unsigned char* rowp_ = (unsigned char*)O + (size_t)(row0 + ((mm) >> 2) * HALF + ((mm) & 3) * 16) * (ldc * 2) + f8col + wc * 64 + d0; \
            *(u32x2*)(rowp_) = (u32x2){w[mm][0].x, w[mm][0].y}; *(u32x2*)(rowp_ + dstep) = (u32x2){w[mm][1].x, w[mm][1].y}; } \
        else { bf16_t* rowp_ = O + (size_t)(row0 + ((mm) >> 2) * HALF + ((mm) & 3) * 16) * ldc + col0; *(u32x4*)(rowp_) = w[mm][0]; *(u32x4*)(rowp_ + dstep) = w[mm][1]; } } while (0)
        QKV_LOADT(0); QKV_LOADT(1);
#pragma unroll
        for (int ch = 0; ch < 4; ++ch) {
#pragma unroll
            for (int r_ = 0; r_ < 2; ++r_) { const int mm = ch * 2 + r_, ai = mm >> 2, m = mm & 3;
                f32x4 x[2][2];
#pragma unroll
                for (int bj = 0; bj < 2; ++bj)
#pragma unroll
                    for (int n = 0; n < 2; ++n) x[bj][n] = acc[ai][bj][m][n];
                if (KIND == 0 && F8OUT) {
#pragma unroll
                    for (int bj = 0; bj < 2; ++bj)
#pragma unroll
                        for (int n = 0; n < 2; ++n) x[bj][n] = x[bj][n] * sc;
                }
                if (KIND != 0) {
                    float ss = 0.f;
#pragma unroll
                    for (int bj = 0; bj < 2; ++bj)
#pragma unroll
                        for (int n = 0; n < 2; ++n) ss += (x[bj][n][0] * x[bj][n][0] + x[bj][n][1] * x[bj][n][1]) + (x[bj][n][2] * x[bj][n][2] + x[bj][n][3] * x[bj][n][3]);
                    { auto p16 = __builtin_amdgcn_permlane16_swap(__float_as_uint(ss), __float_as_uint(ss), false, false); ss = __uint_as_float(p16[0]) + __uint_as_float(p16[1]); }
                    { auto p32 = __builtin_amdgcn_permlane32_swap(__float_as_uint(ss), __float_as_uint(ss), false, false); ss = __uint_as_float(p32[0]) + __uint_as_float(p32[1]); }
                    const float rr = __builtin_amdgcn_rsqf(ss * (1.f / 64.f) + 1e-6f);
#pragma unroll
                    for (int bj = 0; bj < 2; ++bj)
#pragma unroll
                        for (int n = 0; n < 2; ++n) x[bj][n] = x[bj][n] * rr * gv[bj][n];
                    if (KIND == 2) {
#pragma unroll
                        for (int n = 0; n < 2; ++n) { const unsigned q0 = tq[ch][r_][n].x, q1 = tq[ch][r_][n].y, q2 = tq[ch][r_][n].z, q3 = tq[ch][r_][n].w;
                            const f32x4 c = (f32x4){__uint_as_float(q0 << 16), __uint_as_float(q1 << 16), __uint_as_float(q2 << 16), __uint_as_float(q3 << 16)};
                            const f32x4 sn = (f32x4){__uint_as_float(q0 & 0xffff0000u), __uint_as_float(q1 & 0xffff0000u), __uint_as_float(q2 & 0xffff0000u), __uint_as_float(q3 & 0xffff0000u)};
                            const f32x4 x1 = x[0][n], x2 = x[1][n];
                            x[0][n] = x1 * c - x2 * sn; x[1][n] = x1 * sn + x2 * c; }
                    }
                }
#pragma unroll
                for (int bj = 0; bj < 2; ++bj) { const f32x4 v0 = x[bj][0], v1 = x[bj][1];
                    if constexpr (F8OUT) { w[mm][bj].x = pk4_fp8(v0[0], v0[1], v0[2], v0[3]); w[mm][bj].y = pk4_fp8(v1[0], v1[1], v1[2], v1[3]); w[mm][bj].z = 0u; w[mm][bj].w = 0u; }
                    else { w[mm][bj].x = cvt_pk_bf16(v0[0], v0[1]); w[mm][bj].y = cvt_pk_bf16(v0[2], v0[3]); w[mm][bj].z = cvt_pk_bf16(v1[0], v1[1]); w[mm][bj].w = cvt_pk_bf16(v1[2], v1[3]); } }
            }
            if (ch == 0) { QKV_LOADT(2); QKV_LOADT(3); }
            QKV_STORE(2 * ch); QKV_STORE(2 * ch + 1);
        }
#undef QKV_LOADT
#undef QKV_STORE
    }
    __device__ __forceinline__ void operator()(const f32x4 (&acc)[2][2][4][2], const Unit& u, int wr, int wc, int fr, int fq) const {
        int kind; const float* gp; float sc = 1.f; int f8col = 0;
        if (LAYER == 0) { const int pn = u.pn;
            if (pn < 2) { kind = 1; gp = g0; sc = qscale; } else if (pn < 4) { kind = 1; gp = g1; } else if (pn < 6) { kind = 0; gp = g0; }
            else if (pn < 8) { kind = 2; gp = g2; sc = qscale * 16.f; f8col = 3072 + (pn - 6) * 256; } else if (wc < 2) { kind = 2; gp = g3; f8col = 4096; } else { kind = 0; gp = g0; sc = 8.f; f8col = 4224; } }
        if (LAYER != 0) { const int pn = u.pn; const bool isq = pn < 4, isk = pn == 4;
            kind = (isq || isk) ? 2 : 0; gp = isk ? g1 : g0; sc = isq ? qscale * 16.f : (isk ? 1.f : 8.f); f8col = isq ? pn * 256 : (isk ? 2048 : 2560); }
        if (kind == 2) body<2, true>(acc, u, wr, wc, fr, fq, gp, sc, f8col);
        else if (LAYER == 0 && kind == 1) body<1, false>(acc, u, wr, wc, fr, fq, gp, sc);
        else if (f8col != 0) body<0, true>(acc, u, wr, wc, fr, fq, gp, sc, f8col);
        else body<0, false>(acc, u, wr, wc, fr, fq, gp, sc);
    }
};
struct EpiGU {
    static constexpr bool PERM = true;
    bf16_t* Hd; int ldh;
    __device__ __forceinline__ void operator()(const f32x4 (&acc)[2][2][4][2], const Unit& u, int wr, int wc, int fr, int fq) const {
        const int row0 = u.pm * BM + wr * 64 + fr, col0 = u.pn * HALF + wc * 32 + 8 * fq;
#pragma unroll
        for (int ai = 0; ai < 2; ++ai)
#pragma unroll
            for (int m = 0; m < 4; ++m) { bf16_t* rowp = Hd + (size_t)(row0 + ai * HALF + m * 16) * ldh + col0; float h[8];
#pragma unroll
                for (int n = 0; n < 2; ++n)
#pragma unroll
                    for (int j = 0; j < 4; ++j) { const float gv = acc[ai][0][m][n][j], uv = acc[ai][1][m][n][j];
                        const float sg = gv * __builtin_amdgcn_rcpf(1.0f + __builtin_amdgcn_exp2f(-1.4426950408889634f * gv)); h[n * 4 + j] = sg * uv; }
                u32x4 w; w.x = cvt_pk_bf16(h[0], h[1]); w.y = cvt_pk_bf16(h[2], h[3]); w.z = cvt_pk_bf16(h[4], h[5]); w.w = cvt_pk_bf16(h[6], h[7]);
                *(u32x4*)rowp = w; }
    }
};
struct EpiGU8 {
    static constexpr bool PERM = true;
    unsigned char* Hd; int ldh;
    __device__ __forceinline__ void operator()(const f32x4 (&acc)[2][2][4][2], const Unit& u, int wr, int wc, int fr, int fq) const {
        const int row0 = u.pm * BM + wr * 64 + fr, col0 = u.pn * HALF + wc * 32 + 8 * fq;
#pragma unroll
        for (int ai = 0; ai < 2; ++ai)
#pragma unroll
            for (int m = 0; m < 4; ++m) { unsigned char* rowp = Hd + (size_t)(row0 + ai * HALF + m * 16) * ldh + col0; float h[8];
#pragma unroll
                for (int n = 0; n < 2; ++n)
#pragma unroll
                    for (int j = 0; j < 4; ++j) { const float gv = acc[ai][0][m][n][j], uv = acc[ai][1][m][n][j];
                        h[n * 4 + j] = (gv * uv) * __builtin_amdgcn_rcpf(1.0f + __builtin_amdgcn_exp2f(gv)); }
                u32x2 w; w.x = pk4_fp8(h[0], h[1], h[2], h[3]); w.y = pk4_fp8(h[4], h[5], h[6], h[7]);
                *(u32x2*)rowp = w; }
    }
};
struct EpiY {
    static constexpr bool PERM = true;
    unsigned char* Y; int ldc; const float* gate;
    __device__ __forceinline__ void operator()(const f32x4 (&acc)[2][2][4][2], const Unit& u, int wr, int wc, int fr, int fq) const {
        const int row0 = u.am * BM + wr * 64 + fr, col0 = u.pn * BM + wc * 32 + 8 * fq;
        float gs[2][4];
#pragma unroll
        for (int ai = 0; ai < 2; ++ai)
#pragma unroll
            for (int m = 0; m < 4; ++m) gs[ai][m] = gate[row0 + ai * HALF + m * 16];
#pragma unroll
        for (int ai = 0; ai < 2; ++ai)
#pragma unroll
            for (int m = 0; m < 4; ++m) { const int row = row0 + ai * HALF + m * 16; const float g16 = gs[ai][m] * 16.0f; unsigned char* rowp = Y + (size_t)row * ldc + col0;
#pragma unroll
                for (int bj = 0; bj < 2; ++bj) { const f32x4 v0 = acc[ai][bj][m][0] * g16, v1 = acc[ai][bj][m][1] * g16;
                    u32x2 w; w.x = pk4_fp8(v0[0], v0[1], v0[2], v0[3]); w.y = pk4_fp8(v1[0], v1[1], v1[2], v1[3]);
                    *(u32x2*)(rowp + bj * HALF) = w; } }
    }
};
template <bool RES_BF16> struct EpiRes {
    static constexpr bool PERM = true;
    const void* res; bf16_t* out; int ldc;
    __device__ __forceinline__ void operator()(const f32x4 (&acc)[2][2][4][2], const Unit& u, int wr, int wc, int fr, int fq) const {
        const int row0 = u.pm * BM + wr * 64 + fr, col0 = u.pn * BM + wc * 32 + 8 * fq;
        if constexpr (RES_BF16) {
            u32x4 w[2][4][2];
#pragma unroll
            for (int ai = 0; ai < 2; ++ai)
#pragma unroll
                for (int m = 0; m < 4; ++m) { const size_t off = (size_t)(row0 + ai * HALF + m * 16) * ldc + col0;
#pragma unroll
                    for (int bj = 0; bj < 2; ++bj) w[ai][m][bj] = *(const u32x4*)((const bf16_t*)res + off + bj * HALF); }
#pragma unroll
            for (int ai = 0; ai < 2; ++ai)
#pragma unroll
                for (int m = 0; m < 4; ++m) { const size_t off = (size_t)(row0 + ai * HALF + m * 16) * ldc + col0;
#pragma unroll
                    for (int bj = 0; bj < 2; ++bj) { const unsigned wx = w[ai][m][bj].x, wy = w[ai][m][bj].y, wz = w[ai][m][bj].z, ww = w[ai][m][bj].w;
                        const f32x4 r0 = (f32x4){__uint_as_float(wx << 16), __uint_as_float(wx & 0xffff0000u), __uint_as_float(wy << 16), __uint_as_float(wy & 0xffff0000u)};
                        const f32x4 r1 = (f32x4){__uint_as_float(wz << 16), __uint_as_float(wz & 0xffff0000u), __uint_as_float(ww << 16), __uint_as_float(ww & 0xffff0000u)};
                        const f32x4 v0 = r0 + acc[ai][bj][m][0], v1 = r1 + acc[ai][bj][m][1];
                        u32x4 o; o.x = cvt_pk_bf16(v0[0], v0[1]); o.y = cvt_pk_bf16(v0[2], v0[3]); o.z = cvt_pk_bf16(v1[0], v1[1]); o.w = cvt_pk_bf16(v1[2], v1[3]);
                        *(u32x4*)(out + off + bj * HALF) = o; } }
        } else {
            f32x4 r[2][4][2][2]; u32x4 o[4][2];
#pragma unroll
            for (int m = 0; m < 4; ++m) { const size_t off = (size_t)(row0 + m * 16) * ldc + col0;
#pragma unroll
                for (int bj = 0; bj < 2; ++bj) { r[0][m][bj][0] = *(const f32x4*)((const float*)res + off + bj * HALF); r[0][m][bj][1] = *(const f32x4*)((const float*)res + off + bj * HALF + 4); } }
#pragma unroll
            for (int m = 0; m < 4; ++m)
#pragma unroll
                for (int bj = 0; bj < 2; ++bj) { const f32x4 v0 = r[0][m][bj][0] + acc[0][bj][m][0], v1 = r[0][m][bj][1] + acc[0][bj][m][1];
                    o[m][bj].x = cvt_pk_bf16(v0[0], v0[1]); o[m][bj].y = cvt_pk_bf16(v0[2], v0[3]); o[m][bj].z = cvt_pk_bf16(v1[0], v1[1]); o[m][bj].w = cvt_pk_bf16(v1[2], v1[3]); }
#pragma unroll
            for (int m = 0; m < 4; ++m) { const size_t off = (size_t)(row0 + HALF + m * 16) * ldc + col0;
#pragma unroll
                for (int bj = 0; bj < 2; ++bj) { r[1][m][bj][0] = *(const f32x4*)((const float*)res + off + bj * HALF); r[1][m][bj][1] = *(const f32x4*)((const float*)res + off + bj * HALF + 4); } }
#pragma unroll
            for (int m = 0; m < 4; ++m) { const size_t off = (size_t)(row0 + m * 16) * ldc + col0;
#pragma unroll
                for (int bj = 0; bj < 2; ++bj) *(u32x4*)(out + off + bj * HALF) = o[m][bj]; }
#pragma unroll
            for (int m = 0; m < 4; ++m) { const size_t off = (size_t)(row0 + HALF + m * 16) * ldc + col0;
#pragma unroll
                for (int bj = 0; bj < 2; ++bj) { const f32x4 v0 = r[1][m][bj][0] + acc[1][bj][m][0], v1 = r[1][m][bj][1] + acc[1][bj][m][1];
                    u32x4 q; q.x = cvt_pk_bf16(v0[0], v0[1]); q.y = cvt_pk_bf16(v0[2], v0[3]); q.z = cvt_pk_bf16(v1[0], v1[1]); q.w = cvt_pk_bf16(v1[2], v1[3]);
                    *(u32x4*)(out + off + bj * HALF) = q; } }
        }
    }
};

template <class Epi, class Sched, bool ALIGN_EPI, bool GATHER, bool F8 = false>
__device__ __forceinline__ void gemm_phase(PG8_LAS unsigned char* lds, const Gemm g, const Sched& S, const Epi& E) {
    int tid = threadIdx.x; asm volatile("" : "+v"(tid));
    const int wid = __builtin_amdgcn_readfirstlane(tid >> 6), lane = tid & 63, wr = wid >> 2, wc = wid & 3, fr = lane & 15, fq = lane >> 4;
    const int K = g.K, nt = K / BK;
    unsigned voffA[2], voffB[2], gC[2]; int gR[2];
#pragma unroll
    for (int i = 0; i < 2; ++i) { int R, C; stage_rc(tid * 16 + i * 8192, R, C); const int Rb = Epi::PERM ? ((R & ~31) + perm32(R & 31)) : R;
        voffA[i] = (unsigned)(R * K + C) * 2u; voffB[i] = (unsigned)(Rb * K + C) * 2u; gR[i] = R; gC[i] = (unsigned)C * 2u; }
    const size_t kstep = (size_t)(BK * 2);
    const size_t hstep = (size_t)HALF * K * 2;
    const size_t tstep = 2 * hstep;
    const unsigned K2 = (unsigned)K * 2u;
    const unsigned ldsw = (unsigned)wid * 1024u;
    const unsigned ldsbase = (unsigned)__builtin_amdgcn_readfirstlane((int)((unsigned)(uintptr_t)lds + ldsw));
    const int aoff = lds_byte(wr * 64 + fr, fq * 8), boff = lds_byte(wc * 32 + fr, fq * 8);
#define PG8_SA(b, h) (((b) * 2 + (h)) * HTB)
#define PG8_SB(b, h) ((4 + (b) * 2 + (h)) * HTB)
#define PG8_STAGE(bufoff, gbase, voff) do { _Pragma("unroll") for (int _i = 0; _i < 2; ++_i) \
        asm volatile("s_mov_b32 m0, %2\n\ts_nop 0\n\tglobal_load_lds_dwordx4 %0, %1" :: "v"((voff)[_i]), "s"((const char*)(gbase)), "s"(ldsbase + (unsigned)((bufoff) + _i * 8192)) : "memory", "m0"); } while (0)
#define PG8_STAGE_A(bufoff, kptr, h, VG) do { if constexpr (GATHER) { PG8_STAGE(bufoff, kptr, (VG)[h]); } else { PG8_STAGE(bufoff, (kptr) + (h) * hstep, voffA); } } while (0)
#define PG8_LD8(p) __builtin_shufflevector(*(const PG8_LAS i32x4*)(p), *(const PG8_LAS i32x4*)((p) + 1024), 0, 1, 2, 3, 4, 5, 6, 7)
#define PG8_LDA(dst, b, h) do { if constexpr (F8) { _Pragma("unroll") for (int m = 0; m < 4; ++m) dst##8[m] = PG8_LD8(lds + PG8_SA(b, h) + aoff + m * 2048); } \
        else { _Pragma("unroll") for (int m = 0; m < 4; ++m) _Pragma("unroll") for (int k = 0; k < 2; ++k) dst[m][k] = *(const PG8_LAS bf16x8*)(lds + PG8_SA(b, h) + aoff + m * 2048 + k * 1024); } } while (0)
#define PG8_LDB(dst, b, h) do { if constexpr (F8) { _Pragma("unroll") for (int n = 0; n < 2; ++n) dst##8[n] = PG8_LD8(lds + PG8_SB(b, h) + boff + n * 2048); } \
        else { _Pragma("unroll") for (int n = 0; n < 2; ++n) _Pragma("unroll") for (int k = 0; k < 2; ++k) dst[n][k] = *(const PG8_LAS bf16x8*)(lds + PG8_SB(b, h) + boff + n * 2048 + k * 1024); } } while (0)
#define PG8_MMA(ai, bj, At, Bt, Z) do { __builtin_amdgcn_s_setprio(1); _Pragma("unroll") for (int m = 0; m < 4; ++m) _Pragma("unroll") for (int n = 0; n < 2; ++n) { \
        if constexpr (F8) { if (Z) asm volatile("v_mfma_scale_f32_16x16x128_f8f6f4 %0, %1, %2, 0, %3, %4 op_sel_hi:[0,0,0]" : "=&v"(acc[ai][bj][m][n]) : "v"(Bt##8[n]), "v"(At##8[m]), "v"(sc_w), "v"(sc_x));   \
            else asm volatile("v_mfma_scale_f32_16x16x128_f8f6f4 %0, %1, %2, %0, %3, %4 op_sel_hi:[0,0,0]" : "+v"(acc[ai][bj][m][n]) : "v"(Bt##8[n]), "v"(At##8[m]), "v"(sc_w), "v"(sc_x)); } \
        else { if (Z) acc[ai][bj][m][n] = (f32x4){0.f, 0.f, 0.f, 0.f}; _Pragma("unroll") for (int k = 0; k < 2; ++k) acc[ai][bj][m][n] = __builtin_amdgcn_mfma_f32_16x16x32_bf16(Bt[n][k], At[m][k], acc[ai][bj][m][n], 0, 0, 0); } } \
        __builtin_amdgcn_s_setprio(0); } while (0)
#define PG8_WAIT_V(n) asm volatile("s_waitcnt vmcnt(" #n ")" ::: "memory")
#define PG8_WAIT_L(n) asm volatile("s_waitcnt lgkmcnt(" #n ")" ::: "memory")
#define PG8_BAR __builtin_amdgcn_s_barrier()
#define PG8_SCHED __builtin_amdgcn_sched_barrier(0)
    Unit cur, nxt; int ui = 0;
    if (!S.next(0, cur)) return;
    f32x4 acc[2][2][4][2];
    bf16x8 At[4][2], B0[2][2], B1[2][2]; i32x8 At8[4], B08[2], B18[2];
    int sc_w = 0x79797979, sc_x = g.scx; if constexpr (F8) asm volatile("" : "+v"(sc_w), "+v"(sc_x));
    unsigned vGc[2][2] = {{0u, 0u}, {0u, 0u}}, vGn[2][2] = {{0u, 0u}, {0u, 0u}};
    if constexpr (GATHER) {
        Unit t1; const bool h1 = S.next(1, t1);
#pragma unroll
        for (int h = 0; h < 2; ++h)
#pragma unroll
            for (int i = 0; i < 2; ++i) { vGc[h][i] = (unsigned)g.gidx[cur.am * BM + h * HALF + gR[i]] * K2 + gC[i];
                vGn[h][i] = h1 ? (unsigned)g.gidx[t1.am * BM + h * HALF + gR[i]] * K2 + gC[i] : vGc[h][i]; }
    }
    const char* cA = GATHER ? (const char*)g.A : (const char*)g.A + (size_t)cur.pm * tstep; const char* cB = (const char*)g.Bt + (size_t)cur.bt * tstep;
    PG8_STAGE(PG8_SB(0, 0), cB, voffB); PG8_STAGE(PG8_SB(0, 1), cB + hstep, voffB); PG8_STAGE_A(PG8_SA(0, 0), cA, 0, vGc); PG8_STAGE_A(PG8_SA(0, 1), cA, 1, vGc);
    if (wr == 1) PG8_BAR;
    PG8_WAIT_V(2); PG8_BAR;
    PG8_STAGE(PG8_SB(1, 0), cB + kstep, voffB); PG8_STAGE_A(PG8_SA(1, 0), cA + kstep, 0, vGc); PG8_STAGE(PG8_SB(1, 1), cB + hstep + kstep, voffB);
    PG8_WAIT_V(6); PG8_BAR;
    for (;;) {
        const bool has_next = S.next(ui + 1, nxt);
        const char* nA = has_next ? (GATHER ? (const char*)g.A : (const char*)g.A + (size_t)nxt.pm * tstep) : cA; const char* nB = has_next ? (const char*)g.Bt + (size_t)nxt.bt * tstep : cB;
#define PG8_ITER(t, Z) do { \
            const bool last = ((t) == nt - 2); \
            const char* a1 = cA + (size_t)((t) + 1) * kstep;                                             \
            const char* a2 = last ? nA : cA + (size_t)((t) + 2) * kstep; const char* b2 = last ? nB : cB + (size_t)((t) + 2) * kstep;     \
            const char* a3 = a2 + kstep; const char* b3 = b2 + kstep;                                \
            unsigned vGs[2][2] = {{0u, 0u}, {0u, 0u}}; \
            if constexpr (GATHER) { const bool usen = last && has_next; \
                _Pragma("unroll") for (int h = 0; h < 2; ++h) _Pragma("unroll") for (int i = 0; i < 2; ++i) vGs[h][i] = usen ? vGn[h][i] : vGc[h][i]; } \
              \
            PG8_LDB(B0, 0, 0); PG8_LDB(B1, 0, 1); PG8_SCHED; PG8_LDA(At, 0, 0); PG8_STAGE_A(PG8_SA(1, 1), a1, 1, vGc); \
            PG8_WAIT_V(8); PG8_WAIT_L(0); PG8_BAR; PG8_MMA(0, 0, At, B0, Z); PG8_MMA(0, 1, At, B1, Z); PG8_BAR; PG8_SCHED; \
              \
            PG8_LDA(At, 0, 1); PG8_STAGE(PG8_SB(0, 0), b2, voffB); PG8_STAGE(PG8_SB(0, 1), b2 + hstep, voffB); PG8_STAGE_A(PG8_SA(0, 0), a2, 0, vGs); \
            PG8_WAIT_V(8); PG8_WAIT_L(0); PG8_BAR; PG8_MMA(1, 0, At, B0, Z); PG8_MMA(1, 1, At, B1, Z); PG8_BAR; PG8_SCHED; \
              \
            PG8_LDB(B0, 1, 0); PG8_LDB(B1, 1, 1); PG8_SCHED; PG8_LDA(At, 1, 0); PG8_STAGE_A(PG8_SA(0, 1), a2, 1, vGs); \
            PG8_WAIT_V(8); PG8_WAIT_L(0); PG8_BAR; PG8_MMA(0, 0, At, B0, false); PG8_MMA(0, 1, At, B1, false); PG8_BAR; PG8_SCHED; \
              \
            PG8_LDA(At, 1, 1); PG8_STAGE(PG8_SB(1, 0), b3, voffB); PG8_STAGE(PG8_SB(1, 1), b3 + hstep, voffB); PG8_STAGE_A(PG8_SA(1, 0), a3, 0, vGs); \
            PG8_WAIT_V(8); PG8_WAIT_L(0); PG8_BAR; PG8_MMA(1, 0, At, B0, false); PG8_MMA(1, 1, At, B1, false); PG8_BAR; PG8_SCHED; } while (0)
        PG8_ITER(0, true);
        for (int t = 2; t < nt; t += 2) PG8_ITER(t, false);
#undef PG8_ITER
        if constexpr (F8) asm volatile("s_nop 15\n\ts_nop 7" ::: "memory");
        if constexpr (ALIGN_EPI) { if (wr == 0) PG8_BAR; }
        int raw[2][2] = {{0, 0}, {0, 0}}; bool has_nn = false;
        if constexpr (GATHER) { Unit nn; has_nn = has_next && S.next(ui + 2, nn);
            if (has_nn) {
#pragma unroll
                for (int h = 0; h < 2; ++h)
#pragma unroll
                    for (int i = 0; i < 2; ++i) raw[h][i] = g.gidx[nn.am * BM + h * HALF + gR[i]]; } }
        E(acc, cur, wr, wc, fr, fq);
        if (!has_next) break;
        if constexpr (GATHER) {
#pragma unroll
            for (int h = 0; h < 2; ++h)
#pragma unroll
                for (int i = 0; i < 2; ++i) { vGc[h][i] = vGn[h][i]; if (has_nn) vGn[h][i] = (unsigned)raw[h][i] * K2 + gC[i]; asm volatile("" : "+v"(vGn[h][i])); } }
        cur = nxt; cA = nA; cB = nB; ++ui;
        if constexpr (ALIGN_EPI) { if (wr == 1) PG8_BAR; }
    }
    PG8_WAIT_V(0);
    if constexpr (!ALIGN_EPI) { if (wr == 0) PG8_BAR; }
    PG8_BAR;
#undef PG8_SA
#undef PG8_SB
#undef PG8_STAGE
#undef PG8_STAGE_A
#undef PG8_LDA
#undef PG8_LDB
#undef PG8_MMA
#undef PG8_WAIT_V
#undef PG8_WAIT_L
#undef PG8_BAR
#undef PG8_SCHED
}
}

namespace attn_body {
using bf16=__hip_bfloat16;
using bf16x8=__attribute__((ext_vector_type(8)))short;
using s16x4=__attribute__((ext_vector_type(4)))short;
using f32x16=__attribute__((ext_vector_type(16)))float;
using u32x4=__attribute__((ext_vector_type(4)))unsigned;
constexpr int D=64,OPITCH=1024;
constexpr int NW=8,QBLK=32,QB=QBLK*NW,KVBLK=64;
__device__ __forceinline__ int crow(int r,int hi){return (r&3)+8*(r>>2)+4*hi;}
#define SBAR() __builtin_amdgcn_sched_barrier(0)
typedef const __attribute__((address_space(3))) float* lds_fptr;
template<int MODE> __device__ __forceinline__ void amask(f32x16&p0,f32x16&p1,int tabs,int q0,int wid,int r32,int hi,lds_fptr btab){
  const float NEG=-INFINITY;
  if(MODE==1){
    const int qw=q0+wid*QBLK,k0=64*tabs;
    if((k0+63-qw<=128)&&(qw+31-k0<=128)) return;
    int base=k0+4*hi-(qw+r32)+128; asm volatile("":"+v"(base));
    #pragma unroll
    for(int r=0;r<16;++r){const int off=(r&3)+8*(r>>2); if((unsigned)(base+off)>256u)p0[r]=NEG; if((unsigned)(base+off+32)>256u)p1[r]=NEG;}
  } else if(MODE==0){
    const int qr=(q0>>6)+(wid>>1),kr=tabs; int rs=qr-4; rs=rs<0?0:(rs>24?24:rs);
    if(kr<rs||kr>=rs+8){
      #pragma unroll
      for(int r=0;r<16;++r){p0[r]=NEG;p1[r]=NEG;}
    } else {
      const int qc=32*(wid&1)+r32; int cs=qc-8; cs=cs<0?0:(cs>48?48:cs);
      int cb=4*hi-cs,tpo=(kr-qr+7)*31+15-qc+4*hi; asm volatile("":"+v"(cb),"+v"(tpo));
      lds_fptr tp=btab+tpo;
      #pragma unroll
      for(int r=0;r<16;++r){const int off=(r&3)+8*(r>>2); const float b0=tp[off],b1=tp[off+32];
        p0[r]=((unsigned)(off+cb)<16u)?p0[r]+b0:NEG; p1[r]=((unsigned)(off+32+cb)<16u)?p1[r]+b1:NEG;}
    }
  }
}
constexpr bool MFREE=true;
constexpr bool ATTN_PRIO_HALF=true;
constexpr bool QK_FP8=true;
using i32x2a=__attribute__((ext_vector_type(2)))int; using i32x4a=__attribute__((ext_vector_type(4)))int; using i32x8a=__attribute__((ext_vector_type(8)))int;
constexpr bool LSUM_MFMA=MFREE;
using f32x4a=__attribute__((ext_vector_type(4)))float;
constexpr bool O_FP8=true;
constexpr int NSLOT=3, SLOTB=8192;
constexpr int LDS_K=0, LDS_V=NSLOT*SLOTB, LDS_WS=2*NSLOT*SLOTB, LDS_OST=LDS_WS+NW*64*4, LDS_BYTES=LDS_OST+NW*4096;
constexpr float C2=0.125f*1.4426950408889634f;
__device__ __forceinline__ void glds16(const void*gsrc,unsigned lds_dst){unsigned keep;
  asm volatile("s_mov_b32 %0, m0\n\ts_mov_b32 m0, %2\n\ts_nop 0\n\tglobal_load_lds_dwordx4 %1, off\n\ts_mov_b32 m0, %0":"=&s"(keep):"v"(gsrc),"s"(lds_dst):"memory");}
__device__ __forceinline__ float max3f(float a,float b,float c){float r;asm("v_max3_f32 %0, %1, %2, %3":"=v"(r):"v"(a),"v"(b),"v"(c));return r;}
__device__ __forceinline__ float max2f(float a,float b){float r;asm("v_max_f32_e32 %0, %1, %2":"=v"(r):"v"(a),"v"(b));return r;}
__device__ __forceinline__ float fadd_s(float a,float b){float r;asm("v_add_f32_e32 %0, %1, %2":"=v"(r):"v"(a),"v"(b));return r;}
__device__ __forceinline__ float fsub_s(float a,float b){float r;asm("v_sub_f32_e32 %0, %1, %2":"=v"(r):"v"(a),"v"(b));return r;}
typedef float f32x2_t __attribute__((ext_vector_type(2))); typedef __bf16 bf16x2_t __attribute__((ext_vector_type(2)));
__device__ __forceinline__ unsigned cvtpk_s(float lo,float hi){f32x2_t v={lo,hi};bf16x2_t b=__builtin_convertvector(v,bf16x2_t);return __builtin_bit_cast(unsigned,b);}
#define WAIT_BAR(N) asm volatile("s_waitcnt vmcnt(" #N ") lgkmcnt(0)\n\ts_barrier":::"memory")

__device__ __forceinline__ void qkt(f32x16&p0,f32x16&p1,const char*Kslot,const bf16x8*qr,const f32x16&negm,int r32,int hi){
  const char*kb=Kslot+hi*1024+r32*16;
  #pragma unroll
  for(int d0=0;d0<4;++d0){
    const bf16x8 b0=*reinterpret_cast<const bf16x8*>(kb+d0*2048);
    const bf16x8 b1=*reinterpret_cast<const bf16x8*>(kb+d0*2048+512);
    if(d0==0){p0=__builtin_amdgcn_mfma_f32_32x32x16_bf16(b0,qr[0],negm,0,0,0);p1=__builtin_amdgcn_mfma_f32_32x32x16_bf16(b1,qr[0],negm,0,0,0);}
    else{p0=__builtin_amdgcn_mfma_f32_32x32x16_bf16(b0,qr[d0],p0,0,0,0);p1=__builtin_amdgcn_mfma_f32_32x32x16_bf16(b1,qr[d0],p1,0,0,0);}}
}
typedef __attribute__((address_space(3))) const char* lds_cptr;
typedef short v4i16_t __attribute__((ext_vector_type(4)));
__device__ __forceinline__ void kload8(bf16x8*kf,lds_cptr kp){
  kf[0]=*(const __attribute__((address_space(3))) bf16x8*)(kp);      kf[1]=*(const __attribute__((address_space(3))) bf16x8*)(kp+512);
  kf[2]=*(const __attribute__((address_space(3))) bf16x8*)(kp+2048); kf[3]=*(const __attribute__((address_space(3))) bf16x8*)(kp+2560);
  kf[4]=*(const __attribute__((address_space(3))) bf16x8*)(kp+4096); kf[5]=*(const __attribute__((address_space(3))) bf16x8*)(kp+4608);
  kf[6]=*(const __attribute__((address_space(3))) bf16x8*)(kp+6144); kf[7]=*(const __attribute__((address_space(3))) bf16x8*)(kp+6656);
}
__device__ __forceinline__ void kload2(bf16x8*kf,lds_cptr kp,int j){ kf[2*j]=*(const __attribute__((address_space(3))) bf16x8*)(kp+j*2048); kf[2*j+1]=*(const __attribute__((address_space(3))) bf16x8*)(kp+j*2048+512); }
__device__ __forceinline__ s16x4 vtr(lds_cptr p){ return __builtin_bit_cast(s16x4,__builtin_amdgcn_ds_read_tr16_b64_v4i16((__attribute__((address_space(3))) v4i16_t*)p)); }
__device__ __forceinline__ float rowmax(const f32x16&p0,const f32x16&p1){
  float a=max3f(p0[0],p0[1],p1[0]),b=max3f(p0[2],p0[3],p1[1]);a=max3f(a,p1[2],p1[3]);
  #pragma unroll
  for(int r=4;r<16;r+=4){a=max3f(a,p0[r],p0[r+1]);b=max3f(b,p0[r+2],p0[r+3]);a=max3f(a,p1[r],p1[r+1]);b=max3f(b,p1[r+2],p1[r+3]);}
  const float m=max2f(a,b);
  auto rr=__builtin_amdgcn_permlane32_swap(__float_as_uint(m),__float_as_uint(m),false,false);
  return max2f(__uint_as_float(rr[0]),__uint_as_float(rr[1]));
}
__device__ __forceinline__ void pv(f32x16*o,int vb,bf16x8 pa0,bf16x8 pa1,bf16x8 pa2,bf16x8 pa3){
  #pragma unroll
  for(int d0=0;d0<2;++d0){s16x4 lo[4],hi[4];
    #pragma unroll
    for(int ks=0;ks<4;++ks){
      asm volatile("ds_read_b64_tr_b16 %0,%1 offset:%c2":"=&v"(lo[ks]):"v"(vb),"i"(d0*4096+ks*1024):"memory");
      asm volatile("ds_read_b64_tr_b16 %0,%1 offset:%c2":"=&v"(hi[ks]):"v"(vb),"i"(d0*4096+ks*1024+512):"memory");}
    asm volatile("s_waitcnt lgkmcnt(0)":::"memory");SBAR();
    #define PK(k) (bf16x8){lo[k][0],lo[k][1],lo[k][2],lo[k][3],hi[k][0],hi[k][1],hi[k][2],hi[k][3]}
    o[d0]=__builtin_amdgcn_mfma_f32_32x32x16_bf16(pa0,PK(0),o[d0],0,0,0);
    o[d0]=__builtin_amdgcn_mfma_f32_32x32x16_bf16(pa1,PK(1),o[d0],0,0,0);
    o[d0]=__builtin_amdgcn_mfma_f32_32x32x16_bf16(pa2,PK(2),o[d0],0,0,0);
    o[d0]=__builtin_amdgcn_mfma_f32_32x32x16_bf16(pa3,PK(3),o[d0],0,0,0);
    #undef PK
  }
}

#ifndef ATTN_STORE16
#define ATTN_STORE16(p,v) (*(u32x4*)(p)=(v))
#endif
template<int MODE,int PITCH,int THRL> __device__ __forceinline__ void attn_unit(const bf16*Qb,const bf16*__restrict__ Kb,const bf16*__restrict__ Vb,bf16*Ob,const int q0,const int t0,const int NT,const float sinkl2,lds_fptr btab,char*shm,
    const bool warm=false,const bool pre=false,const bf16*Qn=nullptr,const bf16*Kn=nullptr,const int q0n=0,const int t0n=0,i32x8a*qnx=nullptr){
  int tid=threadIdx.x; asm volatile("":"+v"(tid)); const int lane=tid&63,r32=lane&31,hi=lane>>5; const int wid=__builtin_amdgcn_readfirstlane(tid>>6);
  constexpr bool QK8=(MODE==2||MODE==1)&&QK_FP8;
  const int wrow=(MODE==1)?(wid&3)*QBLK:wid*QBLK, whead=(MODE==1)?(wid>>2)*D:0;
  const bf16*Qw=Qb+(long)(q0+wrow)*PITCH+whead;
  const bf16*Kh=Kb+(long)t0*KVBLK*PITCH,*Vh=Vb+(long)t0*KVBLK*PITCH;
  const unsigned lds0=(unsigned)(uintptr_t)shm;
  float*wsf=(float*)(shm+LDS_WS)+wid*64;
  const bf16*ksrc=Kh+(long)lane*PITCH+wid*8;
  const char*ksrc8=(const char*)Kb+(long)(t0*KVBLK+lane)*(PITCH*2)+16*(wid&3);
  const bf16*vsrc=Vh+(long)(16*(wid&3)+(lane>>2))*PITCH+(wid>>2)*32+(lane&3)*8;
  const char*vsrc8=(const char*)Vb+(long)(t0*KVBLK+16*(wid&3)+(lane>>2))*(PITCH*2)+16*((lane&3)^((lane>>5)<<1));
  const unsigned kdst=QK8?lds0+LDS_K+(wid&3)*1024:lds0+LDS_K+wid*1024, vdst=QK8?lds0+LDS_V+(wid&3)*1024:lds0+LDS_V+wid*1024;
  #define DMA_K(t,slot) do{ if(QK8){ if(wid<4) glds16(ksrc8+(long)(t)*KVBLK*(PITCH*2),(unsigned)__builtin_amdgcn_readfirstlane(kdst+(slot))); } else glds16(ksrc+(long)(t)*KVBLK*PITCH,(unsigned)__builtin_amdgcn_readfirstlane(kdst+(slot))); }while(0)
  #define DMA_V(t,slot) do{ if(QK8){ if(wid>=4) glds16(vsrc8+(long)(t)*KVBLK*(PITCH*2),(unsigned)__builtin_amdgcn_readfirstlane(vdst+(slot))); } else glds16(vsrc+(long)(t)*KVBLK*PITCH,(unsigned)__builtin_amdgcn_readfirstlane(vdst+(slot))); }while(0)
  const int vb0=(int)(lds0+LDS_V)+((lane>>4)&1)*32+(lane&3)*8+(4*hi+((lane&15)>>2))*64;
  const char*Kbase=shm+LDS_K; bf16x8 kf[8]; i32x8a kf8[2]; i32x8a qr8;
  const lds_cptr shm3=(lds_cptr)shm; const lds_cptr kp0=QK8?shm3+LDS_K+hi*2048+r32*16:shm3+LDS_K+hi*1024+r32*16; const lds_cptr vp0=shm3+LDS_V+((lane>>4)&1)*32+(lane&3)*8+(4*hi+((lane&15)>>2))*64;
  const int k8_=(lane&15)>>1, c8_=lane&1, g8_=(lane>>4)&1, sw8_=(k8_>>2)&1, row8_=(k8_&3)+8*(k8_>>2)+4*hi;
  const lds_cptr vb8a=shm3+LDS_V+row8_*64+((g8_^(sw8_<<1))*16)+8*c8_, vb8b=shm3+LDS_V+row8_*64+(((g8_+2)^(sw8_<<1))*16)+8*c8_;
  i32x8a ones8f; { const int o1=(((lane>>4)&1)==((lane>>3)&1))?0x38383838:0; ones8f=(i32x8a){o1,o1,o1,o1,o1,o1,o1,o1}; asm volatile("":"+v"(ones8f)); }
  if(ATTN_PRIO_HALF && wid>=4) __builtin_amdgcn_s_setprio(1);
  const bool hot=QK8&&warm;
  if(hot){ DMA_V(0,0); } else { DMA_K(0,0);DMA_V(0,0);DMA_K(1,SLOTB); }
  bf16x8 qr[4];
  #pragma unroll
  for(int d0=0;d0<4;++d0)qr[d0]=QK8?bf16x8{}:*reinterpret_cast<const bf16x8*>(&Qw[(long)r32*PITCH+d0*16+hi*8]);
  if(QK8){ if(hot){ qr8=*qnx; } else { const char*qp=(const char*)Qb+(long)(q0+wrow+r32)*(PITCH*2)+whead+32*hi; const i32x4a qa=*(const i32x4a*)qp, qb_=*(const i32x4a*)(qp+16); qr8=__builtin_shufflevector(qa,qb_,0,1,2,3,4,5,6,7); } }
  f32x4a lacc={0.f,0.f,0.f,0.f}; bf16x8 ones8; { const short o1=(short)((((lane>>4)&1)==((lane>>3)&1))?0x3F80:0); ones8=(bf16x8){o1,o1,o1,o1,o1,o1,o1,o1}; asm volatile("":"+v"(ones8)); }
  float mhat=0.f,l_reg=0.f;f32x16 o[2];o[0]=f32x16{};o[1]=f32x16{};f32x16 negm=f32x16{}; if(QK8){ _Pragma("unroll") for(int r=0;r<16;++r) negm[r]=-4.f; } if(MODE==2&&!MFREE) asm volatile("":"+v"(negm));
  const int qrel=wid*QBLK+r32;
  #define CMASK(P0,P1,t) do{ if(MODE!=2) amask<MODE>(P0,P1,t0+(t),q0,(MODE==1)?(wid&3):wid,r32,hi,btab); }while(0)
  bool resc=false;
  #define START(P0,P1) do{ resc=false; if(!MFREE){ const float rm=rowmax(P0,P1); \
      const float dl=__builtin_fmaxf(rm,-64.f); mhat=fadd_s(mhat,dl); \
      _Pragma("unroll") for(int r=0;r<16;++r){P0[r]=fsub_s(P0[r],dl);P1[r]=fsub_s(P1[r],dl);} \
      if(MODE==2){ _Pragma("unroll") for(int r=0;r<16;++r)negm[r]=-mhat; asm volatile("":"+v"(negm)); } } \
    _Pragma("unroll") for(int r=0;r<16;++r)P0[r]=__builtin_amdgcn_exp2f(P0[r]); }while(0)
  #define RESC() do{ if(resc){ asm volatile("s_waitcnt lgkmcnt(0)":::"memory"); \
      _Pragma("unroll") for(int d_=0;d_<2;++d_) _Pragma("unroll") for(int r=0;r<16;++r)o[d_][r]*=wsf[crow(r,hi)]; } }while(0)
  f32x16 pA0,pA1,pB0,pB1;
  int sl_prev=0,sl_cur=0,sl_next=SLOTB;
  #define ROT() do{sl_prev=sl_cur;sl_cur=sl_next;sl_next=(sl_next==(NSLOT-1)*SLOTB)?0:sl_next+SLOTB;}while(0)
  if(!hot){ DMA_K(2,2*SLOTB); }
  if(hot){WAIT_BAR(4);}
  else if(QK8){WAIT_BAR(2);}else{WAIT_BAR(3);}
  #define KLD8(j,base) __builtin_shufflevector(*(const __attribute__((address_space(3))) i32x4a*)((base)+(j)*512),*(const __attribute__((address_space(3))) i32x4a*)((base)+(j)*512+1024),0,1,2,3,4,5,6,7)
  #define MF8(j) __builtin_amdgcn_mfma_scale_f32_32x32x64_f8f6f4(kf8[j],qr8,negm,0,0,0,0x7f7f7f7f,0,0x7b7b7b7b)
  if(QK8){ kf8[0]=KLD8(0,kp0); kf8[1]=KLD8(1,kp0); pA0=MF8(0); pA1=MF8(1); } else qkt(pA0,pA1,Kbase,qr,negm,r32,hi);
  asm volatile("s_nop 15\n\ts_nop 7":"+v"(pA0),"+v"(pA1));CMASK(pA0,pA1,0);
  START(pA0,pA1);
  _Pragma("unroll") for(int r=0;r<16;++r)pA1[r]=__builtin_amdgcn_exp2f(pA1[r]);
  WAIT_BAR(0);
  DMA_K(3,0);DMA_V(1,SLOTB);
  ROT();
  if(QK8){ kf8[0]=KLD8(0,kp0+sl_cur); kf8[1]=KLD8(1,kp0+sl_cur); } else kload8(kf,kp0+sl_cur);
  WAIT_BAR(2);
  s16x4 vlo[8],vhi[8]; u32x4 pw0,pw1,pw2,pw3;
  #define PKW(P,B) cvtpk_s(P[B],P[B+1])
  #define PAF(k) __builtin_bit_cast(bf16x8,pw##k)
  #define VFR(i) (bf16x8){vlo[i][0],vlo[i][1],vlo[i][2],vlo[i][3],vhi[i][0],vhi[i][1],vhi[i][2],vhi[i][3]}
  #define PIN(x) asm volatile("":"+v"(x))
  #define MX3(a,b,c) __builtin_fmaxf(__builtin_fmaxf((a),(b)),(c))
  #define GAPA(MF,A0,A1,A2,A3,W0,W1,PW) do{ MF; if(!LSUM_MFMA){ sacc+=A0; sacc+=A1; sacc+=A2; sacc+=A3; PIN(sacc); } W0; W1; PIN(PW); SBAR(); }while(0)
  #define LMF(k) do{ if(LSUM_MFMA) lacc=__builtin_amdgcn_mfma_f32_16x16x32_bf16(PAF(k),ones8,lacc,0,0,0); }while(0)
  #define QKMF(F8S,B16S) do{ if(QK8){ F8S; } else { B16S; } }while(0)
  #define EX(v) __builtin_amdgcn_exp2f(v)
  #define GAPB(MF,X,B) do{ MF; X[B]=EX(X[B]); X[B+1]=EX(X[B+1]); X[B+2]=EX(X[B+2]); X[B+3]=EX(X[B+3]); PIN(X); SBAR(); }while(0)
  #define VRD(i) do{ vlo[i]=vtr(vp_+(((i)>>2)*4096+((i)&3)*1024)); vhi[i]=vtr(vp_+(((i)>>2)*4096+((i)&3)*1024+512)); }while(0)
  #define KRD(G,j) do{ if(G){ if(QK8){ if((j)<2){ kf8[(j)&1]=KLD8((j)&1,kp0+sl_next); SBAR(); } } else { kload2(kf,kp0+sl_next,j); SBAR(); } } }while(0)
  #define STEP(C0,C1,P0,P1,t,GK,GV,GL) do{ SBAR(); \
    const lds_cptr vp_=vp0+sl_prev; \
    VRD(0); SBAR(); float sacc=LSUM_MFMA?0.f:(P0[0]+P0[1]); \
    GAPA(QKMF(C0=MF8(0), C0=__builtin_amdgcn_mfma_f32_32x32x16_bf16(kf[0],qr[0],negm,0,0,0)), P0[2],P0[3],P0[4],P0[5],     pw0[0]=PKW(P0,0), pw0[1]=PKW(P0,2), pw0); \
    VRD(4); SBAR(); GAPA(QKMF((void)0, C1=__builtin_amdgcn_mfma_f32_32x32x16_bf16(kf[1],qr[0],negm,0,0,0)), P0[6],P0[7],P0[8],P0[9],     pw0[2]=PKW(P0,4), pw0[3]=PKW(P0,6), pw0); \
    VRD(1); SBAR(); GAPA(QKMF((void)0, C0=__builtin_amdgcn_mfma_f32_32x32x16_bf16(kf[2],qr[1],C0,0,0,0)); LMF(0),   P0[10],P0[11],P0[12],P0[13], pw1[0]=PKW(P0,8), pw1[1]=PKW(P0,10), pw1); \
    VRD(5); SBAR(); GAPA(QKMF((void)0, C1=__builtin_amdgcn_mfma_f32_32x32x16_bf16(kf[3],qr[1],C1,0,0,0)),   P0[14],P0[15],P1[0],P1[1],   pw1[2]=PKW(P0,12),pw1[3]=PKW(P0,14), pw1); \
    VRD(2); SBAR(); GAPA(QKMF(C1=MF8(1), C0=__builtin_amdgcn_mfma_f32_32x32x16_bf16(kf[4],qr[2],C0,0,0,0)); LMF(1),   P1[2],P1[3],P1[4],P1[5],     pw2[0]=PKW(P1,0), pw2[1]=PKW(P1,2), pw2); \
    VRD(6); SBAR(); GAPA(QKMF((void)0, C1=__builtin_amdgcn_mfma_f32_32x32x16_bf16(kf[5],qr[2],C1,0,0,0)),   P1[6],P1[7],P1[8],P1[9],     pw2[2]=PKW(P1,4), pw2[3]=PKW(P1,6), pw2); \
    VRD(3); SBAR(); GAPA(QKMF((void)0, C0=__builtin_amdgcn_mfma_f32_32x32x16_bf16(kf[6],qr[3],C0,0,0,0)); LMF(2),   P1[10],P1[11],P1[12],P1[13], pw3[0]=PKW(P1,8), pw3[1]=PKW(P1,10), pw3); \
    VRD(7); SBAR(); GAPA(QKMF((void)0, C1=__builtin_amdgcn_mfma_f32_32x32x16_bf16(kf[7],qr[3],C1,0,0,0)),   P1[14],P1[15],0.f,0.f,       pw3[2]=PKW(P1,12),pw3[3]=PKW(P1,14), pw3); \
    if(!LSUM_MFMA) l_reg+=sacc; \
    if(GK){DMA_K((t)+3,sl_cur);} if(GV){DMA_V((t)+1,sl_next);} \
    CMASK(C0,C1,t); \
    if(MODE!=2&&!MFREE){ _Pragma("unroll") for(int r=0;r<16;++r){C0[r]-=mhat;C1[r]-=mhat;} } \
    if(!MFREE){ float a=MX3(C0[0],C0[1],C1[0]),b=MX3(C0[2],C0[3],C1[1]); a=MX3(a,C1[2],C1[3]); \
      _Pragma("unroll") for(int r=4;r<16;r+=4){a=MX3(a,C0[r],C0[r+1]);b=MX3(b,C0[r+2],C0[r+3]);a=MX3(a,C1[r],C1[r+1]);b=MX3(b,C1[r+2],C1[r+3]);} \
      float rm=__builtin_fmaxf(a,b); { auto rr=__builtin_amdgcn_permlane32_swap(__float_as_uint(rm),__float_as_uint(rm),false,false); rm=__builtin_fmaxf(__uint_as_float(rr[0]),__uint_as_float(rr[1])); } \
      resc=false; \
      if(__builtin_expect(__any(rm>(float)THRL),0)){ const float dl=__builtin_fmaxf(rm,0.f); mhat+=dl; \
        _Pragma("unroll") for(int r=0;r<16;++r){C0[r]-=dl;C1[r]-=dl;} \
        if(MODE==2){ _Pragma("unroll") for(int r=0;r<16;++r)negm[r]=-mhat; asm volatile("":"+v"(negm)); } \
        const float f=__builtin_amdgcn_exp2f(-dl); l_reg*=f; if(hi==0)wsf[r32]=f; resc=true; } } \
    SBAR(); \
    GAPB(o[0]=__builtin_amdgcn_mfma_f32_32x32x16_bf16(PAF(0),VFR(0),o[0],0,0,0); LMF(3), C0,0); \
    GAPB(o[1]=__builtin_amdgcn_mfma_f32_32x32x16_bf16(PAF(0),VFR(4),o[1],0,0,0), C0,4); \
    KRD(GL,0); GAPB(o[0]=__builtin_amdgcn_mfma_f32_32x32x16_bf16(PAF(1),VFR(1),o[0],0,0,0), C0,8); \
    KRD(GL,1); GAPB(o[1]=__builtin_amdgcn_mfma_f32_32x32x16_bf16(PAF(1),VFR(5),o[1],0,0,0), C0,12); \
    KRD(GL,2); GAPB(o[0]=__builtin_amdgcn_mfma_f32_32x32x16_bf16(PAF(2),VFR(2),o[0],0,0,0), C1,0); \
    KRD(GL,3); GAPB(o[1]=__builtin_amdgcn_mfma_f32_32x32x16_bf16(PAF(2),VFR(6),o[1],0,0,0), C1,4); \
    GAPB(o[0]=__builtin_amdgcn_mfma_f32_32x32x16_bf16(PAF(3),VFR(3),o[0],0,0,0), C1,8); \
    GAPB(o[1]=__builtin_amdgcn_mfma_f32_32x32x16_bf16(PAF(3),VFR(7),o[1],0,0,0), C1,12); \
    }while(0)
  i32x2a vr8[2][4]; i32x8a pw8; int sc1_=0x7f7f7f7f, scv_=0x7c7c7c7c, scq_=0x7b7b7b7b; asm volatile("":"+v"(sc1_),"+v"(scv_),"+v"(scq_));
  #define PK4E(P,B) ({ int w_; asm("v_cvt_pk_fp8_f32 %0, %1, %2":"=v"(w_):"v"(P[B]),"v"(P[(B)+1])); asm("v_cvt_pk_fp8_f32 %0, %1, %2 op_sel:[0,0,1]":"+v"(w_):"v"(P[(B)+2]),"v"(P[(B)+3])); w_; })
  #define MF8A(j,CX) asm volatile("v_mfma_scale_f32_32x32x64_f8f6f4 %0, %1, %2, -4.0, %3, %4 op_sel_hi:[0,0,0]":"=&v"(CX):"v"(kf8[j]),"v"(qr8),"v"(sc1_),"v"(scq_))
  #define PK8E(P,B,M) do{ int w0_,w1_; asm("v_cvt_pk_fp8_f32 %0, %2, %3\n\tv_cvt_pk_fp8_f32 %1, %6, %7\n\tv_cvt_pk_fp8_f32 %0, %4, %5 op_sel:[0,0,1]\n\tv_cvt_pk_fp8_f32 %1, %8, %9 op_sel:[0,0,1]":"=&v"(w0_),"=&v"(w1_):"v"(P[B]),"v"(P[(B)+1]),"v"(P[(B)+2]),"v"(P[(B)+3]),"v"(P[(B)+4]),"v"(P[(B)+5]),"v"(P[(B)+6]),"v"(P[(B)+7])); pw8[M]=w0_; pw8[(M)+1]=w1_; }while(0)
  #define VTR8(p) __builtin_amdgcn_ds_read_tr8_b64_v2i32((__attribute__((address_space(3))) i32x2a*)(p))
  #define VB8(b) (i32x8a){vr8[b][0][0],vr8[b][0][1],vr8[b][1][0],vr8[b][1][1],vr8[b][2][0],vr8[b][2][1],vr8[b][3][0],vr8[b][3][1]}
  #define PVMF(b) do{ const i32x8a vb_op_=VB8(b); asm volatile("v_mfma_scale_f32_32x32x64_f8f6f4 %0, %1, %2, %0, %3, %4 op_sel_hi:[0,0,0]":"+v"(o[b]):"v"(pw8),"v"(vb_op_),"v"(sc1_),"v"(scv_)); }while(0)
  #define LMF8() asm volatile("v_mfma_scale_f32_16x16x128_f8f6f4 %0, %1, %2, %0, %3, %3 op_sel_hi:[0,0,0]":"+v"(lacc):"v"(pw8),"v"(ones8f),"v"(sc1_))
  #define G8A(MF,RD,W) do{ RD; SBAR(); MF; W; PIN(pw8); SBAR(); }while(0)
  #define STEP8(C0,C1,P0,P1,t,GK,GV,GL) do{ SBAR(); \
    const lds_cptr va_=vb8a+sl_prev, vb_=vb8b+sl_prev; \
    G8A(MF8A(0,C0), vr8[0][0]=VTR8(va_); vr8[0][1]=VTR8(va_+1024),      PK8E(P0,0,0)); \
    G8A((void)0,   vr8[0][2]=VTR8(va_+2048); vr8[0][3]=VTR8(va_+3072), PK8E(P0,8,2)); \
    G8A(MF8A(1,C1), vr8[1][0]=VTR8(vb_); vr8[1][1]=VTR8(vb_+1024),      PK8E(P1,0,4)); \
    G8A((void)0,   vr8[1][2]=VTR8(vb_+2048); vr8[1][3]=VTR8(vb_+3072), PK8E(P1,8,6)); \
    if(GK){DMA_K((t)+3,sl_cur);} if(GV){DMA_V((t)+1,sl_next);} \
    if(MODE!=2){ asm volatile("s_nop 15\n\ts_nop 15\n\ts_nop 15":"+v"(C0),"+v"(C1)); CMASK(C0,C1,t); }     \
    SBAR(); \
    GAPB(PVMF(0), C0,0); \
    GAPB((void)0, C0,4); \
    KRD(GL,0); GAPB(LMF8(), C0,8); \
    KRD(GL,1); GAPB((void)0, C0,12); \
    GAPB(PVMF(1), C1,0); \
    GAPB((void)0, C1,4); \
    GAPB((void)0, C1,8); \
    GAPB((void)0, C1,12); \
    }while(0)
  #define STEPX(C0,C1,P0,P1,t,GK,GV,GL) do{ if(QK8){ STEP8(C0,C1,P0,P1,t,GK,GV,GL); } else { STEP(C0,C1,P0,P1,t,GK,GV,GL); } }while(0)
  int t=1;
  for(;t+5<NT;t+=2){
    STEPX(pB0,pB1,pA0,pA1,t,true,true,true);     if(QK8){WAIT_BAR(1);}else{WAIT_BAR(2);} RESC(); ROT();
    STEPX(pA0,pA1,pB0,pB1,t+1,true,true,true);   if(QK8){WAIT_BAR(1);}else{WAIT_BAR(2);} RESC(); ROT();
  }
  #define ENDW(tt) do{ if(QK8){ if((tt)+3<NT){WAIT_BAR(1);} else {WAIT_BAR(0);} } else if((tt)+3<NT){WAIT_BAR(2);} else if((tt)+2<NT){WAIT_BAR(1);} else {WAIT_BAR(0);} }while(0)
  for(;t+1<NT;t+=2){
    STEPX(pB0,pB1,pA0,pA1,t,(t+3<NT),(t+1<NT),(t+1<NT));       ENDW(t);   RESC(); ROT();
    STEPX(pA0,pA1,pB0,pB1,t+1,(t+4<NT),(t+2<NT),(t+2<NT));     ENDW(t+1); RESC(); ROT();
  }
  if(QK8&&pre){
    const char*ksn=(const char*)Kn+(long)(t0n*KVBLK+lane)*(PITCH*2)+16*(wid&3);
    if(wid<4){ glds16(ksn,(unsigned)__builtin_amdgcn_readfirstlane(kdst)); glds16(ksn+(long)KVBLK*(PITCH*2),(unsigned)__builtin_amdgcn_readfirstlane(kdst+SLOTB)); glds16(ksn+(long)2*KVBLK*(PITCH*2),(unsigned)__builtin_amdgcn_readfirstlane(kdst+2*SLOTB)); }
    const char*qpn=(const char*)Qn+(long)(q0n+wrow+r32)*(PITCH*2)+whead+32*hi; const i32x4a qa=*(const i32x4a*)qpn, qb_=*(const i32x4a*)(qpn+16); *qnx=__builtin_shufflevector(qa,qb_,0,1,2,3,4,5,6,7); }
  STEPX(pB0,pB1,pA0,pA1,NT-1,false,false,false); RESC();
  { if(!LSUM_MFMA){ float sacc=pB0[0]+pB0[1]; _Pragma("unroll") for(int r=2;r<16;++r)sacc+=pB0[r]; _Pragma("unroll") for(int r=0;r<16;++r)sacc+=pB1[r]; l_reg+=sacc; }
    pw0=(u32x4){PKW(pB0,0),PKW(pB0,2),PKW(pB0,4),PKW(pB0,6)};pw1=(u32x4){PKW(pB0,8),PKW(pB0,10),PKW(pB0,12),PKW(pB0,14)};pw2=(u32x4){PKW(pB1,0),PKW(pB1,2),PKW(pB1,4),PKW(pB1,6)};pw3=(u32x4){PKW(pB1,8),PKW(pB1,10),PKW(pB1,12),PKW(pB1,14)};
    if(QK8){ PK8E(pB0,0,0); PK8E(pB0,8,2); PK8E(pB1,0,4); PK8E(pB1,8,6);
      const lds_cptr va_=vb8a+sl_cur, vb_=vb8b+sl_cur; _Pragma("unroll") for(int q_=0;q_<4;++q_){ vr8[0][q_]=VTR8(va_+q_*1024); vr8[1][q_]=VTR8(vb_+q_*1024); }
      LMF8(); PVMF(0); PVMF(1); asm volatile("s_nop 15\n\ts_nop 7":"+v"(o[0]),"+v"(o[1]),"+v"(lacc)); }
    else { LMF(0); LMF(1); LMF(2); LMF(3);
    SBAR(); pv(o,vb0+sl_cur,PAF(0),PAF(1),PAF(2),PAF(3)); } }
  #undef PKW
  #undef PAF
  #undef VFR
  #undef PIN
  #undef MX3
  #undef GAPA
  #undef MF8A
  #undef STEP8
  #undef STEPX
  #undef G8A
  #undef PK4E
  #undef PK8E
  #undef VTR8
  #undef VB8
  #undef PVMF
  #undef LMF8
  #undef QKMF
  #undef KLD8
  #undef MF8
  #undef LMF
  #undef GAPB
  #undef EX
  #undef VRD
  #undef KRD
  #undef STEP
  #undef ENDW
  if(LSUM_MFMA){ const float sk=(MODE==1)?__builtin_amdgcn_exp2f(sinkl2-(QK8?4.f:mhat)):0.f;
    if((lane&7)==0){ const int qb=((lane>>3)&1)*16+(lane>>4)*4; wsf[32+qb]=lacc[0]+sk; wsf[32+qb+1]=lacc[1]+sk; wsf[32+qb+2]=lacc[2]+sk; wsf[32+qb+3]=lacc[3]+sk; } }
  else{
  {auto rr=__builtin_amdgcn_permlane32_swap(__float_as_uint(l_reg),__float_as_uint(l_reg),false,false);l_reg=__uint_as_float(rr[0])+__uint_as_float(rr[1]);}
  if(MODE==1) l_reg+=__builtin_amdgcn_exp2f(sinkl2-mhat);
  if(hi==0)wsf[32+r32]=l_reg; }
  asm volatile("s_waitcnt lgkmcnt(0)":::"memory");
  float rli[16];
  #pragma unroll
  for(int r=0;r<16;++r)rli[r]=__builtin_amdgcn_rcpf(wsf[32+crow(r,hi)]);
  bf16*Ow=Ob+(long)(q0+wrow)*OPITCH+whead; unsigned char*Ow8=(unsigned char*)Ob+(long)(q0+wrow)*OPITCH+whead;
  if(O_FP8){ unsigned char*stg8=(unsigned char*)(shm+LDS_OST)+wid*4096;
    #pragma unroll
    for(int r=0;r<16;++r){const int orow=crow(r,hi); const float s16=rli[r]*16.f;
      const float a_=__builtin_amdgcn_fmed3f(o[0][r]*s16,-448.f,448.f), b_=__builtin_amdgcn_fmed3f(o[1][r]*s16,-448.f,448.f);
      const unsigned w_=(unsigned)__builtin_amdgcn_cvt_pk_fp8_f32(a_,b_,0,false);
      stg8[orow*64+r32]=(unsigned char)(w_&0xffu); stg8[orow*64+32+r32]=(unsigned char)((w_>>8)&0xffu);}
    asm volatile("s_waitcnt lgkmcnt(0)":::"memory");
    #pragma unroll
    for(int i=0;i<2;++i){const int row=i*16+(lane>>2),ch=lane&3; const u32x4 v=*(const u32x4*)(stg8+row*64+ch*16); ATTN_STORE16(Ow8+(long)row*OPITCH+ch*16,v);} }
  else   { bf16*stg=(bf16*)(shm+LDS_OST)+wid*2048;
    #pragma unroll
    for(int r=0;r<16;++r){const int orow=crow(r,hi);
      #pragma unroll
      for(int d0=0;d0<2;++d0)stg[orow*64+d0*32+r32]=__float2bfloat16(o[d0][r]*rli[r]);}
    asm volatile("s_waitcnt lgkmcnt(0)":::"memory");
    #pragma unroll
    for(int i=0;i<4;++i){const int row=i*8+(lane>>3),ch=lane&7; const u32x4 v=*(const u32x4*)(stg+row*64+ch*8); ATTN_STORE16(Ow+(long)row*OPITCH+ch*8,v);} }
  if(ATTN_PRIO_HALF && wid>=4) __builtin_amdgcn_s_setprio(0);
  asm volatile("s_waitcnt lgkmcnt(0)\n\ts_barrier":::"memory");
  #undef DMA_K
  #undef DMA_V
  #undef CMASK
  #undef START
  #undef RESC
  #undef ROT
}
constexpr int ATTN_LDS_BYTES=LDS_BYTES;
#undef SBAR
#undef WAIT_BAR
}

constexpr int NWAVES = 8;
constexpr int BATCH = 32, SEQ = 2048, DM = 1024, NTOK = BATCH * SEQ;
constexpr int EVEN_IN = 2304, ODD_IN = 1536, NE = 16, CAP = 256, DFF = 2048;
constexpr float RMS_EPS = 1e-6f, LOG2E = 1.4426950408889634f, QSCALE = 0.125f * 1.4426950408889634f;

constexpr size_t MiB = 1u << 20;
constexpr size_t WS_CTL = 0, CTL_ZERO_BYTES = 32768;
constexpr size_t WS_TAB = 1 * MiB;
constexpr size_t WS_WIN0 = 2 * MiB, WS_WOUT0 = 7 * MiB, WS_WIN1 = 9 * MiB, WS_WOUT1 = 12 * MiB;
constexpr size_t WS_SELROW = 14 * MiB, WS_GATE = 14 * MiB + 512 * 1024;
constexpr size_t WS_INV = 15 * MiB;
constexpr size_t WS_AFF = 19 * MiB;
constexpr size_t WS_WGU = 24 * MiB;
constexpr size_t WS_WD = 152 * MiB;
constexpr size_t WS_H = 216 * MiB;
constexpr size_t WS_QKV = 344 * MiB;
constexpr size_t WS_Y = 632 * MiB;
constexpr size_t WS_XB = 760 * MiB;
constexpr size_t WS_H8 = 888 * MiB;
constexpr size_t WS_END = 952 * MiB;
constexpr int CW_BAR = 4096;
constexpr int TAB_COS = 0, TAB_SIN = 65536, TAB_ACOS = 131072, TAB_ASIN = 131072 + 1024;

constexpr int RING_OFF = 0, RING_BYTES = 131072;
constexpr int BIAS_OFF = 86016, BIAS_PAD = 64;
constexpr int LDS_BYTES = 159744;
constexpr int LDSCTL_OFF = LDS_BYTES - 512, MISC_OFF = LDSCTL_OFF + 320;
constexpr int NA_SLOT = 16384, NA_XO = 9 * NA_SLOT, NA_XL = NA_XO + 8192, NA_BT = NA_XL + 1024;
static_assert(NA_BT + 2400 <= LDSCTL_OFF, "mixer A LDS map");
static_assert(MISC_OFF + 128 <= LDS_BYTES && attn_body::ATTN_LDS_BYTES <= BIAS_OFF && BIAS_OFF + 4 * (465 + 2 * BIAS_PAD + 64) <= RING_BYTES, "LDS map");

#define GAS __attribute__((address_space(1)))
#define LAS __attribute__((address_space(3)))
typedef unsigned short bf16;
typedef unsigned v4u __attribute__((ext_vector_type(4)));
typedef unsigned v2u __attribute__((ext_vector_type(2)));
typedef float f32x4 __attribute__((ext_vector_type(4)));
typedef GAS unsigned gu32;
#define RLX_AGENT __ATOMIC_RELAXED, __HIP_MEMORY_SCOPE_AGENT
#define LDS_WAIT() asm volatile("s_waitcnt lgkmcnt(0)" ::: "memory")
__device__ __forceinline__ unsigned f2bf(float f) { unsigned u = __builtin_bit_cast(unsigned, f); return (u + 0x7fffu + ((u >> 16) & 1u)) >> 16; }
__device__ __forceinline__ unsigned pk2(float lo, float hi) { return f2bf(lo) | (f2bf(hi) << 16); }
__device__ __forceinline__ float bf_lo(unsigned w) { return __builtin_bit_cast(float, w << 16); }
__device__ __forceinline__ float bf_hi(unsigned w) { return __builtin_bit_cast(float, w & 0xffff0000u); }

#define XB_TMO      128
#define XB_XCNT(j)  (256  + 64 * (j))
#define XB_XSUB(j)  (1280 + 64 * (j))
#define XB_XGEN(j)  (2304 + 64 * (j))
#define XB_TOP      3328
#define XB_TOPGEN   3392
#define XCD_BAR_WORDS 3456
#define XB_SPIN_CAP (1u << 18)

__device__ __forceinline__ unsigned xb_ld(unsigned* p)              { return __hip_atomic_load(p, __ATOMIC_RELAXED, __HIP_MEMORY_SCOPE_AGENT); }
__device__ __forceinline__ unsigned xb_add(unsigned* p, unsigned v) { return __hip_atomic_fetch_add(p, v, __ATOMIC_RELAXED, __HIP_MEMORY_SCOPE_AGENT); }
__device__ __forceinline__ unsigned xb_xcc_id() { return (unsigned)__builtin_amdgcn_s_getreg((3 << 11) | 20) & 0xFu; }
#define XB_SPIN(cond, bar) do { unsigned _sp = 0; while (cond) { __builtin_amdgcn_s_sleep(1); \
    if ((++_sp & 255u) == 0u) { if (xb_ld(&(bar)[XB_TMO])) break; if (_sp > XB_SPIN_CAP) { atomicAdd(&(bar)[XB_TMO], 1u); break; } } } } while (0)

struct XcdBarrier {
    unsigned* bar; unsigned x;
    volatile LAS unsigned* st;
};

__device__ __forceinline__ XcdBarrier xcd_barrier_post(unsigned* bar, volatile LAS unsigned* st) {
    XcdBarrier b; b.bar = bar; b.x = xb_xcc_id(); b.st = st;
    if (threadIdx.x == 0) (void)xb_add(&bar[XB_XCNT(b.x)], 1u);
    return b;
}
__device__ __forceinline__ void xcd_barrier_complete(unsigned* bar, unsigned x, unsigned& nloc, unsigned& nx) {
    const unsigned G = gridDim.x * gridDim.y * gridDim.z;
    unsigned sum, cnt, mine, sp = 0u;
    for (;;) {
        sum = 0u; cnt = 0u; mine = 0u;
#pragma unroll
        for (unsigned j = 0; j < 16; ++j) { const unsigned c = xb_ld(&bar[XB_XCNT(j)]); sum += c; cnt += (c > 0u) ? 1u : 0u; mine = (j == x) ? c : mine; }
        if (sum == G) break;
        __builtin_amdgcn_s_sleep(1);
        if ((++sp & 255u) == 0u) { if (xb_ld(&bar[XB_TMO])) break; if (sp > XB_SPIN_CAP) { atomicAdd(&bar[XB_TMO], 1u); break; } }
    }
    nloc = mine > 0u ? mine : 1u; nx = cnt > 0u ? cnt : 1u;
}

__device__ __forceinline__ void xcd_barrier(const XcdBarrier& b) {
    asm volatile("s_waitcnt vmcnt(0)" ::: "memory");
    __syncthreads();
    if (threadIdx.x == 0) {
        unsigned* bar = b.bar;
        __builtin_amdgcn_s_waitcnt(0);
        unsigned nloc = b.st[0], nx = b.st[1];
        if (nloc == 0u) { xcd_barrier_complete(bar, b.x, nloc, nx); b.st[0] = nloc; b.st[1] = nx; }
        const unsigned old = xb_add(&bar[XB_XSUB(b.x)], 1u);
        const unsigned gen = old / nloc;
        if (old + 1u == (gen + 1u) * nloc) {
            __builtin_amdgcn_fence(__ATOMIC_RELEASE, "agent");
            asm volatile("s_waitcnt vmcnt(0)" ::: "memory");
            const unsigned og = xb_add(&bar[XB_TOP], 1u);
            const unsigned tg = og / nx;
            if (og + 1u == (tg + 1u) * nx) xb_add(&bar[XB_TOPGEN], 1u);
            else XB_SPIN(xb_ld(&bar[XB_TOPGEN]) == tg, bar);
            __builtin_amdgcn_fence(__ATOMIC_ACQUIRE, "agent");
            xb_add(&bar[XB_XGEN(b.x)], 1u);
            asm volatile("s_waitcnt vmcnt(0)" ::: "memory");
        } else {
            XB_SPIN(xb_ld(&bar[XB_XGEN(b.x)]) == gen, bar);
            __builtin_amdgcn_fence(__ATOMIC_ACQUIRE, "agent");
            asm volatile("s_waitcnt vmcnt(0)" ::: "memory");
        }
    }
    __syncthreads();
}

struct Frame {
    LAS unsigned char* lds;
    int tid, lane, wave;
    int vcu, G;
};

__device__ __forceinline__ float wave_sum(float v) {
#pragma unroll
    for (int o = 1; o < 64; o <<= 1) v += __shfl_xor(v, o);
    return v;
}
__device__ __forceinline__ void transpose_item(const float* W, int K, int N, bf16* WT, int k0, int n0, int drow0, LAS float* scr, int lane, int hi_step = 16) {
#pragma unroll 8
    for (int i = 0; i < 32; ++i) { const int kk = 2 * i + (lane >> 5); scr[kk * 33 + (lane & 31)] = W[(size_t)(k0 + kk) * N + n0 + (lane & 31)]; }
    LDS_WAIT(); asm volatile("" ::: "memory");
    const int c = lane & 7;
#pragma unroll
    for (int j = 0; j < 4; ++j) { const int n = (lane >> 3) + 8 * j; const LAS float* s = scr + (8 * c) * 33 + n;
        v4u o; o.x = pk2(s[0 * 33], s[1 * 33]); o.y = pk2(s[2 * 33], s[3 * 33]); o.z = pk2(s[4 * 33], s[5 * 33]); o.w = pk2(s[6 * 33], s[7 * 33]);
        *(GAS v4u*)(WT + (size_t)(drow0 + (n & 15) + (n >> 4) * hi_step) * K + k0 + 8 * c) = o; }
    LDS_WAIT(); asm volatile("" ::: "memory");
}
__device__ __forceinline__ unsigned pk4_fp8(float a, float b, float c, float d) {
    a = __builtin_amdgcn_fmed3f(a, -448.f, 448.f); b = __builtin_amdgcn_fmed3f(b, -448.f, 448.f); c = __builtin_amdgcn_fmed3f(c, -448.f, 448.f); d = __builtin_amdgcn_fmed3f(d, -448.f, 448.f);
    int w = 0; w = __builtin_amdgcn_cvt_pk_fp8_f32(a, b, w, false); w = __builtin_amdgcn_cvt_pk_fp8_f32(c, d, w, true); return (unsigned)w; }
__device__ __forceinline__ void transpose_item8(const float* W, int K, int N, unsigned char* WT, int k0, int n0, int drow0, LAS float* scr, int lane, int hi_step = 16) {
#pragma unroll 8
    for (int i = 0; i < 32; ++i) { const int kk = 2 * i + (lane >> 5); scr[kk * 33 + (lane & 31)] = W[(size_t)(k0 + kk) * N + n0 + (lane & 31)]; }
    LDS_WAIT(); asm volatile("" ::: "memory");
    const int c = lane & 7;
#pragma unroll
    for (int j = 0; j < 4; ++j) { const int n = (lane >> 3) + 8 * j; const LAS float* s = scr + (8 * c) * 33 + n;
        v2u o; o.x = pk4_fp8(s[0 * 33] * 64.f, s[1 * 33] * 64.f, s[2 * 33] * 64.f, s[3 * 33] * 64.f); o.y = pk4_fp8(s[4 * 33] * 64.f, s[5 * 33] * 64.f, s[6 * 33] * 64.f, s[7 * 33] * 64.f);
        *(GAS v2u*)(WT + (size_t)(drow0 + (n & 15) + (n >> 4) * hi_step) * K + k0 + 8 * c) = o; }
    LDS_WAIT(); asm volatile("" ::: "memory");
}
__device__ __forceinline__ void prep_small_weights(Frame& F, const float* win0, const float* wout0, const float* win1, const float* wout1, unsigned char* ws) {
    int lane_ = F.lane, tid_ = F.tid; asm volatile("" : "+v"(lane_), "+v"(tid_));
    LAS float* scr = (LAS float*)(F.lds + RING_OFF + F.wave * 16384);
    const int gw = F.vcu * NWAVES + F.wave, NGW = F.G * NWAVES;
    constexpr int I0 = 16 * (EVEN_IN / 32), I1 = 16 * (DM / 32), I2 = 16 * (ODD_IN / 32), I3 = 16 * (DM / 32);
    for (int it = gw; it < I0 + I1 + I2 + I3; it += NGW) {
        int r = it; const float* W; bf16* WT; int N;
        if (r < I0) { W = win0; WT = (bf16*)(ws + WS_WIN0); N = EVEN_IN; }
        else if ((r -= I0) < I1) { W = wout0; WT = (bf16*)(ws + WS_WOUT0); N = DM; }
        else if ((r -= I1) < I2) { W = win1; WT = (bf16*)(ws + WS_WIN1); N = ODD_IN; }
        else { r -= I2; W = wout1; WT = (bf16*)(ws + WS_WOUT1); N = DM; }
        const int nblk = N / 32, kb = r / nblk, nb = r % nblk, n0 = 32 * nb;
        if (N == EVEN_IN) transpose_item8(W, DM, N, (unsigned char*)WT, 64 * kb, n0, (n0 & ~255) + 128 * ((n0 >> 5) & 1) + 32 * ((n0 >> 6) & 3), scr, lane_);
        else if (N == ODD_IN) transpose_item8(W, DM, N, (unsigned char*)WT, 64 * kb, n0, (n0 & ~255) + 32 * ((n0 >> 6) & 3) + 16 * ((n0 >> 5) & 1), scr, lane_, 128);
        else transpose_item8(W, DM, N, (unsigned char*)WT, 64 * kb, n0, n0, scr, lane_);
    }
}
__device__ __forceinline__ void xpose8_block(const float* W, int N, unsigned char* WT, int Kb, int k0, int n0, int drow0, int lane, const float sc = 64.f) {
    const int g = lane >> 4, c = lane & 15;
    const GAS f32x4* src = (const GAS f32x4*)(W + (size_t)(k0 + 16 * g) * N + n0 + 4 * c);
    f32x4 v[16];
#pragma unroll
    for (int i = 0; i < 16; ++i) v[i] = __builtin_nontemporal_load(&src[(size_t)i * (N / 4)]);
#pragma unroll
    for (int jn = 0; jn < 4; ++jn) { v4u w;
        w.x = pk4_fp8(v[0][jn] * sc, v[1][jn] * sc, v[2][jn] * sc, v[3][jn] * sc); w.y = pk4_fp8(v[4][jn] * sc, v[5][jn] * sc, v[6][jn] * sc, v[7][jn] * sc);
        w.z = pk4_fp8(v[8][jn] * sc, v[9][jn] * sc, v[10][jn] * sc, v[11][jn] * sc); w.w = pk4_fp8(v[12][jn] * sc, v[13][jn] * sc, v[14][jn] * sc, v[15][jn] * sc);
        __builtin_nontemporal_store(w, (GAS v4u*)(WT + (size_t)(drow0 + 4 * c + jn) * Kb + k0 + 16 * g)); }
}
__device__ __forceinline__ void prep_moe_weights(Frame& F, const float* wg, const float* wu, const float* wd, unsigned char* ws) {
    int lane_ = F.lane; asm volatile("" : "+v"(lane_));
    const int gw = F.vcu * NWAVES + F.wave, NGW = F.G * NWAVES;
    constexpr int IG = (DM / 64) * (DFF / 64), ID = (DFF / 64) * (DM / 64), IE = 2 * IG + ID;
    for (int it = gw; it < 2 * NE * IE; it += NGW) {
        const int e = it / IE; int r = it % IE;
        if (r < 2 * IG) { const int up = r >= IG; r -= up * IG; const int kb = r / (DFF / 64), nb = r % (DFF / 64), n0 = 64 * nb;
            xpose8_block((up ? wu : wg) + (size_t)e * DM * DFF, DFF, ws + WS_WGU + (size_t)e * 4096 * DM, DM, 64 * kb, n0, (n0 >> 7) * 256 + (n0 & 127) + up * 128, lane_, up ? -0.6931471805599453f * 64.f : -1.4426950408889634f * 64.f); }
        else { r -= 2 * IG; const int kb = r / (DM / 64), nb = r % (DM / 64);
            xpose8_block(wd + (size_t)e * DFF * DM, DM, ws + WS_WD + (size_t)e * DM * DFF, DFF, 64 * kb, 64 * nb, 64 * nb, lane_); }
    }
}
__device__ __forceinline__ void prep_moe_layer(Frame& F, const int LY, const float* wg, const float* wu, const float* wd, unsigned char* ws) {
    int lane_ = F.lane; asm volatile("" : "+v"(lane_));
    const int gw = F.vcu * NWAVES + F.wave, NGW = F.G * NWAVES;
    constexpr int IG = (DM / 64) * (DFF / 64), ID = (DFF / 64) * (DM / 64), IE = 2 * IG + ID;
    for (int it = LY * NE * IE + gw; it < (LY + 1) * NE * IE; it += NGW) {
        const int e = it / IE; int r = it % IE;
        if (r < 2 * IG) { const int up = r >= IG; r -= up * IG; const int kb = r / (DFF / 64), nb = r % (DFF / 64), n0 = 64 * nb;
            xpose8_block((up ? wu : wg) + (size_t)e * DM * DFF, DFF, ws + WS_WGU + (size_t)e * 4096 * DM, DM, 64 * kb, n0, (n0 >> 7) * 256 + (n0 & 127) + up * 128, lane_, up ? -0.6931471805599453f * 64.f : -1.4426950408889634f * 64.f); }
        else { r -= 2 * IG; const int kb = r / (DM / 64), nb = r % (DM / 64);
            xpose8_block(wd + (size_t)e * DFF * DM, DM, ws + WS_WD + (size_t)e * DM * DFF, DFF, 64 * kb, 64 * nb, 64 * nb, lane_); }
    }
}
__device__ __forceinline__ void prep_tables(Frame& F, float* tab) {
    int lane_ = F.lane, tid_ = F.tid; asm volatile("" : "+v"(lane_), "+v"(tid_));
    const int gt = F.vcu * (NWAVES * 64) + tid_, NGT = F.G * NWAVES * 64;
    for (int idx = gt; idx < SEQ * 32 + 64 * 16; idx += NGT) {
        if (idx < SEQ * 32) { const int pos = idx >> 5, i = idx & 31; const float inv = powf(10000.0f, -(float)i / 32.0f), ang = (float)pos * inv; ((unsigned*)tab)[idx] = pg8::cvt_pk_bf16(cosf(ang), sinf(ang)); }
        else { const int j = idx - SEQ * 32, pos = j >> 4, i = j & 15; const float inv = powf(10000.0f, -(float)i / 16.0f), ang = (float)pos * inv; ((unsigned*)tab)[65536 + j] = pg8::cvt_pk_bf16(cosf(ang), sinf(ang)); }
    }
}
__device__ __forceinline__ void norm_rows(Frame& F, const float* x, const float* gain, unsigned char* H8) {
    int lane_ = F.lane, tid_ = F.tid; asm volatile("" : "+v"(lane_), "+v"(tid_));
    const int gw = F.vcu * NWAVES + F.wave, NGW = F.G * NWAVES;
    f32x4 gv[4];
#pragma unroll
    for (int j = 0; j < 4; ++j) gv[j] = ((const f32x4*)gain)[lane_ + 64 * j];
    int m0 = 2 * gw; f32x4 nv[2][4];
#pragma unroll
    for (int q = 0; q < 2; ++q)
#pragma unroll
        for (int j = 0; j < 4; ++j) nv[q][j] = m0 < NTOK ? ((const GAS f32x4*)(x + (size_t)(m0 + q) * DM) + lane_)[64 * j] : (f32x4){0.f, 0.f, 0.f, 0.f};
    for (; m0 < NTOK; m0 += 2 * NGW) {
        f32x4 v[2][4]; const int mn = m0 + 2 * NGW;
#pragma unroll
        for (int q = 0; q < 2; ++q)
#pragma unroll
            for (int j = 0; j < 4; ++j) v[q][j] = nv[q][j];
        if (mn < NTOK) {
#pragma unroll
            for (int q = 0; q < 2; ++q)
#pragma unroll
                for (int j = 0; j < 4; ++j) nv[q][j] = ((const GAS f32x4*)(x + (size_t)(mn + q) * DM) + lane_)[64 * j]; }
#pragma unroll
        for (int q = 0; q < 2; ++q) { float s = 0.f;
#pragma unroll
            for (int j = 0; j < 4; ++j) s += (v[q][j].x * v[q][j].x + v[q][j].y * v[q][j].y) + (v[q][j].z * v[q][j].z + v[q][j].w * v[q][j].w);
            const float r = rsqrtf(wave_sum(s) * (1.f / DM) + RMS_EPS);
            GAS unsigned* o4 = (GAS unsigned*)(H8 + (size_t)(m0 + q) * DM) + lane_;
#pragma unroll
            for (int j = 0; j < 4; ++j) { const f32x4 o = v[q][j] * r * gv[j]; o4[64 * j] = pk4_fp8(o.x, o.y, o.z, o.w); } }
    }
}
__device__ __forceinline__ void norm_router_phase(Frame& F, const bf16* x, const float* gain, const float* wr, unsigned char* H8, float* aff) {
    typedef short bf16x8 __attribute__((ext_vector_type(8)));
    int lane_ = F.lane, tid_ = F.tid; asm volatile("" : "+v"(lane_), "+v"(tid_));
    constexpr int WROW = 1032;
    LAS bf16* whi = (LAS bf16*)(F.lds + RING_OFF); LAS bf16* wlo = whi + 16 * WROW; LAS float* gl = (LAS float*)(wlo + 16 * WROW);
    { float wv[32], gk[32];
#pragma unroll
      for (int q = 0; q < 32; ++q) { const int i = tid_ + 512 * q; wv[q] = wr[i]; gk[q] = gain[i >> 4]; }
      const float g0_ = gain[tid_], g1_ = gain[tid_ + 512];
#pragma unroll
      for (int q = 0; q < 32; ++q) { const int i = tid_ + 512 * q, k = i >> 4, e = i & 15; const float w = wv[q] * gk[q]; const unsigned hb = f2bf(w); const float hf = __uint_as_float(hb << 16);
          whi[e * WROW + k] = (bf16)hb; wlo[e * WROW + k] = (bf16)f2bf(w - hf); }
      gl[tid_] = g0_; gl[tid_ + 512] = g1_; }
    LDS_WAIT(); __syncthreads();
    const int gw = F.vcu * NWAVES + F.wave, NGW = F.G * NWAVES, r_ = lane_ & 15, g_ = lane_ >> 4;
    for (int grp = gw; grp < NTOK / 16; grp += NGW) {
        asm volatile("" ::: "memory");
        const int m0 = grp * 16;
        const GAS v4u* xr = (const GAS v4u*)(x + (size_t)(m0 + r_) * DM + 8 * g_);
        v4u xf[32];
#pragma unroll
        for (int s2 = 0; s2 < 32; ++s2) xf[s2] = xr[4 * s2];
        f32x4 acc = (f32x4){0.f, 0.f, 0.f, 0.f}; float ss = 0.f;
#pragma unroll
        for (int s2 = 0; s2 < 32; ++s2) { if ((s2 & 3) == 0) asm volatile("" ::: "memory");     const bf16x8 xa = __builtin_bit_cast(bf16x8, xf[s2]);
            const bf16x8 bh = *(const LAS bf16x8*)(whi + r_ * WROW + 32 * s2 + 8 * g_), bl = *(const LAS bf16x8*)(wlo + r_ * WROW + 32 * s2 + 8 * g_);
            acc = __builtin_amdgcn_mfma_f32_16x16x32_bf16(xa, bh, acc, 0, 0, 0); acc = __builtin_amdgcn_mfma_f32_16x16x32_bf16(xa, bl, acc, 0, 0, 0);
            const v4u w_ = xf[s2]; const unsigned w0 = w_.x, w1 = w_.y, w2 = w_.z, w3 = w_.w;
            const float a0 = bf_lo(w0), a1 = bf_hi(w0), a2 = bf_lo(w1), a3 = bf_hi(w1), a4 = bf_lo(w2), a5 = bf_hi(w2), a6 = bf_lo(w3), a7 = bf_hi(w3);
            ss += ((a0 * a0 + a1 * a1) + (a2 * a2 + a3 * a3)) + ((a4 * a4 + a5 * a5) + (a6 * a6 + a7 * a7)); }
#pragma unroll
        for (int s2 = 0; s2 < 32; ++s2) asm volatile("" : "+v"(xf[s2]));
        ss += __shfl_xor(ss, 16); ss += __shfl_xor(ss, 32);
        const float rr = rsqrtf(ss * (1.f / DM) + RMS_EPS);
        float pe[4], sm[4];
#pragma unroll
        for (int rg = 0; rg < 4; ++rg) { const float lg = acc[rg] * __shfl(rr, 4 * g_ + rg); float mx = lg;
#pragma unroll
            for (int o = 1; o <= 8; o <<= 1) mx = fmaxf(mx, __shfl_xor(mx, o));
            pe[rg] = expf(lg - mx); float su = pe[rg];
#pragma unroll
            for (int o = 1; o <= 8; o <<= 1) su += __shfl_xor(su, o);
            sm[rg] = su; }
        { const int b = m0 >> 11, sq = (m0 & (SEQ - 1)) + 4 * g_;
          *(GAS f32x4*)(aff + ((size_t)(b * NE + r_)) * SEQ + sq) = (f32x4){pe[0] / sm[0], pe[1] / sm[1], pe[2] / sm[2], pe[3] / sm[3]}; }
        GAS v2u* orow = (GAS v2u*)(H8 + (size_t)(m0 + r_) * DM + 8 * g_);
#pragma unroll
        for (int s2 = 0; s2 < 32; ++s2) { if ((s2 & 3) == 0) asm volatile("" ::: "memory"); const v4u w_ = xf[s2]; const unsigned w0 = w_.x, w1 = w_.y, w2 = w_.z, w3 = w_.w;
            const f32x4 g0 = *(const LAS f32x4*)(gl + 32 * s2 + 8 * g_), g1 = *(const LAS f32x4*)(gl + 32 * s2 + 8 * g_ + 4);
            v2u o; o.x = pk4_fp8(bf_lo(w0) * rr * g0.x, bf_hi(w0) * rr * g0.y, bf_lo(w1) * rr * g0.z, bf_hi(w1) * rr * g0.w);
            o.y = pk4_fp8(bf_lo(w2) * rr * g1.x, bf_hi(w2) * rr * g1.y, bf_lo(w3) * rr * g1.z, bf_hi(w3) * rr * g1.w);
            orow[4 * s2] = o; }
    }
    __syncthreads();
}
__device__ __forceinline__ void select_phase(Frame& F, const float* aff, int* selrow, float* gate, int* inv) {
    int lane_ = F.lane, tid_ = F.tid; asm volatile("" : "+v"(lane_), "+v"(tid_));
    LAS unsigned* hist = (LAS unsigned*)(F.lds + RING_OFF);
    LAS unsigned* bc = hist + 256;
    LAS unsigned* wsum = hist + 272;
    for (int u = F.vcu; u < BATCH * NE; u += F.G) {
        const int b = u >> 4, e = u & 15;
        const f32x4 a4 = ((const GAS f32x4*)(aff + (size_t)u * SEQ))[tid_];
        const float a0_ = a4[0], a1_ = a4[1], a2_ = a4[2], a3_ = a4[3];
        unsigned k[4] = {__float_as_uint(a0_), __float_as_uint(a1_), __float_as_uint(a2_), __float_as_uint(a3_)};
        unsigned prefix = 0u, need = CAP;
#pragma unroll
        for (int pass = 0; pass < 4; ++pass) { const int shift = 24 - 8 * pass;
            if (tid_ < 256) hist[tid_] = 0u;
            LDS_WAIT(); __syncthreads();
#pragma unroll
            for (int i = 0; i < 4; ++i) if (pass == 0 || (k[i] >> (shift + 8)) == prefix) __hip_atomic_fetch_add(&hist[(k[i] >> shift) & 255u], 1u, __ATOMIC_RELAXED, __HIP_MEMORY_SCOPE_WORKGROUP);
            LDS_WAIT(); __syncthreads();
            if (F.wave == 0) { unsigned c[4];
#pragma unroll
                for (int i = 0; i < 4; ++i) c[i] = hist[4 * lane_ + i];
                const unsigned sl = (c[0] + c[1]) + (c[2] + c[3]); unsigned suf = sl;
#pragma unroll
                for (int o = 1; o < 64; o <<= 1) { const unsigned t = __shfl_down(suf, o); if (lane_ + o < 64) suf += t; }
                unsigned run = suf - sl;
#pragma unroll
                for (int bi = 3; bi >= 0; --bi) { if (run < need && need <= run + c[bi]) { bc[0] = (prefix << 8) | (unsigned)(4 * lane_ + bi); bc[1] = need - run; } run += c[bi]; }
            }
            LDS_WAIT(); __syncthreads();
            prefix = bc[0]; need = bc[1];
        }
        unsigned cg = 0u, ce = 0u;
#pragma unroll
        for (int i = 0; i < 4; ++i) { cg += (k[i] > prefix) ? 1u : 0u; ce += (k[i] == prefix) ? 1u : 0u; }
        unsigned pk = cg | (ce << 16), inc = pk;
#pragma unroll
        for (int o = 1; o < 64; o <<= 1) { const unsigned t = __shfl_up(inc, o); if (lane_ >= o) inc += t; }
        if (lane_ == 63) wsum[F.wave] = inc;
        LDS_WAIT(); __syncthreads();
        unsigned base = 0u, tot = 0u;
#pragma unroll
        for (int w = 0; w < NWAVES; ++w) { const unsigned t = wsum[w]; if (w < F.wave) base += t; tot += t; }
        const unsigned ex = base + inc - pk; unsigned pg = ex & 0xffffu, pe = ex >> 16; const unsigned ngt = tot & 0xffffu;
#pragma unroll
        for (int i = 0; i < 4; ++i) { const int sq = 4 * tid_ + i; int slot = -1;
            if (k[i] > prefix) { slot = (int)pg; ++pg; } else if (k[i] == prefix) { if (pe < need) slot = (int)(ngt + pe); ++pe; }
            if (slot >= 0) { selrow[(e * BATCH + b) * CAP + slot] = b * SEQ + sq; gate[(e * BATCH + b) * CAP + slot] = __uint_as_float(k[i]); }
            inv[(size_t)(b * SEQ + sq) * NE + e] = slot; }
        LDS_WAIT(); __syncthreads();
    }
}
__device__ __forceinline__ void combine_phase(Frame& F, bf16* x, float* xout, const unsigned char* Y, const int* inv, const float* gain, unsigned char* H8, bool with_norm) {
    int lane_ = F.lane, tid_ = F.tid; asm volatile("" : "+v"(lane_), "+v"(tid_));
    const int gw = F.vcu * NWAVES + F.wave, NGW = F.G * NWAVES;
    f32x4 gv[4];
#pragma unroll
    for (int j = 0; j < 4; ++j) gv[j] = with_norm ? ((const f32x4*)gain)[lane_ + 64 * j] : (f32x4){0.f, 0.f, 0.f, 0.f};
    int m = gw; int niv = -1; v2u nv[4];
    if (m < NTOK) { niv = inv[(size_t)m * NE + (lane_ & 15)];
#pragma unroll
        for (int j = 0; j < 4; ++j) nv[j] = ((const GAS v2u*)(x + (size_t)m * DM) + lane_)[64 * j]; }
    for (; m < NTOK; m += NGW) {
        const int b = m >> 11, iv = niv, mn = m + NGW;
        f32x4 v[4];
#pragma unroll
        for (int j = 0; j < 4; ++j) { const v2u w_ = nv[j]; v[j] = (f32x4){bf_lo(w_.x), bf_hi(w_.x), bf_lo(w_.y), bf_hi(w_.y)}; }
        if (mn < NTOK) { niv = inv[(size_t)mn * NE + (lane_ & 15)];
#pragma unroll
            for (int j = 0; j < 4; ++j) nv[j] = ((const GAS v2u*)(x + (size_t)mn * DM) + lane_)[64 * j]; }
        unsigned mask = (unsigned)(__builtin_amdgcn_ballot_w64(iv >= 0) & 0xffffull);
        while (mask) {
            const int e0 = __builtin_ctz(mask); mask &= mask - 1; const bool two = mask != 0u; const int e1 = two ? __builtin_ctz(mask) : e0; if (two) mask &= mask - 1;
            const int s0 = __builtin_amdgcn_readlane(iv, e0), s1 = __builtin_amdgcn_readlane(iv, e1);
            const GAS unsigned* y0 = (const GAS unsigned*)(Y + ((size_t)((e0 * BATCH + b) * CAP + s0)) * DM) + lane_; const GAS unsigned* y1 = (const GAS unsigned*)(Y + ((size_t)((e1 * BATCH + b) * CAP + s1)) * DM) + lane_;
            unsigned w0[4], w1[4];
#pragma unroll
            for (int j = 0; j < 4; ++j) w0[j] = y0[64 * j];
            if (two) {
#pragma unroll
                for (int j = 0; j < 4; ++j) w1[j] = y1[64 * j]; }
#pragma unroll
            for (int j = 0; j < 4; ++j) { const auto lo = __builtin_amdgcn_cvt_pk_f32_fp8((int)w0[j], false), hi = __builtin_amdgcn_cvt_pk_f32_fp8((int)w0[j], true);
                v[j].x += lo[0] * 0.0625f; v[j].y += lo[1] * 0.0625f; v[j].z += hi[0] * 0.0625f; v[j].w += hi[1] * 0.0625f; }
            if (two) {
#pragma unroll
                for (int j = 0; j < 4; ++j) { const auto lo = __builtin_amdgcn_cvt_pk_f32_fp8((int)w1[j], false), hi = __builtin_amdgcn_cvt_pk_f32_fp8((int)w1[j], true);
                    v[j].x += lo[0] * 0.0625f; v[j].y += lo[1] * 0.0625f; v[j].z += hi[0] * 0.0625f; v[j].w += hi[1] * 0.0625f; } }
        }
        float s = 0.f;
#pragma unroll
        for (int j = 0; j < 4; ++j) { if (with_norm) { v2u w_; w_.x = pk2(v[j].x, v[j].y); w_.y = pk2(v[j].z, v[j].w); ((GAS v2u*)(x + (size_t)m * DM) + lane_)[64 * j] = w_; v[j] = (f32x4){bf_lo(w_.x), bf_hi(w_.x), bf_lo(w_.y), bf_hi(w_.y)}; }
            else ((GAS f32x4*)(xout + (size_t)m * DM) + lane_)[64 * j] = v[j];
            s += (v[j].x * v[j].x + v[j].y * v[j].y) + (v[j].z * v[j].z + v[j].w * v[j].w); }
        if (with_norm) { const float r = rsqrtf(wave_sum(s) * (1.f / DM) + RMS_EPS); GAS unsigned* o4 = (GAS unsigned*)(H8 + (size_t)m * DM) + lane_;
#pragma unroll
            for (int j = 0; j < 4; ++j) { const f32x4 o = v[j] * r * gv[j]; o4[64 * j] = pk4_fp8(o.x, o.y, o.z, o.w); } }
    }
}

__device__ __forceinline__ void na_phase(Frame& F, const bf16* QKVp, bf16* Op, const float* rel_bias) {
    typedef short bf16x8 __attribute__((ext_vector_type(8))); typedef short s16x4 __attribute__((ext_vector_type(4)));
    int tid = F.tid; asm volatile("" : "+v"(tid));
    const int lane = tid & 63, wid = F.wave, g = lane >> 4, lq = lane & 15, iq = wid & 3, gq = wid >> 2;
    const int kb0 = iq < 2 ? 0 : 1;
    LAS unsigned char* L = F.lds; const unsigned ldsbase = (unsigned)(uintptr_t)F.lds;
    LAS float* nbt = (LAS float*)(L + NA_BT);
    const int qc = 16 * iq + lq; int cs = qc - 8; cs = cs < 0 ? 0 : (cs > 48 ? 48 : cs);
    const int dkey = 8 * wid + (lane >> 3), dchunk = (lane & 7) ^ (dkey & 7);
    const size_t dsrc = (size_t)dkey * EVEN_IN + dchunk * 8;
    const unsigned kc1 = (unsigned)(kb0 * 2048 + lq * 128 + ((g ^ (lq & 7)) * 16)), kc2 = (unsigned)(kb0 * 2048 + lq * 128 + (((4 + g) ^ (lq & 7)) * 16));
    unsigned vc[4]; { const int q_ = lq >> 2, p_ = lq & 3, keyl = (4 * g + q_) & 7;
#pragma unroll
        for (int dt = 0; dt < 4; ++dt) vc[dt] = (unsigned)(8192 + kb0 * 2048 + g * 512 + q_ * 128 + (((2 * dt + (p_ >> 1)) ^ keyl) * 16) + (p_ & 1) * 8); }
    const int bc = 16 * kb0 + 4 * g - qc + 15;
    float mk[3][4];
#pragma unroll
    for (int kbi = 0; kbi < 3; ++kbi)
#pragma unroll
        for (int rg = 0; rg < 4; ++rg) mk[kbi][rg] = ((unsigned)(16 * (kb0 + kbi) + 4 * g - cs + rg) < 16u) ? 0.f : -1.0e30f;
#define NA_BAR() asm volatile("s_waitcnt vmcnt(0) lgkmcnt(0)\n\ts_barrier" ::: "memory")
#define NA_BAR4() asm volatile("s_waitcnt vmcnt(4) lgkmcnt(0)\n\ts_barrier" ::: "memory")
#define NA_DMA(kr) do { const unsigned sl_ = (unsigned)__builtin_amdgcn_readfirstlane((int)(ldsbase + (unsigned)(((kr) % 9) * NA_SLOT) + (unsigned)wid * 1024u)); \
        attn_body::glds16(Kb + (size_t)(kr) * 64 * EVEN_IN + dsrc, sl_); attn_body::glds16(Vb + (size_t)(kr) * 64 * EVEN_IN + dsrc, sl_ + 8192u); } while (0)
#define NA_CLAMP(x) ((x) < 0 ? 0 : ((x) > 24 ? 24 : (x)))
#define NA_PAIR(pr) do { f32x4 sb[2]; bf16x8 kfr[2][2]; float bia[2][4]; s16x4 va[4][2]; int kcs[2]; \
          \
        _Pragma("unroll") for (int u2 = 0; u2 < 2; ++u2) { const int n = 2 * (pr) + u2, kri = n / 3, kbi = n % 3; const int kr = rs + kri, kb = kb0 + kbi; \
            const unsigned sk = (unsigned)((kr % 9) * NA_SLOT); const int key = 16 * kb + lq; \
            kfr[u2][0] = *(const LAS bf16x8*)(L + ((sk + kc1) + kbi * 2048)); kfr[u2][1] = *(const LAS bf16x8*)(L + ((sk + kc2) + kbi * 2048)); \
            kcs[u2] = 0; const LAS float* bp = nbt + 64 + (((kr - rq + 7) * 31 + bc) + 16 * kbi); \
            _Pragma("unroll") for (int rg = 0; rg < 4; ++rg) bia[u2][rg] = bp[rg]; \
            _Pragma("unroll") for (int dt = 0; dt < 4; ++dt) va[dt][u2] = attn_body::vtr((attn_body::lds_cptr)(L + ((sk + vc[dt]) + kbi * 2048))); } \
        _Pragma("unroll") for (int u2 = 0; u2 < 2; ++u2) { \
            f32x4 sv; _Pragma("unroll") for (int rg = 0; rg < 4; ++rg) sv[rg] = bia[u2][rg] + mk[(2 * (pr) + u2) % 3][rg];     \
            sv = __builtin_amdgcn_mfma_f32_16x16x32_bf16(kfr[u2][0], qf0, sv, 0, 0, 0); sv = __builtin_amdgcn_mfma_f32_16x16x32_bf16(kfr[u2][1], qf1, sv, 0, 0, 0); \
            _Pragma("unroll") for (int rg = 0; rg < 4; ++rg) sv[rg] = __builtin_amdgcn_exp2f(sv[rg]); \
            lsum4 += sv; sb[u2] = sv; } \
        bf16x8 pb; { const unsigned w0 = pg8::cvt_pk_bf16(sb[0][0], sb[0][1]), w1 = pg8::cvt_pk_bf16(sb[0][2], sb[0][3]), w2 = pg8::cvt_pk_bf16(sb[1][0], sb[1][1]), w3 = pg8::cvt_pk_bf16(sb[1][2], sb[1][3]); \
            pb = __builtin_bit_cast(bf16x8, (v4u){w0, w1, w2, w3}); } \
        _Pragma("unroll") for (int dt = 0; dt < 4; ++dt) { \
            const bf16x8 vf = (bf16x8){va[dt][0][0], va[dt][0][1], va[dt][0][2], va[dt][0][3], va[dt][1][0], va[dt][1][1], va[dt][1][2], va[dt][1][3]}; \
            oacc[dt] = __builtin_amdgcn_mfma_f32_16x16x32_bf16(vf, pb, oacc[dt], 0, 0, 0); } } while (0)
    for (int bh = F.vcu; bh < BATCH * 8; bh += F.G) {
        const int b = bh >> 3, h = bh & 7;
        const bf16* Qb = QKVp + (size_t)b * SEQ * EVEN_IN + 64 * h; const bf16* Kb = Qb + 512; const bf16* Vb = Qb + 1024;
        bf16* Ob = attn_body::O_FP8 ? (bf16*)((unsigned char*)Op + (size_t)b * SEQ * DM + 64 * h) : Op + (size_t)b * SEQ * DM + 64 * h;
        NA_BAR();
        if (tid < 465) nbt[64 + tid] = rel_bias[h * 465 + tid] * LOG2E;
#pragma unroll
        for (int kr = 0; kr < 8; ++kr) NA_DMA(kr);
        bf16x8 qn[2];
#pragma unroll
        for (int s2 = 0; s2 < 2; ++s2) qn[s2] = *(const GAS bf16x8*)(Qb + (size_t)(gq * 64 + qc) * EVEN_IN + 32 * s2 + 8 * g);
        NA_BAR();
        for (int t = 0; t < 16; ++t) {
            const int rq = 2 * t + gq, rs = NA_CLAMP(rq - 4);
            const bf16x8 qf0 = qn[0], qf1 = qn[1];
            f32x4 oacc[4]; f32x4 lsum4 = (f32x4){0.f, 0.f, 0.f, 0.f};
#pragma unroll
            for (int dt = 0; dt < 4; ++dt) oacc[dt] = (f32x4){0.f, 0.f, 0.f, 0.f};
            NA_PAIR(0); NA_PAIR(1); NA_PAIR(2);
            NA_BAR4();
            if (t + 1 < 16) { const int hi0 = NA_CLAMP(2 * t + 1 - 4) + 7, hi1 = NA_CLAMP(2 * t + 3 - 4) + 7;
                for (int kr = hi0 + 1; kr <= hi1; ++kr) NA_DMA(kr);
#pragma unroll
                for (int s2 = 0; s2 < 2; ++s2) qn[s2] = *(const GAS bf16x8*)(Qb + (size_t)((rq + 2) * 64 + qc) * EVEN_IN + 32 * s2 + 8 * g); }
            NA_PAIR(3); NA_PAIR(4); NA_PAIR(5); NA_PAIR(6); NA_PAIR(7); NA_PAIR(8); NA_PAIR(9); NA_PAIR(10); NA_PAIR(11);
            float lsum = (lsum4[0] + lsum4[1]) + (lsum4[2] + lsum4[3]); lsum += __shfl_xor(lsum, 16); lsum += __shfl_xor(lsum, 32);
            const float rl = __builtin_amdgcn_rcpf(lsum);
            if (attn_body::O_FP8) { unsigned char* orow8 = (unsigned char*)Ob + (size_t)(rq * 64 + qc) * DM + 4 * g; const float r16 = rl * 16.f;
#pragma unroll
                for (int dt = 0; dt < 4; ++dt) *(GAS unsigned*)(orow8 + 16 * dt) = pk4_fp8(oacc[dt][0] * r16, oacc[dt][1] * r16, oacc[dt][2] * r16, oacc[dt][3] * r16); }
            else { bf16* orow = Ob + (size_t)(rq * 64 + qc) * DM + 4 * g;
#pragma unroll
                for (int dt = 0; dt < 4; ++dt) { v2u ov; ov.x = pk2(oacc[dt][0] * rl, oacc[dt][1] * rl); ov.y = pk2(oacc[dt][2] * rl, oacc[dt][3] * rl); *(GAS v2u*)(orow + 16 * dt) = ov; } }
        }
    }
    NA_BAR();
#undef NA_PAIR
#undef NA_CLAMP
#undef NA_BAR
#undef NA_BAR4
#undef NA_DMA
}

struct Args { const float* in[20]; float* out; unsigned char* ws; };
__global__ void __launch_bounds__(NWAVES * 64, 2) mega_fwd(Args args) {
    extern __shared__ __attribute__((aligned(16))) unsigned char lds[];
    asm volatile("s_setreg_imm32_b32 hwreg(HW_REG_MODE, 23, 1), 1");
    bool sat_bad; { float big = 1000.f, nbig = -3.0e9f; asm volatile("" : "+v"(big), "+v"(nbig)); const int tw = __builtin_amdgcn_cvt_pk_fp8_f32(big, nbig, 0, false); sat_bad = (tw & 0xffff) != 0xfe7e; }
    Frame F;
    F.lds = (LAS unsigned char*)lds;
    volatile LAS unsigned* MISC = (volatile LAS unsigned*)(F.lds + MISC_OFF);
    F.tid = threadIdx.x; F.lane = F.tid & 63; F.wave = __builtin_amdgcn_readfirstlane(F.tid >> 6);
    F.G = gridDim.x; { const int bx = blockIdx.x; F.vcu = (F.G % 8 == 0) ? (bx % 8) * (F.G / 8) + bx / 8 : bx; }
    unsigned char* ws = args.ws;
    gu32* ctl = (gu32*)(ws + WS_CTL);
    for (int u = F.tid; u < (LDS_BYTES - LDSCTL_OFF) / 4; u += NWAVES * 64) ((LAS unsigned*)(F.lds + LDSCTL_OFF))[u] = 0u;
    __syncthreads();
    XcdBarrier bar = xcd_barrier_post((unsigned*)(ctl + CW_BAR), MISC + 8);
#define GRID_BAR() xcd_barrier(bar)
    const float* x_in = args.in[0]; float* xres = args.out; bf16* XB = (bf16*)(ws + WS_XB);
    bf16* Hb = (bf16*)(ws + WS_H); bf16* QKV = (bf16*)(ws + WS_QKV); unsigned char* HID = ws + WS_QKV; unsigned char* Yb = ws + WS_Y; unsigned char* H8 = ws + WS_H8;
    float* tab = (float*)(ws + WS_TAB); float* aff = (float*)(ws + WS_AFF); int* selrow = (int*)(ws + WS_SELROW); float* gate = (float*)(ws + WS_GATE); int* inv = (int*)(ws + WS_INV);

    prep_small_weights(F, args.in[2], args.in[9], args.in[11], args.in[14], ws);
    prep_tables(F, tab);
    norm_rows(F, x_in, args.in[1], H8);
#if PROBE & 2
    norm_rows(F, x_in, args.in[1], H8);
#endif
    GRID_BAR();

    { constexpr int L = 0;
        const int NQ = L == 0 ? EVEN_IN : ODD_IN;
        { pg8::Gemm g{(const bf16*)H8, (const bf16*)(ws + (L == 0 ? WS_WIN0 : WS_WIN1)), DM / 2, nullptr}; pg8::StaticOrder S; S.init(NTOK, NQ, F.G, (int)blockIdx.x);
          if (L == 0) { pg8::EpiQKV<0> E{QKV, NQ, tab, args.in[3], args.in[4], args.in[6], args.in[7], QSCALE};
            pg8::gemm_phase<pg8::EpiQKV<0>, pg8::StaticOrder, true, false, true>(F.lds + RING_OFF, g, S, E); }
          else { pg8::EpiQKV<1> E{QKV, NQ, tab, args.in[12], args.in[13], args.in[12], args.in[13], QSCALE};
            pg8::gemm_phase<pg8::EpiQKV<1>, pg8::StaticOrder, true, false, true>(F.lds + RING_OFF, g, S, E); } }

        GRID_BAR();
#define O_AT(off) (attn_body::O_FP8 ? (attn_body::bf16*)((unsigned char*)Hb + (off)) : (attn_body::bf16*)Hb + (off))
        if (L == 0) {
            const attn_body::lds_fptr btab = (attn_body::lds_fptr)(F.lds + BIAS_OFF) + BIAS_PAD;
            na_phase(F, QKV, Hb, args.in[5]);
            attn_body::i32x8a qnx_ = {0, 0, 0, 0, 0, 0, 0, 0};
            for (int n = F.vcu, ui_ = 0; n < BATCH * 8 * 8; n += F.G, ++ui_) {
                if (ui_ == 2 * (F.vcu & 3)) prep_moe_layer(F, 0, args.in[17], args.in[18], args.in[19], ws);
                const int grp = n >> 5, j = n & 31, b = grp >> 1, kvh = grp & 1, hp = j >> 4, qb = j & 15, hq = kvh * 4 + 2 * hp;
                const int t0 = 2 * qb - 2 < 0 ? 0 : 2 * qb - 2, t1 = 2 * qb + 3 > 31 ? 31 : 2 * qb + 3;
                const attn_body::bf16* base = (const attn_body::bf16*)QKV + (size_t)b * SEQ * EVEN_IN;
                const float* sk_ = args.in[8] + hq; const float sinkl2 = ((F.wave >> 2) ? sk_[1] : sk_[0]) * LOG2E;
                const int n2 = n + F.G; const bool pre = n2 < BATCH * 8 * 8;
                const int grp2 = n2 >> 5, j2 = n2 & 31, b2 = grp2 >> 1, kvh2 = grp2 & 1, hp2 = j2 >> 4, qb2 = j2 & 15, hq2 = kvh2 * 4 + 2 * hp2, t02 = 2 * qb2 - 2 < 0 ? 0 : 2 * qb2 - 2;
                const char* base2 = (const char*)((const attn_body::bf16*)QKV + (size_t)(pre ? b2 : b) * SEQ * EVEN_IN);
                attn_body::attn_unit<1, EVEN_IN, 8>(attn_body::QK_FP8 ? (const attn_body::bf16*)((const char*)base + 3072 + 64 * hq) : base + 1536 + 64 * hq, attn_body::QK_FP8 ? (const attn_body::bf16*)((const char*)base + 4096 + 64 * kvh) : base + 2048 + 64 * kvh,
                                                    attn_body::QK_FP8 ? (const attn_body::bf16*)((const char*)base + 4352 + 64 * kvh) : base + 2176 + 64 * kvh, O_AT((size_t)b * SEQ * DM + 512 + 64 * hq), 128 * qb, t0, t1 - t0 + 1,
                                                    sinkl2, btab, (char*)lds + RING_OFF, ui_ > 0, pre, (const attn_body::bf16*)(base2 + 3072 + 64 * hq2), (const attn_body::bf16*)(base2 + 4096 + 64 * kvh2), 128 * qb2, t02, &qnx_);
            }
        } else {
            const attn_body::lds_fptr btab = (attn_body::lds_fptr)(F.lds + BIAS_OFF) + BIAS_PAD;
            attn_body::i32x8a qnx_ = {0, 0, 0, 0, 0, 0, 0, 0};
            for (int n = F.vcu, ui_ = 0; n < BATCH * 16 * 8; n += F.G, ++ui_) {
                if (ui_ == 4 * (F.vcu & 3)) prep_moe_layer(F, 1, args.in[17], args.in[18], args.in[19], ws);
                const int grp = n >> 5, j = n & 31, b = grp >> 2, kvh = grp & 3, hq = kvh * 4 + (j >> 3), qb = j & 7;
                const attn_body::bf16* base = (const attn_body::bf16*)QKV + (size_t)b * SEQ * ODD_IN;
                const int n2 = n + F.G; const bool pre = n2 < BATCH * 16 * 8;
                const int grp2 = n2 >> 5, j2 = n2 & 31, b2 = grp2 >> 2, kvh2 = grp2 & 3, hq2 = kvh2 * 4 + (j2 >> 3), qb2 = j2 & 7;
                const char* base2 = (const char*)((const attn_body::bf16*)QKV + (size_t)(pre ? b2 : b) * SEQ * ODD_IN);
                attn_body::attn_unit<2, ODD_IN, 8>(attn_body::QK_FP8 ? (const attn_body::bf16*)((const char*)base + 64 * hq) : base + 64 * hq, attn_body::QK_FP8 ? (const attn_body::bf16*)((const char*)base + 2048 + 64 * kvh) : base + 1024 + 64 * kvh, attn_body::QK_FP8 ? (const attn_body::bf16*)((const char*)base + 2560 + 64 * kvh) : base + 1280 + 64 * kvh, O_AT((size_t)b * SEQ * DM + 64 * hq), 256 * qb, 0, 32, 0.f, btab, (char*)lds + RING_OFF,
                                                   ui_ > 0, pre, (const attn_body::bf16*)(base2 + 64 * hq2), (const attn_body::bf16*)(base2 + 2048 + 64 * kvh2), 256 * qb2, 0, &qnx_);
            }
        }

        GRID_BAR();
        { pg8::Gemm g{Hb, (const bf16*)(ws + (L == 0 ? WS_WOUT0 : WS_WOUT1)), DM / 2, nullptr, 0x7b7b7b7b}; pg8::StaticOrder S; S.init(NTOK, DM, F.G, (int)blockIdx.x);
          if (L == 0) { pg8::EpiRes<false> E{(const void*)x_in, XB, DM}; pg8::gemm_phase<pg8::EpiRes<false>, pg8::StaticOrder, true, false, true>(F.lds + RING_OFF, g, S, E); }
          else { pg8::EpiRes<true> E{(const void*)XB, XB, DM}; pg8::gemm_phase<pg8::EpiRes<true>, pg8::StaticOrder, true, false, true>(F.lds + RING_OFF, g, S, E); } }

        GRID_BAR();
        norm_router_phase(F, XB, args.in[15] + L * DM, args.in[16] + (size_t)L * DM * NE, H8, aff);
        GRID_BAR();
        select_phase(F, aff, selrow, gate, inv);


        GRID_BAR();
        { pg8::Gemm g{(const bf16*)H8, (const bf16*)(ws + WS_WGU + (size_t)L * NE * 4096 * DM), DM / 2, selrow}; pg8::StaticOrder S; S.init(NE * BATCH * CAP, 2 * DFF, F.G, (int)blockIdx.x, BATCH, BATCH, 0);
          pg8::EpiGU8 E{HID, DFF};
          pg8::gemm_phase<pg8::EpiGU8, pg8::StaticOrder, true, true, true>(F.lds + RING_OFF, g, S, E); }
        GRID_BAR();
        { pg8::Gemm g{(const bf16*)HID, (const bf16*)(ws + WS_WD + (size_t)L * NE * DM * DFF), DFF / 2, nullptr}; pg8::StaticOrder S; S.init(NE * BATCH * CAP, DM, F.G, (int)blockIdx.x, BATCH, BATCH, 0);
          pg8::EpiY E{Yb, DM, gate};
          pg8::gemm_phase<pg8::EpiY, pg8::StaticOrder, true, false, true>(F.lds + RING_OFF, g, S, E); }
        GRID_BAR();
        combine_phase(F, XB, xres, Yb, inv, args.in[10], H8, L == 0);
        if (L == 0) GRID_BAR();
    }
    if (sat_bad) { GRID_BAR(); if (blockIdx.x == 0 && threadIdx.x == 0) xres[0] = __builtin_nanf("");     }
    { constexpr int L = 1;
        const int NQ = L == 0 ? EVEN_IN : ODD_IN;
        { pg8::Gemm g{(const bf16*)H8, (const bf16*)(ws + (L == 0 ? WS_WIN0 : WS_WIN1)), DM / 2, nullptr}; pg8::StaticOrder S; S.init(NTOK, NQ, F.G, (int)blockIdx.x);
          if (L == 0) { pg8::EpiQKV<0> E{QKV, NQ, tab, args.in[3], args.in[4], args.in[6], args.in[7], QSCALE};
            pg8::gemm_phase<pg8::EpiQKV<0>, pg8::StaticOrder, true, false, true>(F.lds + RING_OFF, g, S, E); }
          else { pg8::EpiQKV<1> E{QKV, NQ, tab, args.in[12], args.in[13], args.in[12], args.in[13], QSCALE};
            pg8::gemm_phase<pg8::EpiQKV<1>, pg8::StaticOrder, true, false, true>(F.lds + RING_OFF, g, S, E); } }

        GRID_BAR();
#define O_AT(off) (attn_body::O_FP8 ? (attn_body::bf16*)((unsigned char*)Hb + (off)) : (attn_body::bf16*)Hb + (off))
        if (L == 0) {
            const attn_body::lds_fptr btab = (attn_body::lds_fptr)(F.lds + BIAS_OFF) + BIAS_PAD;
            na_phase(F, QKV, Hb, args.in[5]);
            attn_body::i32x8a qnx_ = {0, 0, 0, 0, 0, 0, 0, 0};
            for (int n = F.vcu, ui_ = 0; n < BATCH * 8 * 8; n += F.G, ++ui_) {
                if (ui_ == 2 * (F.vcu & 3)) prep_moe_layer(F, 0, args.in[17], args.in[18], args.in[19], ws);
                const int grp = n >> 5, j = n & 31, b = grp >> 1, kvh = grp & 1, hp = j >> 4, qb = j & 15, hq = kvh * 4 + 2 * hp;
                const int t0 = 2 * qb - 2 < 0 ? 0 : 2 * qb - 2, t1 = 2 * qb + 3 > 31 ? 31 : 2 * qb + 3;
                const attn_body::bf16* base = (const attn_body::bf16*)QKV + (size_t)b * SEQ * EVEN_IN;
                const float* sk_ = args.in[8] + hq; const float sinkl2 = ((F.wave >> 2) ? sk_[1] : sk_[0]) * LOG2E;
                const int n2 = n + F.G; const bool pre = n2 < BATCH * 8 * 8;
                const int grp2 = n2 >> 5, j2 = n2 & 31, b2 = grp2 >> 1, kvh2 = grp2 & 1, hp2 = j2 >> 4, qb2 = j2 & 15, hq2 = kvh2 * 4 + 2 * hp2, t02 = 2 * qb2 - 2 < 0 ? 0 : 2 * qb2 - 2;
                const char* base2 = (const char*)((const attn_body::bf16*)QKV + (size_t)(pre ? b2 : b) * SEQ * EVEN_IN);
                attn_body::attn_unit<1, EVEN_IN, 8>(attn_body::QK_FP8 ? (const attn_body::bf16*)((const char*)base + 3072 + 64 * hq) : base + 1536 + 64 * hq, attn_body::QK_FP8 ? (const attn_body::bf16*)((const char*)base + 4096 + 64 * kvh) : base + 2048 + 64 * kvh,
                                                    attn_body::QK_FP8 ? (const attn_body::bf16*)((const char*)base + 4352 + 64 * kvh) : base + 2176 + 64 * kvh, O_AT((size_t)b * SEQ * DM + 512 + 64 * hq), 128 * qb, t0, t1 - t0 + 1,
                                                    sinkl2, btab, (char*)lds + RING_OFF, ui_ > 0, pre, (const attn_body::bf16*)(base2 + 3072 + 64 * hq2), (const attn_body::bf16*)(base2 + 4096 + 64 * kvh2), 128 * qb2, t02, &qnx_);
            }
        } else {
            const attn_body::lds_fptr btab = (attn_body::lds_fptr)(F.lds + BIAS_OFF) + BIAS_PAD;
            attn_body::i32x8a qnx_ = {0, 0, 0, 0, 0, 0, 0, 0};
            for (int n = F.vcu, ui_ = 0; n < BATCH * 16 * 8; n += F.G, ++ui_) {
                if (ui_ == 4 * (F.vcu & 3)) prep_moe_layer(F, 1, args.in[17], args.in[18], args.in[19], ws);
                const int grp = n >> 5, j = n & 31, b = grp >> 2, kvh = grp & 3, hq = kvh * 4 + (j >> 3), qb = j & 7;
                const attn_body::bf16* base = (const attn_body::bf16*)QKV + (size_t)b * SEQ * ODD_IN;
                const int n2 = n + F.G; const bool pre = n2 < BATCH * 16 * 8;
                const int grp2 = n2 >> 5, j2 = n2 & 31, b2 = grp2 >> 2, kvh2 = grp2 & 3, hq2 = kvh2 * 4 + (j2 >> 3), qb2 = j2 & 7;
                const char* base2 = (const char*)((const attn_body::bf16*)QKV + (size_t)(pre ? b2 : b) * SEQ * ODD_IN);
                attn_body::attn_unit<2, ODD_IN, 8>(attn_body::QK_FP8 ? (const attn_body::bf16*)((const char*)base + 64 * hq) : base + 64 * hq, attn_body::QK_FP8 ? (const attn_body::bf16*)((const char*)base + 2048 + 64 * kvh) : base + 1024 + 64 * kvh, attn_body::QK_FP8 ? (const attn_body::bf16*)((const char*)base + 2560 + 64 * kvh) : base + 1280 + 64 * kvh, O_AT((size_t)b * SEQ * DM + 64 * hq), 256 * qb, 0, 32, 0.f, btab, (char*)lds + RING_OFF,
                                                   ui_ > 0, pre, (const attn_body::bf16*)(base2 + 64 * hq2), (const attn_body::bf16*)(base2 + 2048 + 64 * kvh2), 256 * qb2, 0, &qnx_);
            }
        }

        GRID_BAR();
        { pg8::Gemm g{Hb, (const bf16*)(ws + (L == 0 ? WS_WOUT0 : WS_WOUT1)), DM / 2, nullptr, 0x7b7b7b7b}; pg8::StaticOrder S; S.init(NTOK, DM, F.G, (int)blockIdx.x);
          if (L == 0) { pg8::EpiRes<false> E{(const void*)x_in, XB, DM}; pg8::gemm_phase<pg8::EpiRes<false>, pg8::StaticOrder, true, false, true>(F.lds + RING_OFF, g, S, E); }
          else { pg8::EpiRes<true> E{(const void*)XB, XB, DM}; pg8::gemm_phase<pg8::EpiRes<true>, pg8::StaticOrder, true, false, true>(F.lds + RING_OFF, g, S, E); } }

        GRID_BAR();
        norm_router_phase(F, XB, args.in[15] + L * DM, args.in[16] + (size_t)L * DM * NE, H8, aff);
        GRID_BAR();
        select_phase(F, aff, selrow, gate, inv);


        GRID_BAR();
        { pg8::Gemm g{(const bf16*)H8, (const bf16*)(ws + WS_WGU + (size_t)L * NE * 4096 * DM), DM / 2, selrow}; pg8::StaticOrder S; S.init(NE * BATCH * CAP, 2 * DFF, F.G, (int)blockIdx.x, BATCH, BATCH, 0);
          pg8::EpiGU8 E{HID, DFF};
          pg8::gemm_phase<pg8::EpiGU8, pg8::StaticOrder, true, true, true>(F.lds + RING_OFF, g, S, E); }
        GRID_BAR();
        { pg8::Gemm g{(const bf16*)HID, (const bf16*)(ws + WS_WD + (size_t)L * NE * DM * DFF), DFF / 2, nullptr}; pg8::StaticOrder S; S.init(NE * BATCH * CAP, DM, F.G, (int)blockIdx.x, BATCH, BATCH, 0);
          pg8::EpiY E{Yb, DM, gate};
          pg8::gemm_phase<pg8::EpiY, pg8::StaticOrder, true, false, true>(F.lds + RING_OFF, g, S, E); }
        GRID_BAR();
        combine_phase(F, XB, xres, Yb, inv, args.in[10], H8, L == 0);
        if (L == 0) GRID_BAR();
    }
    if (sat_bad) { GRID_BAR(); if (blockIdx.x == 0 && threadIdx.x == 0) xres[0] = __builtin_nanf("");     }
#undef GRID_BAR
}

extern "C" void kernel_launch(void* const* d_in, const int* in_sizes, int n_in, void* d_out, int out_size, void* d_ws, size_t ws_size, hipStream_t stream) {
    static int grid = 0;
    if (grid == 0) {
        if (n_in != 20 || in_sizes[0] != NTOK * DM || out_size != NTOK * DM || ws_size < WS_END) { fprintf(stderr, "kernel_launch: unexpected shapes (n_in %d, in0 %d, out %d, ws %zu); nothing launched\n", n_in, n_in > 0 ? in_sizes[0] : -1, out_size, ws_size); grid = -1; return; }
        int dev = 0, cus = 0, per_cu = 0;
        if (hipGetDevice(&dev) != hipSuccess || hipDeviceGetAttribute(&cus, hipDeviceAttributeMultiprocessorCount, dev) != hipSuccess) { fprintf(stderr, "kernel_launch: device query failed\n"); grid = -1; return; }
        if (hipFuncSetAttribute((const void*)mega_fwd, hipFuncAttributeMaxDynamicSharedMemorySize, LDS_BYTES) != hipSuccess) { fprintf(stderr, "kernel_launch: hipFuncSetAttribute failed\n"); grid = -1; return; }
        if (hipOccupancyMaxActiveBlocksPerMultiprocessor(&per_cu, (const void*)mega_fwd, NWAVES * 64, LDS_BYTES) != hipSuccess || per_cu < 1)
            fprintf(stderr, "kernel_launch: note: occupancy query reports %d workgroups per CU\n", per_cu);
        (void)hipGetLastError();
        grid = cus;
    }
    if (grid < 0) return;
    if (hipMemsetAsync((char*)d_ws + WS_CTL, 0, CTL_ZERO_BYTES, stream) != hipSuccess) { fprintf(stderr, "kernel_launch: memset failed\n"); return; }
    Args a{};
    for (int i = 0; i < 20; ++i) a.in[i] = (const float*)d_in[i];
    a.out = (float*)d_out; a.ws = (unsigned char*)d_ws;
    hipLaunchKernelGGL(mega_fwd, dim3(grid), dim3(NWAVES * 64), LDS_BYTES, stream, a);
    const hipError_t le = hipPeekAtLastError();
    if (le != hipSuccess) fprintf(stderr, "kernel_launch: launch failed: %s\n", hipGetErrorName(le));
}
```

```cpp
#include <hip/hip_runtime.h>
#include <hip/hip_bf16.h>
#include <cstdio>
#include <cstdint>
#include <cmath>
#ifndef PROBE
#define PROBE 0
#endif
namespace pg8 {
#define PG8_LAS __attribute__((address_space(3)))
typedef unsigned short bf16_t;
typedef short bf16x8 __attribute__((ext_vector_type(8)));
typedef float f32x4 __attribute__((ext_vector_type(4)));
typedef unsigned u32x4 __attribute__((ext_vector_type(4)));
typedef int i32x4 __attribute__((ext_vector_type(4)));
typedef int i32x8 __attribute__((ext_vector_type(8)));
typedef unsigned u32x2 __attribute__((ext_vector_type(2)));
constexpr int BM = 256, BK = 64, HALF = 128, HTB = HALF * BK * 2  , STAGE_BYTES = 8 * HTB, NXCD = 8, WGM = 8;

__host__ __device__ __forceinline__ int lds_byte(int r, int c) { const int st = (r >> 4) * 2 + (c >> 5), rr = r & 15, cc = c & 31, ob = rr * 64 + cc * 2; return st * 1024 + (ob ^ (((ob >> 9) & 1) << 5)); }
__host__ __device__ __forceinline__ void stage_rc(int b, int& R, int& C) { const int st = b / 1024, sb = b % 1024, swz = sb ^ (((sb >> 9) & 1) << 5); R = (st >> 1) * 16 + swz / 64; C = (st & 1) * 32 + (swz % 64) / 2; }
__host__ __device__ __forceinline__ int perm32(int rho) { const int n = rho >> 4, i = rho & 15; return 8 * (i >> 2) + 4 * n + (i & 3); }

struct Unit { int pm, pn, bt, am; };
struct Gemm { const bf16_t* A; const bf16_t* Bt; int K; const int* gidx; int scx = 0x7f7f7f7f; };

struct StaticOrder {
    int nM, nN, nwg, G, c, ediv, amul, aoff, rev;
    __device__ void init(int M, int N, int G_, int c_, int ediv_ = (1 << 30), int amul_ = 0, int aoff_ = 0, int rev_ = 0) { nM = M / BM; nN = N / BM; nwg = nM * nN; G = G_; c = c_; ediv = ediv_; amul = amul_; aoff = aoff_; rev = rev_; }
    __device__ bool next(int i, Unit& u) const {
        const long L = (long)i * G + c; if (L >= nwg) return false;
        int wgid = (int)L; { const int q = nwg / NXCD, r = nwg % NXCD, xcd = wgid % NXCD, off = wgid / NXCD; wgid = (xcd < r ? xcd * (q + 1) : r * (q + 1) + (xcd - r) * q) + off; }
        const int nig = WGM * nN, gid = wgid / nig, fm = gid * WGM, gsz = (nM - fm) < WGM ? (nM - fm) : WGM;
        u.pm = fm + ((wgid % nig) % gsz); u.pn = (wgid % nig) / gsz; if (rev) u.pm = nM - 1 - u.pm;
        const int e = u.pm / ediv, bl = u.pm - e * ediv; u.bt = e * nN + u.pn; u.am = e * amul + aoff + bl;
        return true;
    }
};

__device__ __forceinline__ unsigned cvt_pk_bf16(float lo, float hi) { unsigned r; asm volatile("v_cvt_pk_bf16_f32 %0, %1, %2" : "=v"(r) : "v"(lo), "v"(hi)); return r; }

__device__ __forceinline__ unsigned pk4_fp8(float a, float b, float c, float d) { int w = 0; w = __builtin_amdgcn_cvt_pk_fp8_f32(a, b, w, false); w = __builtin_amdgcn_cvt_pk_fp8_f32(c, d, w, true); return (unsigned)w; }
struct EpiBf16 {
    static constexpr bool PERM = true;
    bf16_t* O; int ldc;
    __device__ __forceinline__ void operator()(const f32x4 (&acc)[2][2][4][2], const Unit& u, int wr, int wc, int fr, int fq) const {
        const int row0 = u.pm * BM + wr * 64 + fr, col0 = u.pn * BM + wc * 32 + 8 * fq;
#pragma unroll
        for (int ai = 0; ai < 2; ++ai)
#pragma unroll
            for (int m = 0; m < 4; ++m) { bf16_t* rowp = O + (size_t)(row0 + ai * HALF + m * 16) * ldc + col0;
#pragma unroll
                for (int bj = 0; bj < 2; ++bj) { const f32x4 v0 = acc[ai][bj][m][0], v1 = acc[ai][bj][m][1];
                    u32x4 w; w.x = cvt_pk_bf16(v0[0], v0[1]); w.y = cvt_pk_bf16(v0[2], v0[3]); w.z = cvt_pk_bf16(v1[0], v1[1]); w.w = cvt_pk_bf16(v1[2], v1[3]);
                    *(u32x4*)(rowp + bj * HALF) = w; } }
    }
};
template <int LAYER> struct EpiQKV {
    static constexpr bool PERM = true;
    bf16_t* O; int ldc; const float* tab; const float* g0; const float* g1; const float* g2; const float* g3; float qscale;
    template <int KIND, bool F8OUT> __device__ __forceinline__ void body(const f32x4 (&acc)[2][2][4][2], const Unit& u, int wr, int wc, int fr, int fq, const float* gp, const float sc, const int f8col = 0) const {
        const int d0 = LAYER == 0 ? 8 * fq : 32 * (fq >> 1) + 8 * (fq & 1), dstep = LAYER == 0 ? 32 : 16;
        const int row0 = u.pm * BM + wr * 64 + fr, col0 = u.pn * BM + wc * 64 + d0;
        f32x4 gv[2][2];
        if (KIND != 0) {
#pragma unroll
            for (int bj = 0; bj < 2; ++bj)
#pragma unroll
                for (int n = 0; n < 2; ++n) gv[bj][n] = *(const f32x4*)(gp + d0 + dstep * bj + 4 * n) * sc;
        }
        u32x4 tq[4][2][2]; u32x4 w[8][2];
#define QKV_LOADT(ch) do { if (KIND == 2) { _Pragma("unroll") for (int r_ = 0; r_ < 2; ++r_) { const int mm_ = (ch) * 2 + r_; const int s_ = (row0 + (mm_ >> 2) * HALF + (mm_ & 3) * 16) & 2047; const unsigned* tcp; \
            if (LAYER == 0) { tcp = (const unsigned*)tab + s_ * 32 + 8 * fq; } else { const int pos_ = (fq >> 1) ? (s_ & 63) : (s_ >> 6); tcp = (const unsigned*)tab + 65536 + pos_ * 16 + 8 * (fq & 1); } \
            _Pragma("unroll") for (int n = 0; n < 2; ++n) tq[ch][r_][n] = *(const u32x4*)(tcp + 4 * n); } } } while (0)
#define QKV_STORE(mm) do { if constexpr (F8OUT) { unsigned char* rowp_ = (unsigned char*)O + (size_t)(row0 + ((mm) >> 2) * HALF + ((mm) & 3) * 16) * (ldc * 2) + f8col + wc * 64 + d0; \
            *(u32x2*)(rowp_) = (u32x2){w[mm][0].x, w[mm][0].y}; *(u32x2*)(rowp_ + dstep) = (u32x2){w[mm][1].x, w[mm][1].y}; } \
        else { bf16_t* rowp_ = O + (size_t)(row0 + ((mm) >> 2) * HALF + ((mm) & 3) * 16) * ldc + col0; *(u32x4*)(rowp_) = w[mm][0]; *(u32x4*)(rowp_ + dstep) = w[mm][1]; } } while (0)
        QKV_LOADT(0); QKV_LOADT(1);
#pragma unroll
        for (int ch = 0; ch < 4; ++ch) {
#pragma unroll
            for (int r_ = 0; r_ < 2; ++r_) { const int mm = ch * 2 + r_, ai = mm >> 2, m = mm & 3;
                f32x4 x[2][2];
#pragma unroll
                for (int bj = 0; bj < 2; ++bj)
#pragma unroll
                    for (int n = 0; n < 2; ++n) x[bj][n] = acc[ai][bj][m][n];
                if (KIND == 0 && F8OUT) {
#pragma unroll
                    for (int bj = 0; bj < 2; ++bj)
#pragma unroll
                        for (int n = 0; n < 2; ++n) x[bj][n] = x[bj][n] * sc;
                }
                if (KIND != 0) {
                    float ss = 0.f;
#pragma unroll
                    for (int bj = 0; bj < 2; ++bj)
#pragma unroll
                        for (int n = 0; n < 2; ++n) ss += (x[bj][n][0] * x[bj][n][0] + x[bj][n][1] * x[bj][n][1]) + (x[bj][n][2] * x[bj][n][2] + x[bj][n][3] * x[bj][n][3]);
                    { auto p16 = __builtin_amdgcn_permlane16_swap(__float_as_uint(ss), __float_as_uint(ss), false, false); ss = __uint_as_float(p16[0]) + __uint_as_float(p16[1]); }
                    { auto p32 = __builtin_amdgcn_permlane32_swap(__float_as_uint(ss), __float_as_uint(ss), false, false); ss = __uint_as_float(p32[0]) + __uint_as_float(p32[1]); }
                    const float rr = __builtin_amdgcn_rsqf(ss * (1.f / 64.f) + 1e-6f);
#pragma unroll
                    for (int bj = 0; bj < 2; ++bj)
#pragma unroll
                        for (int n = 0; n < 2; ++n) x[bj][n] = x[bj][n] * rr * gv[bj][n];
                    if (KIND == 2) {
#pragma unroll
                        for (int n = 0; n < 2; ++n) { const unsigned q0 = tq[ch][r_][n].x, q1 = tq[ch][r_][n].y, q2 = tq[ch][r_][n].z, q3 = tq[ch][r_][n].w;
                            const f32x4 c = (f32x4){__uint_as_float(q0 << 16), __uint_as_float(q1 << 16), __uint_as_float(q2 << 16), __uint_as_float(q3 << 16)};
                            const f32x4 sn = (f32x4){__uint_as_float(q0 & 0xffff0000u), __uint_as_float(q1 & 0xffff0000u), __uint_as_float(q2 & 0xffff0000u), __uint_as_float(q3 & 0xffff0000u)};
                            const f32x4 x1 = x[0][n], x2 = x[1][n];
                            x[0][n] = x1 * c - x2 * sn; x[1][n] = x1 * sn + x2 * c; }
                    }
                }
#pragma unroll
                for (int bj = 0; bj < 2; ++bj) { const f32x4 v0 = x[bj][0], v1 = x[bj][1];
                    if constexpr (F8OUT) { w[mm][bj].x = pk4_fp8(v0[0], v0[1], v0[2], v0[3]); w[mm][bj].y = pk4_fp8(v1[0], v1[1], v1[2], v1[3]); w[mm][bj].z = 0u; w[mm][bj].w = 0u; }
                    else { w[mm][bj].x = cvt_pk_bf16(v0[0], v0[1]); w[mm][bj].y = cvt_pk_bf16(v0[2], v0[3]); w[mm][bj].z = cvt_pk_bf16(v1[0], v1[1]); w[mm][bj].w = cvt_pk_bf16(v1[2], v1[3]); } }
            }
            if (ch == 0) { QKV_LOADT(2); QKV_LOADT(3); }
            QKV_STORE(2 * ch); QKV_STORE(2 * ch + 1);
        }
#undef QKV_LOADT
#undef QKV_STORE
    }
    __device__ __forceinline__ void operator()(const f32x4 (&acc)[2][2][4][2], const Unit& u, int wr, int wc, int fr, int fq) const {
        int kind; const float* gp; float sc = 1.f; int f8col = 0;
        if (LAYER == 0) { const int pn = u.pn;
            if (pn < 2) { kind = 1; gp = g0; sc = qscale; } else if (pn < 4) { kind = 1; gp = g1; } else if (pn < 6) { kind = 0; gp = g0; }
            else if (pn < 8) { kind = 2; gp = g2; sc = qscale * 16.f; f8col = 3072 + (pn - 6) * 256; } else if (wc < 2) { kind = 2; gp = g3; f8col = 4096; } else { kind = 0; gp = g0; sc = 8.f; f8col = 4224; } }
        if (LAYER != 0) { const int pn = u.pn; const bool isq = pn < 4, isk = pn == 4;
            kind = (isq || isk) ? 2 : 0; gp = isk ? g1 : g0; sc = isq ? qscale * 16.f : (isk ? 1.f : 8.f); f8col = isq ? pn * 256 : (isk ? 2048 : 2560); }
        if (kind == 2) body<2, true>(acc, u, wr, wc, fr, fq, gp, sc, f8col);
        else if (LAYER == 0 && kind == 1) body<1, false>(acc, u, wr, wc, fr, fq, gp, sc);
        else if (f8col != 0) body<0, true>(acc, u, wr, wc, fr, fq, gp, sc, f8col);
        else body<0, false>(acc, u, wr, wc, fr, fq, gp, sc);
    }
};
struct EpiGU {
    static constexpr bool PERM = true;
    bf16_t* Hd; int ldh;
    __device__ __forceinline__ void operator()(const f32x4 (&acc)[2][2][4][2], const Unit& u, int wr, int wc, int fr, int fq) const {
        const int row0 = u.pm * BM + wr * 64 + fr, col0 = u.pn * HALF + wc * 32 + 8 * fq;
#pragma unroll
        for (int ai = 0; ai < 2; ++ai)
#pragma unroll
            for (int m = 0; m < 4; ++m) { bf16_t* rowp = Hd + (size_t)(row0 + ai * HALF + m * 16) * ldh + col0; float h[8];
#pragma unroll
                for (int n = 0; n < 2; ++n)
#pragma unroll
                    for (int j = 0; j < 4; ++j) { const float gv = acc[ai][0][m][n][j], uv = acc[ai][1][m][n][j];
                        const float sg = gv * __builtin_amdgcn_rcpf(1.0f + __builtin_amdgcn_exp2f(-1.4426950408889634f * gv)); h[n * 4 + j] = sg * uv; }
                u32x4 w; w.x = cvt_pk_bf16(h[0], h[1]); w.y = cvt_pk_bf16(h[2], h[3]); w.z = cvt_pk_bf16(h[4], h[5]); w.w = cvt_pk_bf16(h[6], h[7]);
                *(u32x4*)rowp = w; }
    }
};
struct EpiGU8 {
    static constexpr bool PERM = true;
    unsigned char* Hd; int ldh;
    __device__ __forceinline__ void operator()(const f32x4 (&acc)[2][2][4][2], const Unit& u, int wr, int wc, int fr, int fq) const {
        const int row0 = u.pm * BM + wr * 64 + fr, col0 = u.pn * HALF + wc * 32 + 8 * fq;
#pragma unroll
        for (int ai = 0; ai < 2; ++ai)
#pragma unroll
            for (int m = 0; m < 4; ++m) { unsigned char* rowp = Hd + (size_t)(row0 + ai * HALF + m * 16) * ldh + col0; float h[8];
#pragma unroll
                for (int n = 0; n < 2; ++n)
#pragma unroll
                    for (int j = 0; j < 4; ++j) { const float gv = acc[ai][0][m][n][j], uv = acc[ai][1][m][n][j];
                        h[n * 4 + j] = (gv * uv) * __builtin_amdgcn_rcpf(1.0f + __builtin_amdgcn_exp2f(gv)); }
                u32x2 w; w.x = pk4_fp8(h[0], h[1], h[2], h[3]); w.y = pk4_fp8(h[4], h[5], h[6], h[7]);
                *(u32x2*)rowp = w; }
    }
};
struct EpiY {
    static constexpr bool PERM = true;
    unsigned char* Y; int ldc; const float* gate;
    __device__ __forceinline__ void operator()(const f32x4 (&acc)[2][2][4][2], const Unit& u, int wr, int wc, int fr, int fq) const {
        const int row0 = u.am * BM + wr * 64 + fr, col0 = u.pn * BM + wc * 32 + 8 * fq;
        float gs[2][4];
#pragma unroll
        for (int ai = 0; ai < 2; ++ai)
#pragma unroll
            for (int m = 0; m < 4; ++m) gs[ai][m] = gate[row0 + ai * HALF + m * 16];
#pragma unroll
        for (int ai = 0; ai < 2; ++ai)
#pragma unroll
            for (int m = 0; m < 4; ++m) { const int row = row0 + ai * HALF + m * 16; const float g16 = gs[ai][m] * 16.0f; unsigned char* rowp = Y + (size_t)row * ldc + col0;
#pragma unroll
                for (int bj = 0; bj < 2; ++bj) { const f32x4 v0 = acc[ai][bj][m][0] * g16, v1 = acc[ai][bj][m][1] * g16;
                    u32x2 w; w.x = pk4_fp8(v0[0], v0[1], v0[2], v0[3]); w.y = pk4_fp8(v1[0], v1[1], v1[2], v1[3]);
                    *(u32x2*)(rowp + bj * HALF) = w; } }
    }
};
template <bool RES_BF16> struct EpiRes {
    static constexpr bool PERM = true;
    const void* res; bf16_t* out; int ldc;
    __device__ __forceinline__ void operator()(const f32x4 (&acc)[2][2][4][2], const Unit& u, int wr, int wc, int fr, int fq) const {
        const int row0 = u.pm * BM + wr * 64 + fr, col0 = u.pn * BM + wc * 32 + 8 * fq;
        if constexpr (RES_BF16) {
            u32x4 w[2][4][2];
#pragma unroll
            for (int ai = 0; ai < 2; ++ai)
#pragma unroll
                for (int m = 0; m < 4; ++m) { const size_t off = (size_t)(row0 + ai * HALF + m * 16) * ldc + col0;
#pragma unroll
                    for (int bj = 0; bj < 2; ++bj) w[ai][m][bj] = *(const u32x4*)((const bf16_t*)res + off + bj * HALF); }
#pragma unroll
            for (int ai = 0; ai < 2; ++ai)
#pragma unroll
                for (int m = 0; m < 4; ++m) { const size_t off = (size_t)(row0 + ai * HALF + m * 16) * ldc + col0;
#pragma unroll
                    for (int bj = 0; bj < 2; ++bj) { const unsigned wx = w[ai][m][bj].x, wy = w[ai][m][bj].y, wz = w[ai][m][bj].z, ww = w[ai][m][bj].w;
                        const f32x4 r0 = (f32x4){__uint_as_float(wx << 16), __uint_as_float(wx & 0xffff0000u), __uint_as_float(wy << 16), __uint_as_float(wy & 0xffff0000u)};
                        const f32x4 r1 = (f32x4){__uint_as_float(wz << 16), __uint_as_float(wz & 0xffff0000u), __uint_as_float(ww << 16), __uint_as_float(ww & 0xffff0000u)};
                        const f32x4 v0 = r0 + acc[ai][bj][m][0], v1 = r1 + acc[ai][bj][m][1];
                        u32x4 o; o.x = cvt_pk_bf16(v0[0], v0[1]); o.y = cvt_pk_bf16(v0[2], v0[3]); o.z = cvt_pk_bf16(v1[0], v1[1]); o.w = cvt_pk_bf16(v1[2], v1[3]);
                        *(u32x4*)(out + off + bj * HALF) = o; } }
        } else {
            f32x4 r[2][4][2][2]; u32x4 o[4][2];
#pragma unroll
            for (int m = 0; m < 4; ++m) { const size_t off = (size_t)(row0 + m * 16) * ldc + col0;
#pragma unroll
                for (int bj = 0; bj < 2; ++bj) { r[0][m][bj][0] = *(const f32x4*)((const float*)res + off + bj * HALF); r[0][m][bj][1] = *(const f32x4*)((const float*)res + off + bj * HALF + 4); } }
#pragma unroll
            for (int m = 0; m < 4; ++m)
#pragma unroll
                for (int bj = 0; bj < 2; ++bj) { const f32x4 v0 = r[0][m][bj][0] + acc[0][bj][m][0], v1 = r[0][m][bj][1] + acc[0][bj][m][1];
                    o[m][bj].x = cvt_pk_bf16(v0[0], v0[1]); o[m][bj].y = cvt_pk_bf16(v0[2], v0[3]); o[m][bj].z = cvt_pk_bf16(v1[0], v1[1]); o[m][bj].w = cvt_pk_bf16(v1[2], v1[3]); }
#pragma unroll
            for (int m = 0; m < 4; ++m) { const size_t off = (size_t)(row0 + HALF + m * 16) * ldc + col0;
#pragma unroll
                for (int bj = 0; bj < 2; ++bj) { r[1][m][bj][0] = *(const f32x4*)((const float*)res + off + bj * HALF); r[1][m][bj][1] = *(const f32x4*)((const float*)res + off + bj * HALF + 4); } }
#pragma unroll
            for (int m = 0; m < 4; ++m) { const size_t off = (size_t)(row0 + m * 16) * ldc + col0;
#pragma unroll
                for (int bj = 0; bj < 2; ++bj) *(u32x4*)(out + off + bj * HALF) = o[m][bj]; }
#pragma unroll
            for (int m = 0; m < 4; ++m) { const size_t off = (size_t)(row0 + HALF + m * 16) * ldc + col0;
#pragma unroll
                for (int bj = 0; bj < 2; ++bj) { const f32x4 v0 = r[1][m][bj][0] + acc[1][bj][m][0], v1 = r[1][m][bj][1] + acc[1][bj][m][1];
                    u32x4 q; q.x = cvt_pk_bf16(v0[0], v0[1]); q.y = cvt_pk_bf16(v0[2], v0[3]); q.z = cvt_pk_bf16(v1[0], v1[1]); q.w = cvt_pk_bf16(v1[2], v1[3]);
                    *(u32x4*)(out + off + bj * HALF) = q; } }
        }
    }
};

template <class Epi, class Sched, bool ALIGN_EPI, bool GATHER, bool F8 = false>
__device__ __forceinline__ void gemm_phase(PG8_LAS unsigned char* lds, const Gemm g, const Sched& S, const Epi& E) {
    int tid = threadIdx.x; asm volatile("" : "+v"(tid));
    const int wid = __builtin_amdgcn_readfirstlane(tid >> 6), lane = tid & 63, wr = wid >> 2, wc = wid & 3, fr = lane & 15, fq = lane >> 4;
    const int K = g.K, nt = K / BK;
    unsigned voffA[2], voffB[2], gC[2]; int gR[2];
#pragma unroll
    for (int i = 0; i < 2; ++i) { int R, C; stage_rc(tid * 16 + i * 8192, R, C); const int Rb = Epi::PERM ? ((R & ~31) + perm32(R & 31)) : R;
        voffA[i] = (unsigned)(R * K + C) * 2u; voffB[i] = (unsigned)(Rb * K + C) * 2u; gR[i] = R; gC[i] = (unsigned)C * 2u; }
    const size_t kstep = (size_t)(BK * 2);
    const size_t hstep = (size_t)HALF * K * 2;
    const size_t tstep = 2 * hstep;
    const unsigned K2 = (unsigned)K * 2u;
    const unsigned ldsw = (unsigned)wid * 1024u;
    const unsigned ldsbase = (unsigned)__builtin_amdgcn_readfirstlane((int)((unsigned)(uintptr_t)lds + ldsw));
    const int aoff = lds_byte(wr * 64 + fr, fq * 8), boff = lds_byte(wc * 32 + fr, fq * 8);
#define PG8_SA(b, h) (((b) * 2 + (h)) * HTB)
#define PG8_SB(b, h) ((4 + (b) * 2 + (h)) * HTB)
#define PG8_STAGE(bufoff, gbase, voff) do { _Pragma("unroll") for (int _i = 0; _i < 2; ++_i) \
        asm volatile("s_mov_b32 m0, %2\n\ts_nop 0\n\tglobal_load_lds_dwordx4 %0, %1" :: "v"((voff)[_i]), "s"((const char*)(gbase)), "s"(ldsbase + (unsigned)((bufoff) + _i * 8192)) : "memory", "m0"); } while (0)
#define PG8_STAGE_A(bufoff, kptr, h, VG) do { if constexpr (GATHER) { PG8_STAGE(bufoff, kptr, (VG)[h]); } else { PG8_STAGE(bufoff, (kptr) + (h) * hstep, voffA); } } while (0)
#define PG8_LD8(p) __builtin_shufflevector(*(const PG8_LAS i32x4*)(p), *(const PG8_LAS i32x4*)((p) + 1024), 0, 1, 2, 3, 4, 5, 6, 7)
#define PG8_LDA(dst, b, h) do { if constexpr (F8) { _Pragma("unroll") for (int m = 0; m < 4; ++m) dst##8[m] = PG8_LD8(lds + PG8_SA(b, h) + aoff + m * 2048); } \
        else { _Pragma("unroll") for (int m = 0; m < 4; ++m) _Pragma("unroll") for (int k = 0; k < 2; ++k) dst[m][k] = *(const PG8_LAS bf16x8*)(lds + PG8_SA(b, h) + aoff + m * 2048 + k * 1024); } } while (0)
#define PG8_LDB(dst, b, h) do { if constexpr (F8) { _Pragma("unroll") for (int n = 0; n < 2; ++n) dst##8[n] = PG8_LD8(lds + PG8_SB(b, h) + boff + n * 2048); } \
        else { _Pragma("unroll") for (int n = 0; n < 2; ++n) _Pragma("unroll") for (int k = 0; k < 2; ++k) dst[n][k] = *(const PG8_LAS bf16x8*)(lds + PG8_SB(b, h) + boff + n * 2048 + k * 1024); } } while (0)
#define PG8_MMA(ai, bj, At, Bt, Z) do { __builtin_amdgcn_s_setprio(1); _Pragma("unroll") for (int m = 0; m < 4; ++m) _Pragma("unroll") for (int n = 0; n < 2; ++n) { \
        if constexpr (F8) { if (Z) asm volatile("v_mfma_scale_f32_16x16x128_f8f6f4 %0, %1, %2, 0, %3, %4 op_sel_hi:[0,0,0]" : "=&v"(acc[ai][bj][m][n]) : "v"(Bt##8[n]), "v"(At##8[m]), "v"(sc_w), "v"(sc_x));   \
            else asm volatile("v_mfma_scale_f32_16x16x128_f8f6f4 %0, %1, %2, %0, %3, %4 op_sel_hi:[0,0,0]" : "+v"(acc[ai][bj][m][n]) : "v"(Bt##8[n]), "v"(At##8[m]), "v"(sc_w), "v"(sc_x)); } \
        else { if (Z) acc[ai][bj][m][n] = (f32x4){0.f, 0.f, 0.f, 0.f}; _Pragma("unroll") for (int k = 0; k < 2; ++k) acc[ai][bj][m][n] = __builtin_amdgcn_mfma_f32_16x16x32_bf16(Bt[n][k], At[m][k], acc[ai][bj][m][n], 0, 0, 0); } } \
        __builtin_amdgcn_s_setprio(0); } while (0)
#define PG8_WAIT_V(n) asm volatile("s_waitcnt vmcnt(" #n ")" ::: "memory")
#define PG8_WAIT_L(n) asm volatile("s_waitcnt lgkmcnt(" #n ")" ::: "memory")
#define PG8_BAR __builtin_amdgcn_s_barrier()
#define PG8_SCHED __builtin_amdgcn_sched_barrier(0)
    Unit cur, nxt; int ui = 0;
    if (!S.next(0, cur)) return;
    f32x4 acc[2][2][4][2];
    bf16x8 At[4][2], B0[2][2], B1[2][2]; i32x8 At8[4], B08[2], B18[2];
    int sc_w = 0x79797979, sc_x = g.scx; if constexpr (F8) asm volatile("" : "+v"(sc_w), "+v"(sc_x));
    unsigned vGc[2][2] = {{0u, 0u}, {0u, 0u}}, vGn[2][2] = {{0u, 0u}, {0u, 0u}};
    if constexpr (GATHER) {
        Unit t1; const bool h1 = S.next(1, t1);
#pragma unroll
        for (int h = 0; h < 2; ++h)
#pragma unroll
            for (int i = 0; i < 2; ++i) { vGc[h][i] = (unsigned)g.gidx[cur.am * BM + h * HALF + gR[i]] * K2 + gC[i];
                vGn[h][i] = h1 ? (unsigned)g.gidx[t1.am * BM + h * HALF + gR[i]] * K2 + gC[i] : vGc[h][i]; }
    }
    const char* cA = GATHER ? (const char*)g.A : (const char*)g.A + (size_t)cur.pm * tstep; const char* cB = (const char*)g.Bt + (size_t)cur.bt * tstep;
    PG8_STAGE(PG8_SB(0, 0), cB, voffB); PG8_STAGE(PG8_SB(0, 1), cB + hstep, voffB); PG8_STAGE_A(PG8_SA(0, 0), cA, 0, vGc); PG8_STAGE_A(PG8_SA(0, 1), cA, 1, vGc);
    if (wr == 1) PG8_BAR;
    PG8_WAIT_V(2); PG8_BAR;
    PG8_STAGE(PG8_SB(1, 0), cB + kstep, voffB); PG8_STAGE_A(PG8_SA(1, 0), cA + kstep, 0, vGc); PG8_STAGE(PG8_SB(1, 1), cB + hstep + kstep, voffB);
    PG8_WAIT_V(6); PG8_BAR;
    for (;;) {
        const bool has_next = S.next(ui + 1, nxt);
        const char* nA = has_next ? (GATHER ? (const char*)g.A : (const char*)g.A + (size_t)nxt.pm * tstep) : cA; const char* nB = has_next ? (const char*)g.Bt + (size_t)nxt.bt * tstep : cB;
#define PG8_ITER(t, Z) do { \
            const bool last = ((t) == nt - 2); \
            const char* a1 = cA + (size_t)((t) + 1) * kstep;                                             \
            const char* a2 = last ? nA : cA + (size_t)((t) + 2) * kstep; const char* b2 = last ? nB : cB + (size_t)((t) + 2) * kstep;     \
            const char* a3 = a2 + kstep; const char* b3 = b2 + kstep;                                \
            unsigned vGs[2][2] = {{0u, 0u}, {0u, 0u}}; \
            if constexpr (GATHER) { const bool usen = last && has_next; \
                _Pragma("unroll") for (int h = 0; h < 2; ++h) _Pragma("unroll") for (int i = 0; i < 2; ++i) vGs[h][i] = usen ? vGn[h][i] : vGc[h][i]; } \
              \
            PG8_LDB(B0, 0, 0); PG8_LDB(B1, 0, 1); PG8_SCHED; PG8_LDA(At, 0, 0); PG8_STAGE_A(PG8_SA(1, 1), a1, 1, vGc); \
            PG8_WAIT_V(8); PG8_WAIT_L(0); PG8_BAR; PG8_MMA(0, 0, At, B0, Z); PG8_MMA(0, 1, At, B1, Z); PG8_BAR; PG8_SCHED; \
              \
            PG8_LDA(At, 0, 1); PG8_STAGE(PG8_SB(0, 0), b2, voffB); PG8_STAGE(PG8_SB(0, 1), b2 + hstep, voffB); PG8_STAGE_A(PG8_SA(0, 0), a2, 0, vGs); \
            PG8_WAIT_V(8); PG8_WAIT_L(0); PG8_BAR; PG8_MMA(1, 0, At, B0, Z); PG8_MMA(1, 1, At, B1, Z); PG8_BAR; PG8_SCHED; \
              \
            PG8_LDB(B0, 1, 0); PG8_LDB(B1, 1, 1); PG8_SCHED; PG8_LDA(At, 1, 0); PG8_STAGE_A(PG8_SA(0, 1), a2, 1, vGs); \
            PG8_WAIT_V(8); PG8_WAIT_L(0); PG8_BAR; PG8_MMA(0, 0, At, B0, false); PG8_MMA(0, 1, At, B1, false); PG8_BAR; PG8_SCHED; \
              \
            PG8_LDA(At, 1, 1); PG8_STAGE(PG8_SB(1, 0), b3, voffB); PG8_STAGE(PG8_SB(1, 1), b3 + hstep, voffB); PG8_STAGE_A(PG8_SA(1, 0), a3, 0, vGs); \
            PG8_WAIT_V(8); PG8_WAIT_L(0); PG8_BAR; PG8_MMA(1, 0, At, B0, false); PG8_MMA(1, 1, At, B1, false); PG8_BAR; PG8_SCHED; } while (0)
        PG8_ITER(0, true);
        for (int t = 2; t < nt; t += 2) PG8_ITER(t, false);
#undef PG8_ITER
        if constexpr (F8) asm volatile("s_nop 15\n\ts_nop 7" ::: "memory");
        if constexpr (ALIGN_EPI) { if (wr == 0) PG8_BAR; }
        int raw[2][2] = {{0, 0}, {0, 0}}; bool has_nn = false;
        if constexpr (GATHER) { Unit nn; has_nn = has_next && S.next(ui + 2, nn);
            if (has_nn) {
#pragma unroll
                for (int h = 0; h < 2; ++h)
#pragma unroll
                    for (int i = 0; i < 2; ++i) raw[h][i] = g.gidx[nn.am * BM + h * HALF + gR[i]]; } }
        E(acc, cur, wr, wc, fr, fq);
        if (!has_next) break;
        if constexpr (GATHER) {
#pragma unroll
            for (int h = 0; h < 2; ++h)
#pragma unroll
                for (int i = 0; i < 2; ++i) { vGc[h][i] = vGn[h][i]; if (has_nn) vGn[h][i] = (unsigned)raw[h][i] * K2 + gC[i]; asm volatile("" : "+v"(vGn[h][i])); } }
        cur = nxt; cA = nA; cB = nB; ++ui;
        if constexpr (ALIGN_EPI) { if (wr == 1) PG8_BAR; }
    }
    PG8_WAIT_V(0);
    if constexpr (!ALIGN_EPI) { if (wr == 0) PG8_BAR; }
    PG8_BAR;
#undef PG8_SA
#undef PG8_SB
#undef PG8_STAGE
#undef PG8_STAGE_A
#undef PG8_LDA
#undef PG8_LDB
#undef PG8_MMA
#undef PG8_WAIT_V
#undef PG8_WAIT_L
#undef PG8_BAR
#undef PG8_SCHED
}
}

namespace attn_body {
using bf16=__hip_bfloat16;
using bf16x8=__attribute__((ext_vector_type(8)))short;
using s16x4=__attribute__((ext_vector_type(4)))short;
using f32x16=__attribute__((ext_vector_type(16)))float;
using u32x4=__attribute__((ext_vector_type(4)))unsigned;
constexpr int D=64,OPITCH=1024;
constexpr int NW=8,QBLK=32,QB=QBLK*NW,KVBLK=64;
__device__ __forceinline__ int crow(int r,int hi){return (r&3)+8*(r>>2)+4*hi;}
#define SBAR() __builtin_amdgcn_sched_barrier(0)
typedef const __attribute__((address_space(3))) float* lds_fptr;
template<int MODE> __device__ __forceinline__ void amask(f32x16&p0,f32x16&p1,int tabs,int q0,int wid,int r32,int hi,lds_fptr btab){
  const float NEG=-INFINITY;
  if(MODE==1){
    const int qw=q0+wid*QBLK,k0=64*tabs;
    if((k0+63-qw<=128)&&(qw+31-k0<=128)) return;
    int base=k0+4*hi-(qw+r32)+128; asm volatile("":"+v"(base));
    #pragma unroll
    for(int r=0;r<16;++r){const int off=(r&3)+8*(r>>2); if((unsigned)(base+off)>256u)p0[r]=NEG; if((unsigned)(base+off+32)>256u)p1[r]=NEG;}
  } else if(MODE==0){
    const int qr=(q0>>6)+(wid>>1),kr=tabs; int rs=qr-4; rs=rs<0?0:(rs>24?24:rs);
    if(kr<rs||kr>=rs+8){
      #pragma unroll
      for(int r=0;r<16;++r){p0[r]=NEG;p1[r]=NEG;}
    } else {
      const int qc=32*(wid&1)+r32; int cs=qc-8; cs=cs<0?0:(cs>48?48:cs);
      int cb=4*hi-cs,tpo=(kr-qr+7)*31+15-qc+4*hi; asm volatile("":"+v"(cb),"+v"(tpo));
      lds_fptr tp=btab+tpo;
      #pragma unroll
      for(int r=0;r<16;++r){const int off=(r&3)+8*(r>>2); const float b0=tp[off],b1=tp[off+32];
        p0[r]=((unsigned)(off+cb)<16u)?p0[r]+b0:NEG; p1[r]=((unsigned)(off+32+cb)<16u)?p1[r]+b1:NEG;}
    }
  }
}
constexpr bool MFREE=true;
constexpr bool ATTN_PRIO_HALF=true;
constexpr bool QK_FP8=true;
using i32x2a=__attribute__((ext_vector_type(2)))int; using i32x4a=__attribute__((ext_vector_type(4)))int; using i32x8a=__attribute__((ext_vector_type(8)))int;
constexpr bool LSUM_MFMA=MFREE;
using f32x4a=__attribute__((ext_vector_type(4)))float;
constexpr bool O_FP8=true;
constexpr int NSLOT=3, SLOTB=8192;
constexpr int LDS_K=0, LDS_V=NSLOT*SLOTB, LDS_WS=2*NSLOT*SLOTB, LDS_OST=LDS_WS+NW*64*4, LDS_BYTES=LDS_OST+NW*4096;
constexpr float C2=0.125f*1.4426950408889634f;
__device__ __forceinline__ void glds16(const void*gsrc,unsigned lds_dst){unsigned keep;
  asm volatile("s_mov_b32 %0, m0\n\ts_mov_b32 m0, %2\n\ts_nop 0\n\tglobal_load_lds_dwordx4 %1, off\n\ts_mov_b32 m0, %0":"=&s"(keep):"v"(gsrc),"s"(lds_dst):"memory");}
__device__ __forceinline__ float max3f(float a,float b,float c){float r;asm("v_max3_f32 %0, %1, %2, %3":"=v"(r):"v"(a),"v"(b),"v"(c));return r;}
__device__ __forceinline__ float max2f(float a,float b){float r;asm("v_max_f32_e32 %0, %1, %2":"=v"(r):"v"(a),"v"(b));return r;}
__device__ __forceinline__ float fadd_s(float a,float b){float r;asm("v_add_f32_e32 %0, %1, %2":"=v"(r):"v"(a),"v"(b));return r;}
__device__ __forceinline__ float fsub_s(float a,float b){float r;asm("v_sub_f32_e32 %0, %1, %2":"=v"(r):"v"(a),"v"(b));return r;}
typedef float f32x2_t __attribute__((ext_vector_type(2))); typedef __bf16 bf16x2_t __attribute__((ext_vector_type(2)));
__device__ __forceinline__ unsigned cvtpk_s(float lo,float hi){f32x2_t v={lo,hi};bf16x2_t b=__builtin_convertvector(v,bf16x2_t);return __builtin_bit_cast(unsigned,b);}
#define WAIT_BAR(N) asm volatile("s_waitcnt vmcnt(" #N ") lgkmcnt(0)\n\ts_barrier":::"memory")

__device__ __forceinline__ void qkt(f32x16&p0,f32x16&p1,const char*Kslot,const bf16x8*qr,const f32x16&negm,int r32,int hi){
  const char*kb=Kslot+hi*1024+r32*16;
  #pragma unroll
  for(int d0=0;d0<4;++d0){
    const bf16x8 b0=*reinterpret_cast<const bf16x8*>(kb+d0*2048);
    const bf16x8 b1=*reinterpret_cast<const bf16x8*>(kb+d0*2048+512);
    if(d0==0){p0=__builtin_amdgcn_mfma_f32_32x32x16_bf16(b0,qr[0],negm,0,0,0);p1=__builtin_amdgcn_mfma_f32_32x32x16_bf16(b1,qr[0],negm,0,0,0);}
    else{p0=__builtin_amdgcn_mfma_f32_32x32x16_bf16(b0,qr[d0],p0,0,0,0);p1=__builtin_amdgcn_mfma_f32_32x32x16_bf16(b1,qr[d0],p1,0,0,0);}}
}
typedef __attribute__((address_space(3))) const char* lds_cptr;
typedef short v4i16_t __attribute__((ext_vector_type(4)));
__device__ __forceinline__ void kload8(bf16x8*kf,lds_cptr kp){
  kf[0]=*(const __attribute__((address_space(3))) bf16x8*)(kp);      kf[1]=*(const __attribute__((address_space(3))) bf16x8*)(kp+512);
  kf[2]=*(const __attribute__((address_space(3))) bf16x8*)(kp+2048); kf[3]=*(const __attribute__((address_space(3))) bf16x8*)(kp+2560);
  kf[4]=*(const __attribute__((address_space(3))) bf16x8*)(kp+4096); kf[5]=*(const __attribute__((address_space(3))) bf16x8*)(kp+4608);
  kf[6]=*(const __attribute__((address_space(3))) bf16x8*)(kp+6144); kf[7]=*(const __attribute__((address_space(3))) bf16x8*)(kp+6656);
}
__device__ __forceinline__ void kload2(bf16x8*kf,lds_cptr kp,int j){ kf[2*j]=*(const __attribute__((address_space(3))) bf16x8*)(kp+j*2048); kf[2*j+1]=*(const __attribute__((address_space(3))) bf16x8*)(kp+j*2048+512); }
__device__ __forceinline__ s16x4 vtr(lds_cptr p){ return __builtin_bit_cast(s16x4,__builtin_amdgcn_ds_read_tr16_b64_v4i16((__attribute__((address_space(3))) v4i16_t*)p)); }
__device__ __forceinline__ float rowmax(const f32x16&p0,const f32x16&p1){
  float a=max3f(p0[0],p0[1],p1[0]),b=max3f(p0[2],p0[3],p1[1]);a=max3f(a,p1[2],p1[3]);
  #pragma unroll
  for(int r=4;r<16;r+=4){a=max3f(a,p0[r],p0[r+1]);b=max3f(b,p0[r+2],p0[r+3]);a=max3f(a,p1[r],p1[r+1]);b=max3f(b,p1[r+2],p1[r+3]);}
  const float m=max2f(a,b);
  auto rr=__builtin_amdgcn_permlane32_swap(__float_as_uint(m),__float_as_uint(m),false,false);
  return max2f(__uint_as_float(rr[0]),__uint_as_float(rr[1]));
}
__device__ __forceinline__ void pv(f32x16*o,int vb,bf16x8 pa0,bf16x8 pa1,bf16x8 pa2,bf16x8 pa3){
  #pragma unroll
  for(int d0=0;d0<2;++d0){s16x4 lo[4],hi[4];
    #pragma unroll
    for(int ks=0;ks<4;++ks){
      asm volatile("ds_read_b64_tr_b16 %0,%1 offset:%c2":"=&v"(lo[ks]):"v"(vb),"i"(d0*4096+ks*1024):"memory");
      asm volatile("ds_read_b64_tr_b16 %0,%1 offset:%c2":"=&v"(hi[ks]):"v"(vb),"i"(d0*4096+ks*1024+512):"memory");}
    asm volatile("s_waitcnt lgkmcnt(0)":::"memory");SBAR();
    #define PK(k) (bf16x8){lo[k][0],lo[k][1],lo[k][2],lo[k][3],hi[k][0],hi[k][1],hi[k][2],hi[k][3]}
    o[d0]=__builtin_amdgcn_mfma_f32_32x32x16_bf16(pa0,PK(0),o[d0],0,0,0);
    o[d0]=__builtin_amdgcn_mfma_f32_32x32x16_bf16(pa1,PK(1),o[d0],0,0,0);
    o[d0]=__builtin_amdgcn_mfma_f32_32x32x16_bf16(pa2,PK(2),o[d0],0,0,0);
    o[d0]=__builtin_amdgcn_mfma_f32_32x32x16_bf16(pa3,PK(3),o[d0],0,0,0);
    #undef PK
  }
}

#ifndef ATTN_STORE16
#define ATTN_STORE16(p,v) (*(u32x4*)(p)=(v))
#endif
template<int MODE,int PITCH,int THRL> __device__ __forceinline__ void attn_unit(const bf16*Qb,const bf16*__restrict__ Kb,const bf16*__restrict__ Vb,bf16*Ob,const int q0,const int t0,const int NT,const float sinkl2,lds_fptr btab,char*shm,
    const bool warm=false,const bool pre=false,const bf16*Qn=nullptr,const bf16*Kn=nullptr,const int q0n=0,const int t0n=0,i32x8a*qnx=nullptr){
  int tid=threadIdx.x; asm volatile("":"+v"(tid)); const int lane=tid&63,r32=lane&31,hi=lane>>5; const int wid=__builtin_amdgcn_readfirstlane(tid>>6);
  constexpr bool QK8=(MODE==2||MODE==1)&&QK_FP8;
  const int wrow=(MODE==1)?(wid&3)*QBLK:wid*QBLK, whead=(MODE==1)?(wid>>2)*D:0;
  const bf16*Qw=Qb+(long)(q0+wrow)*PITCH+whead;
  const bf16*Kh=Kb+(long)t0*KVBLK*PITCH,*Vh=Vb+(long)t0*KVBLK*PITCH;
  const unsigned lds0=(unsigned)(uintptr_t)shm;
  float*wsf=(float*)(shm+LDS_WS)+wid*64;
  const bf16*ksrc=Kh+(long)lane*PITCH+wid*8;
  const char*ksrc8=(const char*)Kb+(long)(t0*KVBLK+lane)*(PITCH*2)+16*(wid&3);
  const bf16*vsrc=Vh+(long)(16*(wid&3)+(lane>>2))*PITCH+(wid>>2)*32+(lane&3)*8;
  const char*vsrc8=(const char*)Vb+(long)(t0*KVBLK+16*(wid&3)+(lane>>2))*(PITCH*2)+16*((lane&3)^((lane>>5)<<1));
  const unsigned kdst=QK8?lds0+LDS_K+(wid&3)*1024:lds0+LDS_K+wid*1024, vdst=QK8?lds0+LDS_V+(wid&3)*1024:lds0+LDS_V+wid*1024;
  #define DMA_K(t,slot) do{ if(QK8){ if(wid<4) glds16(ksrc8+(long)(t)*KVBLK*(PITCH*2),(unsigned)__builtin_amdgcn_readfirstlane(kdst+(slot))); } else glds16(ksrc+(long)(t)*KVBLK*PITCH,(unsigned)__builtin_amdgcn_readfirstlane(kdst+(slot))); }while(0)
  #define DMA_V(t,slot) do{ if(QK8){ if(wid>=4) glds16(vsrc8+(long)(t)*KVBLK*(PITCH*2),(unsigned)__builtin_amdgcn_readfirstlane(vdst+(slot))); } else glds16(vsrc+(long)(t)*KVBLK*PITCH,(unsigned)__builtin_amdgcn_readfirstlane(vdst+(slot))); }while(0)
  const int vb0=(int)(lds0+LDS_V)+((lane>>4)&1)*32+(lane&3)*8+(4*hi+((lane&15)>>2))*64;
  const char*Kbase=shm+LDS_K; bf16x8 kf[8]; i32x8a kf8[2]; i32x8a qr8;
  const lds_cptr shm3=(lds_cptr)shm; const lds_cptr kp0=QK8?shm3+LDS_K+hi*2048+r32*16:shm3+LDS_K+hi*1024+r32*16; const lds_cptr vp0=shm3+LDS_V+((lane>>4)&1)*32+(lane&3)*8+(4*hi+((lane&15)>>2))*64;
  const int k8_=(lane&15)>>1, c8_=lane&1, g8_=(lane>>4)&1, sw8_=(k8_>>2)&1, row8_=(k8_&3)+8*(k8_>>2)+4*hi;
  const lds_cptr vb8a=shm3+LDS_V+row8_*64+((g8_^(sw8_<<1))*16)+8*c8_, vb8b=shm3+LDS_V+row8_*64+(((g8_+2)^(sw8_<<1))*16)+8*c8_;
  i32x8a ones8f; { const int o1=(((lane>>4)&1)==((lane>>3)&1))?0x38383838:0; ones8f=(i32x8a){o1,o1,o1,o1,o1,o1,o1,o1}; asm volatile("":"+v"(ones8f)); }
  if(ATTN_PRIO_HALF && wid>=4) __builtin_amdgcn_s_setprio(1);
  const bool hot=QK8&&warm;
  if(hot){ DMA_V(0,0); } else { DMA_K(0,0);DMA_V(0,0);DMA_K(1,SLOTB); }
  bf16x8 qr[4];
  #pragma unroll
  for(int d0=0;d0<4;++d0)qr[d0]=QK8?bf16x8{}:*reinterpret_cast<const bf16x8*>(&Qw[(long)r32*PITCH+d0*16+hi*8]);
  if(QK8){ if(hot){ qr8=*qnx; } else { const char*qp=(const char*)Qb+(long)(q0+wrow+r32)*(PITCH*2)+whead+32*hi; const i32x4a qa=*(const i32x4a*)qp, qb_=*(const i32x4a*)(qp+16); qr8=__builtin_shufflevector(qa,qb_,0,1,2,3,4,5,6,7); } }
  f32x4a lacc={0.f,0.f,0.f,0.f}; bf16x8 ones8; { const short o1=(short)((((lane>>4)&1)==((lane>>3)&1))?0x3F80:0); ones8=(bf16x8){o1,o1,o1,o1,o1,o1,o1,o1}; asm volatile("":"+v"(ones8)); }
  float mhat=0.f,l_reg=0.f;f32x16 o[2];o[0]=f32x16{};o[1]=f32x16{};f32x16 negm=f32x16{}; if(QK8){ _Pragma("unroll") for(int r=0;r<16;++r) negm[r]=-4.f; } if(MODE==2&&!MFREE) asm volatile("":"+v"(negm));
  const int qrel=wid*QBLK+r32;
  #define CMASK(P0,P1,t) do{ if(MODE!=2) amask<MODE>(P0,P1,t0+(t),q0,(MODE==1)?(wid&3):wid,r32,hi,btab); }while(0)
  bool resc=false;
  #define START(P0,P1) do{ resc=false; if(!MFREE){ const float rm=rowmax(P0,P1); \
      const float dl=__builtin_fmaxf(rm,-64.f); mhat=fadd_s(mhat,dl); \
      _Pragma("unroll") for(int r=0;r<16;++r){P0[r]=fsub_s(P0[r],dl);P1[r]=fsub_s(P1[r],dl);} \
      if(MODE==2){ _Pragma("unroll") for(int r=0;r<16;++r)negm[r]=-mhat; asm volatile("":"+v"(negm)); } } \
    _Pragma("unroll") for(int r=0;r<16;++r)P0[r]=__builtin_amdgcn_exp2f(P0[r]); }while(0)
  #define RESC() do{ if(resc){ asm volatile("s_waitcnt lgkmcnt(0)":::"memory"); \
      _Pragma("unroll") for(int d_=0;d_<2;++d_) _Pragma("unroll") for(int r=0;r<16;++r)o[d_][r]*=wsf[crow(r,hi)]; } }while(0)
  f32x16 pA0,pA1,pB0,pB1;
  int sl_prev=0,sl_cur=0,sl_next=SLOTB;
  #define ROT() do{sl_prev=sl_cur;sl_cur=sl_next;sl_next=(sl_next==(NSLOT-1)*SLOTB)?0:sl_next+SLOTB;}while(0)
  if(!hot){ DMA_K(2,2*SLOTB); }
  if(hot){WAIT_BAR(4);}
  else if(QK8){WAIT_BAR(2);}else{WAIT_BAR(3);}
  #define KLD8(j,base) __builtin_shufflevector(*(const __attribute__((address_space(3))) i32x4a*)((base)+(j)*512),*(const __attribute__((address_space(3))) i32x4a*)((base)+(j)*512+1024),0,1,2,3,4,5,6,7)
  #define MF8(j) __builtin_amdgcn_mfma_scale_f32_32x32x64_f8f6f4(kf8[j],qr8,negm,0,0,0,0x7f7f7f7f,0,0x7b7b7b7b)
  if(QK8){ kf8[0]=KLD8(0,kp0); kf8[1]=KLD8(1,kp0); pA0=MF8(0); pA1=MF8(1); } else qkt(pA0,pA1,Kbase,qr,negm,r32,hi);
  asm volatile("s_nop 15\n\ts_nop 7":"+v"(pA0),"+v"(pA1));CMASK(pA0,pA1,0);
  START(pA0,pA1);
  _Pragma("unroll") for(int r=0;r<16;++r)pA1[r]=__builtin_amdgcn_exp2f(pA1[r]);
  WAIT_BAR(0);
  DMA_K(3,0);DMA_V(1,SLOTB);
  ROT();
  if(QK8){ kf8[0]=KLD8(0,kp0+sl_cur); kf8[1]=KLD8(1,kp0+sl_cur); } else kload8(kf,kp0+sl_cur);
  WAIT_BAR(2);
  s16x4 vlo[8],vhi[8]; u32x4 pw0,pw1,pw2,pw3;
  #define PKW(P,B) cvtpk_s(P[B],P[B+1])
  #define PAF(k) __builtin_bit_cast(bf16x8,pw##k)
  #define VFR(i) (bf16x8){vlo[i][0],vlo[i][1],vlo[i][2],vlo[i][3],vhi[i][0],vhi[i][1],vhi[i][2],vhi[i][3]}
  #define PIN(x) asm volatile("":"+v"(x))
  #define MX3(a,b,c) __builtin_fmaxf(__builtin_fmaxf((a),(b)),(c))
  #define GAPA(MF,A0,A1,A2,A3,W0,W1,PW) do{ MF; if(!LSUM_MFMA){ sacc+=A0; sacc+=A1; sacc+=A2; sacc+=A3; PIN(sacc); } W0; W1; PIN(PW); SBAR(); }while(0)
  #define LMF(k) do{ if(LSUM_MFMA) lacc=__builtin_amdgcn_mfma_f32_16x16x32_bf16(PAF(k),ones8,lacc,0,0,0); }while(0)
  #define QKMF(F8S,B16S) do{ if(QK8){ F8S; } else { B16S; } }while(0)
  #define EX(v) __builtin_amdgcn_exp2f(v)
  #define GAPB(MF,X,B) do{ MF; X[B]=EX(X[B]); X[B+1]=EX(X[B+1]); X[B+2]=EX(X[B+2]); X[B+3]=EX(X[B+3]); PIN(X); SBAR(); }while(0)
  #define VRD(i) do{ vlo[i]=vtr(vp_+(((i)>>2)*4096+((i)&3)*1024)); vhi[i]=vtr(vp_+(((i)>>2)*4096+((i)&3)*1024+512)); }while(0)
  #define KRD(G,j) do{ if(G){ if(QK8){ if((j)<2){ kf8[(j)&1]=KLD8((j)&1,kp0+sl_next); SBAR(); } } else { kload2(kf,kp0+sl_next,j); SBAR(); } } }while(0)
  #define STEP(C0,C1,P0,P1,t,GK,GV,GL) do{ SBAR(); \
    const lds_cptr vp_=vp0+sl_prev; \
    VRD(0); SBAR(); float sacc=LSUM_MFMA?0.f:(P0[0]+P0[1]); \
    GAPA(QKMF(C0=MF8(0), C0=__builtin_amdgcn_mfma_f32_32x32x16_bf16(kf[0],qr[0],negm,0,0,0)), P0[2],P0[3],P0[4],P0[5],     pw0[0]=PKW(P0,0), pw0[1]=PKW(P0,2), pw0); \
    VRD(4); SBAR(); GAPA(QKMF((void)0, C1=__builtin_amdgcn_mfma_f32_32x32x16_bf16(kf[1],qr[0],negm,0,0,0)), P0[6],P0[7],P0[8],P0[9],     pw0[2]=PKW(P0,4), pw0[3]=PKW(P0,6), pw0); \
    VRD(1); SBAR(); GAPA(QKMF((void)0, C0=__builtin_amdgcn_mfma_f32_32x32x16_bf16(kf[2],qr[1],C0,0,0,0)); LMF(0),   P0[10],P0[11],P0[12],P0[13], pw1[0]=PKW(P0,8), pw1[1]=PKW(P0,10), pw1); \
    VRD(5); SBAR(); GAPA(QKMF((void)0, C1=__builtin_amdgcn_mfma_f32_32x32x16_bf16(kf[3],qr[1],C1,0,0,0)),   P0[14],P0[15],P1[0],P1[1],   pw1[2]=PKW(P0,12),pw1[3]=PKW(P0,14), pw1); \
    VRD(2); SBAR(); GAPA(QKMF(C1=MF8(1), C0=__builtin_amdgcn_mfma_f32_32x32x16_bf16(kf[4],qr[2],C0,0,0,0)); LMF(1),   P1[2],P1[3],P1[4],P1[5],     pw2[0]=PKW(P1,0), pw2[1]=PKW(P1,2), pw2); \
    VRD(6); SBAR(); GAPA(QKMF((void)0, C1=__builtin_amdgcn_mfma_f32_32x32x16_bf16(kf[5],qr[2],C1,0,0,0)),   P1[6],P1[7],P1[8],P1[9],     pw2[2]=PKW(P1,4), pw2[3]=PKW(P1,6), pw2); \
    VRD(3); SBAR(); GAPA(QKMF((void)0, C0=__builtin_amdgcn_mfma_f32_32x32x16_bf16(kf[6],qr[3],C0,0,0,0)); LMF(2),   P1[10],P1[11],P1[12],P1[13], pw3[0]=PKW(P1,8), pw3[1]=PKW(P1,10), pw3); \
    VRD(7); SBAR(); GAPA(QKMF((void)0, C1=__builtin_amdgcn_mfma_f32_32x32x16_bf16(kf[7],qr[3],C1,0,0,0)),   P1[14],P1[15],0.f,0.f,       pw3[2]=PKW(P1,12),pw3[3]=PKW(P1,14), pw3); \
    if(!LSUM_MFMA) l_reg+=sacc; \
    if(GK){DMA_K((t)+3,sl_cur);} if(GV){DMA_V((t)+1,sl_next);} \
    CMASK(C0,C1,t); \
    if(MODE!=2&&!MFREE){ _Pragma("unroll") for(int r=0;r<16;++r){C0[r]-=mhat;C1[r]-=mhat;} } \
    if(!MFREE){ float a=MX3(C0[0],C0[1],C1[0]),b=MX3(C0[2],C0[3],C1[1]); a=MX3(a,C1[2],C1[3]); \
      _Pragma("unroll") for(int r=4;r<16;r+=4){a=MX3(a,C0[r],C0[r+1]);b=MX3(b,C0[r+2],C0[r+3]);a=MX3(a,C1[r],C1[r+1]);b=MX3(b,C1[r+2],C1[r+3]);} \
      float rm=__builtin_fmaxf(a,b); { auto rr=__builtin_amdgcn_permlane32_swap(__float_as_uint(rm),__float_as_uint(rm),false,false); rm=__builtin_fmaxf(__uint_as_float(rr[0]),__uint_as_float(rr[1])); } \
      resc=false; \
      if(__builtin_expect(__any(rm>(float)THRL),0)){ const float dl=__builtin_fmaxf(rm,0.f); mhat+=dl; \
        _Pragma("unroll") for(int r=0;r<16;++r){C0[r]-=dl;C1[r]-=dl;} \
        if(MODE==2){ _Pragma("unroll") for(int r=0;r<16;++r)negm[r]=-mhat; asm volatile("":"+v"(negm)); } \
        const float f=__builtin_amdgcn_exp2f(-dl); l_reg*=f; if(hi==0)wsf[r32]=f; resc=true; } } \
    SBAR(); \
    GAPB(o[0]=__builtin_amdgcn_mfma_f32_32x32x16_bf16(PAF(0),VFR(0),o[0],0,0,0); LMF(3), C0,0); \
    GAPB(o[1]=__builtin_amdgcn_mfma_f32_32x32x16_bf16(PAF(0),VFR(4),o[1],0,0,0), C0,4); \
    KRD(GL,0); GAPB(o[0]=__builtin_amdgcn_mfma_f32_32x32x16_bf16(PAF(1),VFR(1),o[0],0,0,0), C0,8); \
    KRD(GL,1); GAPB(o[1]=__builtin_amdgcn_mfma_f32_32x32x16_bf16(PAF(1),VFR(5),o[1],0,0,0), C0,12); \
    KRD(GL,2); GAPB(o[0]=__builtin_amdgcn_mfma_f32_32x32x16_bf16(PAF(2),VFR(2),o[0],0,0,0), C1,0); \
    KRD(GL,3); GAPB(o[1]=__builtin_amdgcn_mfma_f32_32x32x16_bf16(PAF(2),VFR(6),o[1],0,0,0), C1,4); \
    GAPB(o[0]=__builtin_amdgcn_mfma_f32_32x32x16_bf16(PAF(3),VFR(3),o[0],0,0,0), C1,8); \
    GAPB(o[1]=__builtin_amdgcn_mfma_f32_32x32x16_bf16(PAF(3),VFR(7),o[1],0,0,0), C1,12); \
    }while(0)
  i32x2a vr8[2][4]; i32x8a pw8; int sc1_=0x7f7f7f7f, scv_=0x7c7c7c7c, scq_=0x7b7b7b7b; asm volatile("":"+v"(sc1_),"+v"(scv_),"+v"(scq_));
  #define PK4E(P,B) ({ int w_; asm("v_cvt_pk_fp8_f32 %0, %1, %2":"=v"(w_):"v"(P[B]),"v"(P[(B)+1])); asm("v_cvt_pk_fp8_f32 %0, %1, %2 op_sel:[0,0,1]":"+v"(w_):"v"(P[(B)+2]),"v"(P[(B)+3])); w_; })
  #define MF8A(j,CX) asm volatile("v_mfma_scale_f32_32x32x64_f8f6f4 %0, %1, %2, -4.0, %3, %4 op_sel_hi:[0,0,0]":"=&v"(CX):"v"(kf8[j]),"v"(qr8),"v"(sc1_),"v"(scq_))
  #define PK8E(P,B,M) do{ int w0_,w1_; asm("v_cvt_pk_fp8_f32 %0, %2, %3\n\tv_cvt_pk_fp8_f32 %1, %6, %7\n\tv_cvt_pk_fp8_f32 %0, %4, %5 op_sel:[0,0,1]\n\tv_cvt_pk_fp8_f32 %1, %8, %9 op_sel:[0,0,1]":"=&v"(w0_),"=&v"(w1_):"v"(P[B]),"v"(P[(B)+1]),"v"(P[(B)+2]),"v"(P[(B)+3]),"v"(P[(B)+4]),"v"(P[(B)+5]),"v"(P[(B)+6]),"v"(P[(B)+7])); pw8[M]=w0_; pw8[(M)+1]=w1_; }while(0)
  #define VTR8(p) __builtin_amdgcn_ds_read_tr8_b64_v2i32((__attribute__((address_space(3))) i32x2a*)(p))
  #define VB8(b) (i32x8a){vr8[b][0][0],vr8[b][0][1],vr8[b][1][0],vr8[b][1][1],vr8[b][2][0],vr8[b][2][1],vr8[b][3][0],vr8[b][3][1]}
  #define PVMF(b) do{ const i32x8a vb_op_=VB8(b); asm volatile("v_mfma_scale_f32_32x32x64_f8f6f4 %0, %1, %2, %0, %3, %4 op_sel_hi:[0,0,0]":"+v"(o[b]):"v"(pw8),"v"(vb_op_),"v"(sc1_),"v"(scv_)); }while(0)
  #define LMF8() asm volatile("v_mfma_scale_f32_16x16x128_f8f6f4 %0, %1, %2, %0, %3, %3 op_sel_hi:[0,0,0]":"+v"(lacc):"v"(pw8),"v"(ones8f),"v"(sc1_))
  #define G8A(MF,RD,W) do{ RD; SBAR(); MF; W; PIN(pw8); SBAR(); }while(0)
  #define STEP8(C0,C1,P0,P1,t,GK,GV,GL) do{ SBAR(); \
    const lds_cptr va_=vb8a+sl_prev, vb_=vb8b+sl_prev; \
    G8A(MF8A(0,C0), vr8[0][0]=VTR8(va_); vr8[0][1]=VTR8(va_+1024),      PK8E(P0,0,0)); \
    G8A((void)0,   vr8[0][2]=VTR8(va_+2048); vr8[0][3]=VTR8(va_+3072), PK8E(P0,8,2)); \
    G8A(MF8A(1,C1), vr8[1][0]=VTR8(vb_); vr8[1][1]=VTR8(vb_+1024),      PK8E(P1,0,4)); \
    G8A((void)0,   vr8[1][2]=VTR8(vb_+2048); vr8[1][3]=VTR8(vb_+3072), PK8E(P1,8,6)); \
    if(GK){DMA_K((t)+3,sl_cur);} if(GV){DMA_V((t)+1,sl_next);} \
    if(MODE!=2){ asm volatile("s_nop 15\n\ts_nop 15\n\ts_nop 15":"+v"(C0),"+v"(C1)); CMASK(C0,C1,t); }     \
    SBAR(); \
    GAPB(PVMF(0), C0,0); \
    GAPB((void)0, C0,4); \
    KRD(GL,0); GAPB(LMF8(), C0,8); \
    KRD(GL,1); GAPB((void)0, C0,12); \
    GAPB(PVMF(1), C1,0); \
    GAPB((void)0, C1,4); \
    GAPB((void)0, C1,8); \
    GAPB((void)0, C1,12); \
    }while(0)
  #define STEPX(C0,C1,P0,P1,t,GK,GV,GL) do{ if(QK8){ STEP8(C0,C1,P0,P1,t,GK,GV,GL); } else { STEP(C0,C1,P0,P1,t,GK,GV,GL); } }while(0)
  int t=1;
  for(;t+5<NT;t+=2){
    STEPX(pB0,pB1,pA0,pA1,t,true,true,true);     if(QK8){WAIT_BAR(1);}else{WAIT_BAR(2);} RESC(); ROT();
    STEPX(pA0,pA1,pB0,pB1,t+1,true,true,true);   if(QK8){WAIT_BAR(1);}else{WAIT_BAR(2);} RESC(); ROT();
  }
  #define ENDW(tt) do{ if(QK8){ if((tt)+3<NT){WAIT_BAR(1);} else {WAIT_BAR(0);} } else if((tt)+3<NT){WAIT_BAR(2);} else if((tt)+2<NT){WAIT_BAR(1);} else {WAIT_BAR(0);} }while(0)
  for(;t+1<NT;t+=2){
    STEPX(pB0,pB1,pA0,pA1,t,(t+3<NT),(t+1<NT),(t+1<NT));       ENDW(t);   RESC(); ROT();
    STEPX(pA0,pA1,pB0,pB1,t+1,(t+4<NT),(t+2<NT),(t+2<NT));     ENDW(t+1); RESC(); ROT();
  }
  if(QK8&&pre){
    const char*ksn=(const char*)Kn+(long)(t0n*KVBLK+lane)*(PITCH*2)+16*(wid&3);
    if(wid<4){ glds16(ksn,(unsigned)__builtin_amdgcn_readfirstlane(kdst)); glds16(ksn+(long)KVBLK*(PITCH*2),(unsigned)__builtin_amdgcn_readfirstlane(kdst+SLOTB)); glds16(ksn+(long)2*KVBLK*(PITCH*2),(unsigned)__builtin_amdgcn_readfirstlane(kdst+2*SLOTB)); }
    const char*qpn=(const char*)Qn+(long)(q0n+wrow+r32)*(PITCH*2)+whead+32*hi; const i32x4a qa=*(const i32x4a*)qpn, qb_=*(const i32x4a*)(qpn+16); *qnx=__builtin_shufflevector(qa,qb_,0,1,2,3,4,5,6,7); }
  STEPX(pB0,pB1,pA0,pA1,NT-1,false,false,false); RESC();
  { if(!LSUM_MFMA){ float sacc=pB0[0]+pB0[1]; _Pragma("unroll") for(int r=2;r<16;++r)sacc+=pB0[r]; _Pragma("unroll") for(int r=0;r<16;++r)sacc+=pB1[r]; l_reg+=sacc; }
    pw0=(u32x4){PKW(pB0,0),PKW(pB0,2),PKW(pB0,4),PKW(pB0,6)};pw1=(u32x4){PKW(pB0,8),PKW(pB0,10),PKW(pB0,12),PKW(pB0,14)};pw2=(u32x4){PKW(pB1,0),PKW(pB1,2),PKW(pB1,4),PKW(pB1,6)};pw3=(u32x4){PKW(pB1,8),PKW(pB1,10),PKW(pB1,12),PKW(pB1,14)};
    if(QK8){ PK8E(pB0,0,0); PK8E(pB0,8,2); PK8E(pB1,0,4); PK8E(pB1,8,6);
      const lds_cptr va_=vb8a+sl_cur, vb_=vb8b+sl_cur; _Pragma("unroll") for(int q_=0;q_<4;++q_){ vr8[0][q_]=VTR8(va_+q_*1024); vr8[1][q_]=VTR8(vb_+q_*1024); }
      LMF8(); PVMF(0); PVMF(1); asm volatile("s_nop 15\n\ts_nop 7":"+v"(o[0]),"+v"(o[1]),"+v"(lacc)); }
    else { LMF(0); LMF(1); LMF(2); LMF(3);
    SBAR(); pv(o,vb0+sl_cur,PAF(0),PAF(1),PAF(2),PAF(3)); } }
  #undef PKW
  #undef PAF
  #undef VFR
  #undef PIN
  #undef MX3
  #undef GAPA
  #undef MF8A
  #undef STEP8
  #undef STEPX
  #undef G8A
  #undef PK4E
  #undef PK8E
  #undef VTR8
  #undef VB8
  #undef PVMF
  #undef LMF8
  #undef QKMF
  #undef KLD8
  #undef MF8
  #undef LMF
  #undef GAPB
  #undef EX
  #undef VRD
  #undef KRD
  #undef STEP
  #undef ENDW
  if(LSUM_MFMA){ const float sk=(MODE==1)?__builtin_amdgcn_exp2f(sinkl2-(QK8?4.f:mhat)):0.f;
    if((lane&7)==0){ const int qb=((lane>>3)&1)*16+(lane>>4)*4; wsf[32+qb]=lacc[0]+sk; wsf[32+qb+1]=lacc[1]+sk; wsf[32+qb+2]=lacc[2]+sk; wsf[32+qb+3]=lacc[3]+sk; } }
  else{
  {auto rr=__builtin_amdgcn_permlane32_swap(__float_as_uint(l_reg),__float_as_uint(l_reg),false,false);l_reg=__uint_as_float(rr[0])+__uint_as_float(rr[1]);}
  if(MODE==1) l_reg+=__builtin_amdgcn_exp2f(sinkl2-mhat);
  if(hi==0)wsf[32+r32]=l_reg; }
  asm volatile("s_waitcnt lgkmcnt(0)":::"memory");
  float rli[16];
  #pragma unroll
  for(int r=0;r<16;++r)rli[r]=__builtin_amdgcn_rcpf(wsf[32+crow(r,hi)]);
  bf16*Ow=Ob+(long)(q0+wrow)*OPITCH+whead; unsigned char*Ow8=(unsigned char*)Ob+(long)(q0+wrow)*OPITCH+whead;
  if(O_FP8){ unsigned char*stg8=(unsigned char*)(shm+LDS_OST)+wid*4096;
    #pragma unroll
    for(int r=0;r<16;++r){const int orow=crow(r,hi); const float s16=rli[r]*16.f;
      const float a_=__builtin_amdgcn_fmed3f(o[0][r]*s16,-448.f,448.f), b_=__builtin_amdgcn_fmed3f(o[1][r]*s16,-448.f,448.f);
      const unsigned w_=(unsigned)__builtin_amdgcn_cvt_pk_fp8_f32(a_,b_,0,false);
      stg8[orow*64+r32]=(unsigned char)(w_&0xffu); stg8[orow*64+32+r32]=(unsigned char)((w_>>8)&0xffu);}
    asm volatile("s_waitcnt lgkmcnt(0)":::"memory");
    #pragma unroll
    for(int i=0;i<2;++i){const int row=i*16+(lane>>2),ch=lane&3; const u32x4 v=*(const u32x4*)(stg8+row*64+ch*16); ATTN_STORE16(Ow8+(long)row*OPITCH+ch*16,v);} }
  else   { bf16*stg=(bf16*)(shm+LDS_OST)+wid*2048;
    #pragma unroll
    for(int r=0;r<16;++r){const int orow=crow(r,hi);
      #pragma unroll
      for(int d0=0;d0<2;++d0)stg[orow*64+d0*32+r32]=__float2bfloat16(o[d0][r]*rli[r]);}
    asm volatile("s_waitcnt lgkmcnt(0)":::"memory");
    #pragma unroll
    for(int i=0;i<4;++i){const int row=i*8+(lane>>3),ch=lane&7; const u32x4 v=*(const u32x4*)(stg+row*64+ch*8); ATTN_STORE16(Ow+(long)row*OPITCH+ch*8,v);} }
  if(ATTN_PRIO_HALF && wid>=4) __builtin_amdgcn_s_setprio(0);
  asm volatile("s_waitcnt lgkmcnt(0)\n\ts_barrier":::"memory");
  #undef DMA_K
  #undef DMA_V
  #undef CMASK
  #undef START
  #undef RESC
  #undef ROT
}
constexpr int ATTN_LDS_BYTES=LDS_BYTES;
#undef SBAR
#undef WAIT_BAR
}

constexpr int NWAVES = 8;
constexpr int BATCH = 32, SEQ = 2048, DM = 1024, NTOK = BATCH * SEQ;
constexpr int EVEN_IN = 2304, ODD_IN = 1536, NE = 16, CAP = 256, DFF = 2048;
constexpr float RMS_EPS = 1e-6f, LOG2E = 1.4426950408889634f, QSCALE = 0.125f * 1.4426950408889634f;

constexpr size_t MiB = 1u << 20;
constexpr size_t WS_CTL = 0, CTL_ZERO_BYTES = 32768;
constexpr size_t WS_TAB = 1 * MiB;
constexpr size_t WS_WIN0 = 2 * MiB, WS_WOUT0 = 7 * MiB, WS_WIN1 = 9 * MiB, WS_WOUT1 = 12 * MiB;
constexpr size_t WS_SELROW = 14 * MiB, WS_GATE = 14 * MiB + 512 * 1024;
constexpr size_t WS_INV = 15 * MiB;
constexpr size_t WS_AFF = 19 * MiB;
constexpr size_t WS_WGU = 24 * MiB;
constexpr size_t WS_WD = 152 * MiB;
constexpr size_t WS_H = 216 * MiB;
constexpr size_t WS_QKV = 344 * MiB;
constexpr size_t WS_Y = 632 * MiB;
constexpr size_t WS_XB = 760 * MiB;
constexpr size_t WS_H8 = 888 * MiB;
constexpr size_t WS_END = 952 * MiB;
constexpr int CW_BAR = 4096;
constexpr int TAB_COS = 0, TAB_SIN = 65536, TAB_ACOS = 131072, TAB_ASIN = 131072 + 1024;

constexpr int RING_OFF = 0, RING_BYTES = 131072;
constexpr int BIAS_OFF = 86016, BIAS_PAD = 64;
constexpr int LDS_BYTES = 159744;
constexpr int LDSCTL_OFF = LDS_BYTES - 512, MISC_OFF = LDSCTL_OFF + 320;
constexpr int NA_SLOT = 16384, NA_XO = 9 * NA_SLOT, NA_XL = NA_XO + 8192, NA_BT = NA_XL + 1024;
static_assert(NA_BT + 2400 <= LDSCTL_OFF, "mixer A LDS map");
static_assert(MISC_OFF + 128 <= LDS_BYTES && attn_body::ATTN_LDS_BYTES <= BIAS_OFF && BIAS_OFF + 4 * (465 + 2 * BIAS_PAD + 64) <= RING_BYTES, "LDS map");

#define GAS __attribute__((address_space(1)))
#define LAS __attribute__((address_space(3)))
typedef unsigned short bf16;
typedef unsigned v4u __attribute__((ext_vector_type(4)));
typedef unsigned v2u __attribute__((ext_vector_type(2)));
typedef float f32x4 __attribute__((ext_vector_type(4)));
typedef GAS unsigned gu32;
#define RLX_AGENT __ATOMIC_RELAXED, __HIP_MEMORY_SCOPE_AGENT
#define LDS_WAIT() asm volatile("s_waitcnt lgkmcnt(0)" ::: "memory")
__device__ __forceinline__ unsigned f2bf(float f) { unsigned u = __builtin_bit_cast(unsigned, f); return (u + 0x7fffu + ((u >> 16) & 1u)) >> 16; }
__device__ __forceinline__ unsigned pk2(float lo, float hi) { return f2bf(lo) | (f2bf(hi) << 16); }
__device__ __forceinline__ float bf_lo(unsigned w) { return __builtin_bit_cast(float, w << 16); }
__device__ __forceinline__ float bf_hi(unsigned w) { return __builtin_bit_cast(float, w & 0xffff0000u); }

#define XB_TMO      128
#define XB_XCNT(j)  (256  + 64 * (j))
#define XB_XSUB(j)  (1280 + 64 * (j))
#define XB_XGEN(j)  (2304 + 64 * (j))
#define XB_TOP      3328
#define XB_TOPGEN   3392
#define XCD_BAR_WORDS 3456
#define XB_SPIN_CAP (1u << 18)

__device__ __forceinline__ unsigned xb_ld(unsigned* p)              { return __hip_atomic_load(p, __ATOMIC_RELAXED, __HIP_MEMORY_SCOPE_AGENT); }
__device__ __forceinline__ unsigned xb_add(unsigned* p, unsigned v) { return __hip_atomic_fetch_add(p, v, __ATOMIC_RELAXED, __HIP_MEMORY_SCOPE_AGENT); }
__device__ __forceinline__ unsigned xb_xcc_id() { return (unsigned)__builtin_amdgcn_s_getreg((3 << 11) | 20) & 0xFu; }
#define XB_SPIN(cond, bar) do { unsigned _sp = 0; while (cond) { __builtin_amdgcn_s_sleep(1); \
    if ((++_sp & 255u) == 0u) { if (xb_ld(&(bar)[XB_TMO])) break; if (_sp > XB_SPIN_CAP) { atomicAdd(&(bar)[XB_TMO], 1u); break; } } } } while (0)

struct XcdBarrier {
    unsigned* bar; unsigned x;
    volatile LAS unsigned* st;
};

__device__ __forceinline__ XcdBarrier xcd_barrier_post(unsigned* bar, volatile LAS unsigned* st) {
    XcdBarrier b; b.bar = bar; b.x = xb_xcc_id(); b.st = st;
    if (threadIdx.x == 0) (void)xb_add(&bar[XB_XCNT(b.x)], 1u);
    return b;
}
__device__ __forceinline__ void xcd_barrier_complete(unsigned* bar, unsigned x, unsigned& nloc, unsigned& nx) {
    const unsigned G = gridDim.x * gridDim.y * gridDim.z;
    unsigned sum, cnt, mine, sp = 0u;
    for (;;) {
        sum = 0u; cnt = 0u; mine = 0u;
#pragma unroll
        for (unsigned j = 0; j < 16; ++j) { const unsigned c = xb_ld(&bar[XB_XCNT(j)]); sum += c; cnt += (c > 0u) ? 1u : 0u; mine = (j == x) ? c : mine; }
        if (sum == G) break;
        __builtin_amdgcn_s_sleep(1);
        if ((++sp & 255u) == 0u) { if (xb_ld(&bar[XB_TMO])) break; if (sp > XB_SPIN_CAP) { atomicAdd(&bar[XB_TMO], 1u); break; } }
    }
    nloc = mine > 0u ? mine : 1u; nx = cnt > 0u ? cnt : 1u;
}

__device__ __forceinline__ void xcd_barrier(const XcdBarrier& b) {
    asm volatile("s_waitcnt vmcnt(0)" ::: "memory");
    __syncthreads();
    if (threadIdx.x == 0) {
        unsigned* bar = b.bar;
        __builtin_amdgcn_s_waitcnt(0);
        unsigned nloc = b.st[0], nx = b.st[1];
        if (nloc == 0u) { xcd_barrier_complete(bar, b.x, nloc, nx); b.st[0] = nloc; b.st[1] = nx; }
        const unsigned old = xb_add(&bar[XB_XSUB(b.x)], 1u);
        const unsigned gen = old / nloc;
        if (old + 1u == (gen + 1u) * nloc) {
            __builtin_amdgcn_fence(__ATOMIC_RELEASE, "agent");
            asm volatile("s_waitcnt vmcnt(0)" ::: "memory");
            const unsigned og = xb_add(&bar[XB_TOP], 1u);
            const unsigned tg = og / nx;
            if (og + 1u == (tg + 1u) * nx) xb_add(&bar[XB_TOPGEN], 1u);
            else XB_SPIN(xb_ld(&bar[XB_TOPGEN]) == tg, bar);
            __builtin_amdgcn_fence(__ATOMIC_ACQUIRE, "agent");
            xb_add(&bar[XB_XGEN(b.x)], 1u);
            asm volatile("s_waitcnt vmcnt(0)" ::: "memory");
        } else {
            XB_SPIN(xb_ld(&bar[XB_XGEN(b.x)]) == gen, bar);
            __builtin_amdgcn_fence(__ATOMIC_ACQUIRE, "agent");
            asm volatile("s_waitcnt vmcnt(0)" ::: "memory");
        }
    }
    __syncthreads();
}

struct Frame {
    LAS unsigned char* lds;
    int tid, lane, wave;
    int vcu, G;
};

__device__ __forceinline__ float wave_sum(float v) {
#pragma unroll
    for (int o = 1; o < 64; o <<= 1) v += __shfl_xor(v, o);
    return v;
}
__device__ __forceinline__ void transpose_item(const float* W, int K, int N, bf16* WT, int k0, int n0, int drow0, LAS float* scr, int lane, int hi_step = 16) {
#pragma unroll 8
    for (int i = 0; i < 32; ++i) { const int kk = 2 * i + (lane >> 5); scr[kk * 33 + (lane & 31)] = W[(size_t)(k0 + kk) * N + n0 + (lane & 31)]; }
    LDS_WAIT(); asm volatile("" ::: "memory");
    const int c = lane & 7;
#pragma unroll
    for (int j = 0; j < 4; ++j) { const int n = (lane >> 3) + 8 * j; const LAS float* s = scr + (8 * c) * 33 + n;
        v4u o; o.x = pk2(s[0 * 33], s[1 * 33]); o.y = pk2(s[2 * 33], s[3 * 33]); o.z = pk2(s[4 * 33], s[5 * 33]); o.w = pk2(s[6 * 33], s[7 * 33]);
        *(GAS v4u*)(WT + (size_t)(drow0 + (n & 15) + (n >> 4) * hi_step) * K + k0 + 8 * c) = o; }
    LDS_WAIT(); asm volatile("" ::: "memory");
}
__device__ __forceinline__ unsigned pk4_fp8(float a, float b, float c, float d) {
    a = __builtin_amdgcn_fmed3f(a, -448.f, 448.f); b = __builtin_amdgcn_fmed3f(b, -448.f, 448.f); c = __builtin_amdgcn_fmed3f(c, -448.f, 448.f); d = __builtin_amdgcn_fmed3f(d, -448.f, 448.f);
    int w = 0; w = __builtin_amdgcn_cvt_pk_fp8_f32(a, b, w, false); w = __builtin_amdgcn_cvt_pk_fp8_f32(c, d, w, true); return (unsigned)w; }
__device__ __forceinline__ void transpose_item8(const float* W, int K, int N, unsigned char* WT, int k0, int n0, int drow0, LAS float* scr, int lane, int hi_step = 16) {
#pragma unroll 8
    for (int i = 0; i < 32; ++i) { const int kk = 2 * i + (lane >> 5); scr[kk * 33 + (lane & 31)] = W[(size_t)(k0 + kk) * N + n0 + (lane & 31)]; }
    LDS_WAIT(); asm volatile("" ::: "memory");
    const int c = lane & 7;
#pragma unroll
    for (int j = 0; j < 4; ++j) { const int n = (lane >> 3) + 8 * j; const LAS float* s = scr + (8 * c) * 33 + n;
        v2u o; o.x = pk4_fp8(s[0 * 33] * 64.f, s[1 * 33] * 64.f, s[2 * 33] * 64.f, s[3 * 33] * 64.f); o.y = pk4_fp8(s[4 * 33] * 64.f, s[5 * 33] * 64.f, s[6 * 33] * 64.f, s[7 * 33] * 64.f);
        *(GAS v2u*)(WT + (size_t)(drow0 + (n & 15) + (n >> 4) * hi_step) * K + k0 + 8 * c) = o; }
    LDS_WAIT(); asm volatile("" ::: "memory");
}
__device__ __forceinline__ void prep_small_weights(Frame& F, const float* win0, const float* wout0, const float* win1, const float* wout1, unsigned char* ws) {
    int lane_ = F.lane, tid_ = F.tid; asm volatile("" : "+v"(lane_), "+v"(tid_));
    LAS float* scr = (LAS float*)(F.lds + RING_OFF + F.wave * 16384);
    const int gw = F.vcu * NWAVES + F.wave, NGW = F.G * NWAVES;
    constexpr int I0 = 16 * (EVEN_IN / 32), I1 = 16 * (DM / 32), I2 = 16 * (ODD_IN / 32), I3 = 16 * (DM / 32);
    for (int it = gw; it < I0 + I1 + I2 + I3; it += NGW) {
        int r = it; const float* W; bf16* WT; int N;
        if (r < I0) { W = win0; WT = (bf16*)(ws + WS_WIN0); N = EVEN_IN; }
        else if ((r -= I0) < I1) { W = wout0; WT = (bf16*)(ws + WS_WOUT0); N = DM; }
        else if ((r -= I1) < I2) { W = win1; WT = (bf16*)(ws + WS_WIN1); N = ODD_IN; }
        else { r -= I2; W = wout1; WT = (bf16*)(ws + WS_WOUT1); N = DM; }
        const int nblk = N / 32, kb = r / nblk, nb = r % nblk, n0 = 32 * nb;
        if (N == EVEN_IN) transpose_item8(W, DM, N, (unsigned char*)WT, 64 * kb, n0, (n0 & ~255) + 128 * ((n0 >> 5) & 1) + 32 * ((n0 >> 6) & 3), scr, lane_);
        else if (N == ODD_IN) transpose_item8(W, DM, N, (unsigned char*)WT, 64 * kb, n0, (n0 & ~255) + 32 * ((n0 >> 6) & 3) + 16 * ((n0 >> 5) & 1), scr, lane_, 128);
        else transpose_item8(W, DM, N, (unsigned char*)WT, 64 * kb, n0, n0, scr, lane_);
    }
}
__device__ __forceinline__ void xpose8_block(const float* W, int N, unsigned char* WT, int Kb, int k0, int n0, int drow0, int lane, const float sc = 64.f) {
    const int g = lane >> 4, c = lane & 15;
    const GAS f32x4* src = (const GAS f32x4*)(W + (size_t)(k0 + 16 * g) * N + n0 + 4 * c);
    f32x4 v[16];
#pragma unroll
    for (int i = 0; i < 16; ++i) v[i] = __builtin_nontemporal_load(&src[(size_t)i * (N / 4)]);
#pragma unroll
    for (int jn = 0; jn < 4; ++jn) { v4u w;
        w.x = pk4_fp8(v[0][jn] * sc, v[1][jn] * sc, v[2][jn] * sc, v[3][jn] * sc); w.y = pk4_fp8(v[4][jn] * sc, v[5][jn] * sc, v[6][jn] * sc, v[7][jn] * sc);
        w.z = pk4_fp8(v[8][jn] * sc, v[9][jn] * sc, v[10][jn] * sc, v[11][jn] * sc); w.w = pk4_fp8(v[12][jn] * sc, v[13][jn] * sc, v[14][jn] * sc, v[15][jn] * sc);
        *(GAS v4u*)(WT + (size_t)(drow0 + 4 * c + jn) * Kb + k0 + 16 * g) = w; }
}
__device__ __forceinline__ void prep_moe_weights(Frame& F, const float* wg, const float* wu, const float* wd, unsigned char* ws) {
    int lane_ = F.lane; asm volatile("" : "+v"(lane_));
    const int gw = F.vcu * NWAVES + F.wave, NGW = F.G * NWAVES;
    constexpr int IG = (DM / 64) * (DFF / 64), ID = (DFF / 64) * (DM / 64), IE = 2 * IG + ID;
    for (int it = gw; it < 2 * NE * IE; it += NGW) {
        const int e = it / IE; int r = it % IE;
        if (r < 2 * IG) { const int up = r >= IG; r -= up * IG; const int kb = r / (DFF / 64), nb = r % (DFF / 64), n0 = 64 * nb;
            xpose8_block((up ? wu : wg) + (size_t)e * DM * DFF, DFF, ws + WS_WGU + (size_t)e * 4096 * DM, DM, 64 * kb, n0, (n0 >> 7) * 256 + (n0 & 127) + up * 128, lane_, up ? -0.6931471805599453f * 64.f : -1.4426950408889634f * 64.f); }
        else { r -= 2 * IG; const int kb = r / (DM / 64), nb = r % (DM / 64);
            xpose8_block(wd + (size_t)e * DFF * DM, DM, ws + WS_WD + (size_t)e * DM * DFF, DFF, 64 * kb, 64 * nb, 64 * nb, lane_); }
    }
}
__device__ __forceinline__ void prep_moe_layer(Frame& F, const int LY, const float* wg, const float* wu, const float* wd, unsigned char* ws) {
    int lane_ = F.lane; asm volatile("" : "+v"(lane_));
    const int gw = F.vcu * NWAVES + F.wave, NGW = F.G * NWAVES;
    constexpr int IG = (DM / 64) * (DFF / 64), ID = (DFF / 64) * (DM / 64), IE = 2 * IG + ID;
    for (int it = LY * NE * IE + gw; it < (LY + 1) * NE * IE; it += NGW) {
        const int e = it / IE; int r = it % IE;
        if (r < 2 * IG) { const int up = r >= IG; r -= up * IG; const int kb = r / (DFF / 64), nb = r % (DFF / 64), n0 = 64 * nb;
            xpose8_block((up ? wu : wg) + (size_t)e * DM * DFF, DFF, ws + WS_WGU + (size_t)e * 4096 * DM, DM, 64 * kb, n0, (n0 >> 7) * 256 + (n0 & 127) + up * 128, lane_, up ? -0.6931471805599453f * 64.f : -1.4426950408889634f * 64.f); }
        else { r -= 2 * IG; const int kb = r / (DM / 64), nb = r % (DM / 64);
            xpose8_block(wd + (size_t)e * DFF * DM, DM, ws + WS_WD + (size_t)e * DM * DFF, DFF, 64 * kb, 64 * nb, 64 * nb, lane_); }
    }
}
__device__ __forceinline__ void prep_tables(Frame& F, float* tab) {
    int lane_ = F.lane, tid_ = F.tid; asm volatile("" : "+v"(lane_), "+v"(tid_));
    const int gt = F.vcu * (NWAVES * 64) + tid_, NGT = F.G * NWAVES * 64;
    for (int idx = gt; idx < SEQ * 32 + 64 * 16; idx += NGT) {
        if (idx < SEQ * 32) { const int pos = idx >> 5, i = idx & 31; const float inv = powf(10000.0f, -(float)i / 32.0f), ang = (float)pos * inv; ((unsigned*)tab)[idx] = pg8::cvt_pk_bf16(cosf(ang), sinf(ang)); }
        else { const int j = idx - SEQ * 32, pos = j >> 4, i = j & 15; const float inv = powf(10000.0f, -(float)i / 16.0f), ang = (float)pos * inv; ((unsigned*)tab)[65536 + j] = pg8::cvt_pk_bf16(cosf(ang), sinf(ang)); }
    }
}
__device__ __forceinline__ void norm_rows(Frame& F, const float* x, const float* gain, unsigned char* H8) {
    int lane_ = F.lane, tid_ = F.tid; asm volatile("" : "+v"(lane_), "+v"(tid_));
    const int gw = F.vcu * NWAVES + F.wave, NGW = F.G * NWAVES;
    f32x4 gv[4];
#pragma unroll
    for (int j = 0; j < 4; ++j) gv[j] = ((const f32x4*)gain)[lane_ + 64 * j];
    int m0 = 2 * gw; f32x4 nv[2][4];
#pragma unroll
    for (int q = 0; q < 2; ++q)
#pragma unroll
        for (int j = 0; j < 4; ++j) nv[q][j] = m0 < NTOK ? __builtin_nontemporal_load(&((const GAS f32x4*)(x + (size_t)(m0 + q) * DM) + lane_)[64 * j]) : (f32x4){0.f, 0.f, 0.f, 0.f};
    for (; m0 < NTOK; m0 += 2 * NGW) {
        f32x4 v[2][4]; const int mn = m0 + 2 * NGW;
#pragma unroll
        for (int q = 0; q < 2; ++q)
#pragma unroll
            for (int j = 0; j < 4; ++j) v[q][j] = nv[q][j];
        if (mn < NTOK) {
#pragma unroll
            for (int q = 0; q < 2; ++q)
#pragma unroll
                for (int j = 0; j < 4; ++j) nv[q][j] = __builtin_nontemporal_load(&((const GAS f32x4*)(x + (size_t)(mn + q) * DM) + lane_)[64 * j]); }
#pragma unroll
        for (int q = 0; q < 2; ++q) { float s = 0.f;
#pragma unroll
            for (int j = 0; j < 4; ++j) s += (v[q][j].x * v[q][j].x + v[q][j].y * v[q][j].y) + (v[q][j].z * v[q][j].z + v[q][j].w * v[q][j].w);
            const float r = rsqrtf(wave_sum(s) * (1.f / DM) + RMS_EPS);
            GAS unsigned* o4 = (GAS unsigned*)(H8 + (size_t)(m0 + q) * DM) + lane_;
#pragma unroll
            for (int j = 0; j < 4; ++j) { const f32x4 o = v[q][j] * r * gv[j]; o4[64 * j] = pk4_fp8(o.x, o.y, o.z, o.w); } }
    }
}
__device__ __forceinline__ void norm_router_phase(Frame& F, const bf16* x, const float* gain, const float* wr, unsigned char* H8, float* aff) {
    typedef short bf16x8 __attribute__((ext_vector_type(8)));
    int lane_ = F.lane, tid_ = F.tid; asm volatile("" : "+v"(lane_), "+v"(tid_));
    constexpr int WROW = 1032;
    LAS bf16* whi = (LAS bf16*)(F.lds + RING_OFF); LAS bf16* wlo = whi + 16 * WROW; LAS float* gl = (LAS float*)(wlo + 16 * WROW);
    { float wv[32], gk[32];
#pragma unroll
      for (int q = 0; q < 32; ++q) { const int i = tid_ + 512 * q; wv[q] = wr[i]; gk[q] = gain[i >> 4]; }
      const float g0_ = gain[tid_], g1_ = gain[tid_ + 512];
#pragma unroll
      for (int q = 0; q < 32; ++q) { const int i = tid_ + 512 * q, k = i >> 4, e = i & 15; const float w = wv[q] * gk[q]; const unsigned hb = f2bf(w); const float hf = __uint_as_float(hb << 16);
          whi[e * WROW + k] = (bf16)hb; wlo[e * WROW + k] = (bf16)f2bf(w - hf); }
      gl[tid_] = g0_; gl[tid_ + 512] = g1_; }
    LDS_WAIT(); __syncthreads();
    const int gw = F.vcu * NWAVES + F.wave, NGW = F.G * NWAVES, r_ = lane_ & 15, g_ = lane_ >> 4;
    for (int grp = gw; grp < NTOK / 16; grp += NGW) {
        asm volatile("" ::: "memory");
        const int m0 = grp * 16;
        const GAS v4u* xr = (const GAS v4u*)(x + (size_t)(m0 + r_) * DM + 8 * g_);
        v4u xf[32];
#pragma unroll
        for (int s2 = 0; s2 < 32; ++s2) xf[s2] = xr[4 * s2];
        f32x4 acc = (f32x4){0.f, 0.f, 0.f, 0.f}; float ss = 0.f;
#pragma unroll
        for (int s2 = 0; s2 < 32; ++s2) { if ((s2 & 3) == 0) asm volatile("" ::: "memory");     const bf16x8 xa = __builtin_bit_cast(bf16x8, xf[s2]);
            const bf16x8 bh = *(const LAS bf16x8*)(whi + r_ * WROW + 32 * s2 + 8 * g_), bl = *(const LAS bf16x8*)(wlo + r_ * WROW + 32 * s2 + 8 * g_);
            acc = __builtin_amdgcn_mfma_f32_16x16x32_bf16(xa, bh, acc, 0, 0, 0); acc = __builtin_amdgcn_mfma_f32_16x16x32_bf16(xa, bl, acc, 0, 0, 0);
            const v4u w_ = xf[s2]; const unsigned w0 = w_.x, w1 = w_.y, w2 = w_.z, w3 = w_.w;
            const float a0 = bf_lo(w0), a1 = bf_hi(w0), a2 = bf_lo(w1), a3 = bf_hi(w1), a4 = bf_lo(w2), a5 = bf_hi(w2), a6 = bf_lo(w3), a7 = bf_hi(w3);
            ss += ((a0 * a0 + a1 * a1) + (a2 * a2 + a3 * a3)) + ((a4 * a4 + a5 * a5) + (a6 * a6 + a7 * a7)); }
#pragma unroll
        for (int s2 = 0; s2 < 32; ++s2) asm volatile("" : "+v"(xf[s2]));
        ss += __shfl_xor(ss, 16); ss += __shfl_xor(ss, 32);
        const float rr = rsqrtf(ss * (1.f / DM) + RMS_EPS);
        float pe[4], sm[4];
#pragma unroll
        for (int rg = 0; rg < 4; ++rg) { const float lg = acc[rg] * __shfl(rr, 4 * g_ + rg); float mx = lg;
#pragma unroll
            for (int o = 1; o <= 8; o <<= 1) mx = fmaxf(mx, __shfl_xor(mx, o));
            pe[rg] = expf(lg - mx); float su = pe[rg];
#pragma unroll
            for (int o = 1; o <= 8; o <<= 1) su += __shfl_xor(su, o);
            sm[rg] = su; }
        { const int b = m0 >> 11, sq = (m0 & (SEQ - 1)) + 4 * g_;
          *(GAS f32x4*)(aff + ((size_t)(b * NE + r_)) * SEQ + sq) = (f32x4){pe[0] / sm[0], pe[1] / sm[1], pe[2] / sm[2], pe[3] / sm[3]}; }
        GAS v2u* orow = (GAS v2u*)(H8 + (size_t)(m0 + r_) * DM + 8 * g_);
#pragma unroll
        for (int s2 = 0; s2 < 32; ++s2) { if ((s2 & 3) == 0) asm volatile("" ::: "memory"); const v4u w_ = xf[s2]; const unsigned w0 = w_.x, w1 = w_.y, w2 = w_.z, w3 = w_.w;
            const f32x4 g0 = *(const LAS f32x4*)(gl + 32 * s2 + 8 * g_), g1 = *(const LAS f32x4*)(gl + 32 * s2 + 8 * g_ + 4);
            v2u o; o.x = pk4_fp8(bf_lo(w0) * rr * g0.x, bf_hi(w0) * rr * g0.y, bf_lo(w1) * rr * g0.z, bf_hi(w1) * rr * g0.w);
            o.y = pk4_fp8(bf_lo(w2) * rr * g1.x, bf_hi(w2) * rr * g1.y, bf_lo(w3) * rr * g1.z, bf_hi(w3) * rr * g1.w);
            orow[4 * s2] = o; }
    }
    __syncthreads();
}
__device__ __forceinline__ void select_phase(Frame& F, const float* aff, int* selrow, float* gate, int* inv) {
    int lane_ = F.lane, tid_ = F.tid; asm volatile("" : "+v"(lane_), "+v"(tid_));
    LAS unsigned* hist = (LAS unsigned*)(F.lds + RING_OFF);
    LAS unsigned* bc = hist + 256;
    LAS unsigned* wsum = hist + 272;
    for (int u = F.vcu; u < BATCH * NE; u += F.G) {
        const int b = u >> 4, e = u & 15;
        const f32x4 a4 = ((const GAS f32x4*)(aff + (size_t)u * SEQ))[tid_];
        const float a0_ = a4[0], a1_ = a4[1], a2_ = a4[2], a3_ = a4[3];
        unsigned k[4] = {__float_as_uint(a0_), __float_as_uint(a1_), __float_as_uint(a2_), __float_as_uint(a3_)};
        unsigned prefix = 0u, need = CAP;
#pragma unroll
        for (int pass = 0; pass < 4; ++pass) { const int shift = 24 - 8 * pass;
            if (tid_ < 256) hist[tid_] = 0u;
            LDS_WAIT(); __syncthreads();
#pragma unroll
            for (int i = 0; i < 4; ++i) if (pass == 0 || (k[i] >> (shift + 8)) == prefix) __hip_atomic_fetch_add(&hist[(k[i] >> shift) & 255u], 1u, __ATOMIC_RELAXED, __HIP_MEMORY_SCOPE_WORKGROUP);
            LDS_WAIT(); __syncthreads();
            if (F.wave == 0) { unsigned c[4];
#pragma unroll
                for (int i = 0; i < 4; ++i) c[i] = hist[4 * lane_ + i];
                const unsigned sl = (c[0] + c[1]) + (c[2] + c[3]); unsigned suf = sl;
#pragma unroll
                for (int o = 1; o < 64; o <<= 1) { const unsigned t = __shfl_down(suf, o); if (lane_ + o < 64) suf += t; }
                unsigned run = suf - sl;
#pragma unroll
                for (int bi = 3; bi >= 0; --bi) { if (run < need && need <= run + c[bi]) { bc[0] = (prefix << 8) | (unsigned)(4 * lane_ + bi); bc[1] = need - run; } run += c[bi]; }
            }
            LDS_WAIT(); __syncthreads();
            prefix = bc[0]; need = bc[1];
        }
        unsigned cg = 0u, ce = 0u;
#pragma unroll
        for (int i = 0; i < 4; ++i) { cg += (k[i] > prefix) ? 1u : 0u; ce += (k[i] == prefix) ? 1u : 0u; }
        unsigned pk = cg | (ce << 16), inc = pk;
#pragma unroll
        for (int o = 1; o < 64; o <<= 1) { const unsigned t = __shfl_up(inc, o); if (lane_ >= o) inc += t; }
        if (lane_ == 63) wsum[F.wave] = inc;
        LDS_WAIT(); __syncthreads();
        unsigned base = 0u, tot = 0u;
#pragma unroll
        for (int w = 0; w < NWAVES; ++w) { const unsigned t = wsum[w]; if (w < F.wave) base += t; tot += t; }
        const unsigned ex = base + inc - pk; unsigned pg = ex & 0xffffu, pe = ex >> 16; const unsigned ngt = tot & 0xffffu;
#pragma unroll
        for (int i = 0; i < 4; ++i) { const int sq = 4 * tid_ + i; int slot = -1;
            if (k[i] > prefix) { slot = (int)pg; ++pg; } else if (k[i] == prefix) { if (pe < need) slot = (int)(ngt + pe); ++pe; }
            if (slot >= 0) { selrow[(e * BATCH + b) * CAP + slot] = b * SEQ + sq; gate[(e * BATCH + b) * CAP + slot] = __uint_as_float(k[i]); }
            inv[(size_t)(b * SEQ + sq) * NE + e] = slot; }
        LDS_WAIT(); __syncthreads();
    }
}
__device__ __forceinline__ void combine_phase(Frame& F, bf16* x, float* xout, const unsigned char* Y, const int* inv, const float* gain, unsigned char* H8, bool with_norm) {
    int lane_ = F.lane, tid_ = F.tid; asm volatile("" : "+v"(lane_), "+v"(tid_));
    const int gw = F.vcu * NWAVES + F.wave, NGW = F.G * NWAVES;
    f32x4 gv[4];
#pragma unroll
    for (int j = 0; j < 4; ++j) gv[j] = with_norm ? ((const f32x4*)gain)[lane_ + 64 * j] : (f32x4){0.f, 0.f, 0.f, 0.f};
    int m = gw; int niv = -1; v2u nv[4];
    if (m < NTOK) { niv = inv[(size_t)m * NE + (lane_ & 15)];
#pragma unroll
        for (int j = 0; j < 4; ++j) nv[j] = ((const GAS v2u*)(x + (size_t)m * DM) + lane_)[64 * j]; }
    for (; m < NTOK; m += NGW) {
        const int b = m >> 11, iv = niv, mn = m + NGW;
        f32x4 v[4];
#pragma unroll
        for (int j = 0; j < 4; ++j) { const v2u w_ = nv[j]; v[j] = (f32x4){bf_lo(w_.x), bf_hi(w_.x), bf_lo(w_.y), bf_hi(w_.y)}; }
        if (mn < NTOK) { niv = inv[(size_t)mn * NE + (lane_ & 15)];
#pragma unroll
            for (int j = 0; j < 4; ++j) nv[j] = ((const GAS v2u*)(x + (size_t)mn * DM) + lane_)[64 * j]; }
        unsigned mask = (unsigned)(__builtin_amdgcn_ballot_w64(iv >= 0) & 0xffffull);
        while (mask) {
            const int e0 = __builtin_ctz(mask); mask &= mask - 1; const bool two = mask != 0u; const int e1 = two ? __builtin_ctz(mask) : e0; if (two) mask &= mask - 1;
            const int s0 = __builtin_amdgcn_readlane(iv, e0), s1 = __builtin_amdgcn_readlane(iv, e1);
            const GAS unsigned* y0 = (const GAS unsigned*)(Y + ((size_t)((e0 * BATCH + b) * CAP + s0)) * DM) + lane_; const GAS unsigned* y1 = (const GAS unsigned*)(Y + ((size_t)((e1 * BATCH + b) * CAP + s1)) * DM) + lane_;
            unsigned w0[4], w1[4];
#pragma unroll
            for (int j = 0; j < 4; ++j) w0[j] = __builtin_nontemporal_load(&y0[64 * j]);
            if (two) {
#pragma unroll
                for (int j = 0; j < 4; ++j) w1[j] = __builtin_nontemporal_load(&y1[64 * j]); }
#pragma unroll
            for (int j = 0; j < 4; ++j) { const auto lo = __builtin_amdgcn_cvt_pk_f32_fp8((int)w0[j], false), hi = __builtin_amdgcn_cvt_pk_f32_fp8((int)w0[j], true);
                v[j].x += lo[0] * 0.0625f; v[j].y += lo[1] * 0.0625f; v[j].z += hi[0] * 0.0625f; v[j].w += hi[1] * 0.0625f; }
            if (two) {
#pragma unroll
                for (int j = 0; j < 4; ++j) { const auto lo = __builtin_amdgcn_cvt_pk_f32_fp8((int)w1[j], false), hi = __builtin_amdgcn_cvt_pk_f32_fp8((int)w1[j], true);
                    v[j].x += lo[0] * 0.0625f; v[j].y += lo[1] * 0.0625f; v[j].z += hi[0] * 0.0625f; v[j].w += hi[1] * 0.0625f; } }
        }
        float s = 0.f;
#pragma unroll
        for (int j = 0; j < 4; ++j) { if (with_norm) { v2u w_; w_.x = pk2(v[j].x, v[j].y); w_.y = pk2(v[j].z, v[j].w); ((GAS v2u*)(x + (size_t)m * DM) + lane_)[64 * j] = w_; v[j] = (f32x4){bf_lo(w_.x), bf_hi(w_.x), bf_lo(w_.y), bf_hi(w_.y)}; }
            else ((GAS f32x4*)(xout + (size_t)m * DM) + lane_)[64 * j] = v[j];
            s += (v[j].x * v[j].x + v[j].y * v[j].y) + (v[j].z * v[j].z + v[j].w * v[j].w); }
        if (with_norm) { const float r = rsqrtf(wave_sum(s) * (1.f / DM) + RMS_EPS); GAS unsigned* o4 = (GAS unsigned*)(H8 + (size_t)m * DM) + lane_;
#pragma unroll
            for (int j = 0; j < 4; ++j) { const f32x4 o = v[j] * r * gv[j]; o4[64 * j] = pk4_fp8(o.x, o.y, o.z, o.w); } }
    }
}

__device__ __forceinline__ void na_phase(Frame& F, const bf16* QKVp, bf16* Op, const float* rel_bias) {
    typedef short bf16x8 __attribute__((ext_vector_type(8))); typedef short s16x4 __attribute__((ext_vector_type(4)));
    int tid = F.tid; asm volatile("" : "+v"(tid));
    const int lane = tid & 63, wid = F.wave, g = lane >> 4, lq = lane & 15, iq = wid & 3, gq = wid >> 2;
    const int kb0 = iq < 2 ? 0 : 1;
    LAS unsigned char* L = F.lds; const unsigned ldsbase = (unsigned)(uintptr_t)F.lds;
    LAS float* nbt = (LAS float*)(L + NA_BT);
    const int qc = 16 * iq + lq; int cs = qc - 8; cs = cs < 0 ? 0 : (cs > 48 ? 48 : cs);
    const int dkey = 8 * wid + (lane >> 3), dchunk = (lane & 7) ^ (dkey & 7);
    const size_t dsrc = (size_t)dkey * EVEN_IN + dchunk * 8;
    const unsigned kc1 = (unsigned)(kb0 * 2048 + lq * 128 + ((g ^ (lq & 7)) * 16)), kc2 = (unsigned)(kb0 * 2048 + lq * 128 + (((4 + g) ^ (lq & 7)) * 16));
    unsigned vc[4]; { const int q_ = lq >> 2, p_ = lq & 3, keyl = (4 * g + q_) & 7;
#pragma unroll
        for (int dt = 0; dt < 4; ++dt) vc[dt] = (unsigned)(8192 + kb0 * 2048 + g * 512 + q_ * 128 + (((2 * dt + (p_ >> 1)) ^ keyl) * 16) + (p_ & 1) * 8); }
    const int bc = 16 * kb0 + 4 * g - qc + 15;
    float mk[3][4];
#pragma unroll
    for (int kbi = 0; kbi < 3; ++kbi)
#pragma unroll
        for (int rg = 0; rg < 4; ++rg) mk[kbi][rg] = ((unsigned)(16 * (kb0 + kbi) + 4 * g - cs + rg) < 16u) ? 0.f : -1.0e30f;
#define NA_BAR() asm volatile("s_waitcnt vmcnt(0) lgkmcnt(0)\n\ts_barrier" ::: "memory")
#define NA_BAR4() asm volatile("s_waitcnt vmcnt(4) lgkmcnt(0)\n\ts_barrier" ::: "memory")
#define NA_DMA(kr) do { const unsigned sl_ = (unsigned)__builtin_amdgcn_readfirstlane((int)(ldsbase + (unsigned)(((kr) % 9) * NA_SLOT) + (unsigned)wid * 1024u)); \
        attn_body::glds16(Kb + (size_t)(kr) * 64 * EVEN_IN + dsrc, sl_); attn_body::glds16(Vb + (size_t)(kr) * 64 * EVEN_IN + dsrc, sl_ + 8192u); } while (0)
#define NA_CLAMP(x) ((x) < 0 ? 0 : ((x) > 24 ? 24 : (x)))
#define NA_PAIR(pr) do { f32x4 sb[2]; bf16x8 kfr[2][2]; float bia[2][4]; s16x4 va[4][2]; int kcs[2]; \
          \
        _Pragma("unroll") for (int u2 = 0; u2 < 2; ++u2) { const int n = 2 * (pr) + u2, kri = n / 3, kbi = n % 3; const int kr = rs + kri, kb = kb0 + kbi; \
            const unsigned sk = (unsigned)((kr % 9) * NA_SLOT); const int key = 16 * kb + lq; \
            kfr[u2][0] = *(const LAS bf16x8*)(L + ((sk + kc1) + kbi * 2048)); kfr[u2][1] = *(const LAS bf16x8*)(L + ((sk + kc2) + kbi * 2048)); \
            kcs[u2] = 0; const LAS float* bp = nbt + 64 + (((kr - rq + 7) * 31 + bc) + 16 * kbi); \
            _Pragma("unroll") for (int rg = 0; rg < 4; ++rg) bia[u2][rg] = bp[rg]; \
            _Pragma("unroll") for (int dt = 0; dt < 4; ++dt) va[dt][u2] = attn_body::vtr((attn_body::lds_cptr)(L + ((sk + vc[dt]) + kbi * 2048))); } \
        _Pragma("unroll") for (int u2 = 0; u2 < 2; ++u2) { \
            f32x4 sv; _Pragma("unroll") for (int rg = 0; rg < 4; ++rg) sv[rg] = bia[u2][rg] + mk[(2 * (pr) + u2) % 3][rg];     \
            sv = __builtin_amdgcn_mfma_f32_16x16x32_bf16(kfr[u2][0], qf0, sv, 0, 0, 0); sv = __builtin_amdgcn_mfma_f32_16x16x32_bf16(kfr[u2][1], qf1, sv, 0, 0, 0); \
            _Pragma("unroll") for (int rg = 0; rg < 4; ++rg) sv[rg] = __builtin_amdgcn_exp2f(sv[rg]); \
            lsum4 += sv; sb[u2] = sv; } \
        bf16x8 pb; { const unsigned w0 = pg8::cvt_pk_bf16(sb[0][0], sb[0][1]), w1 = pg8::cvt_pk_bf16(sb[0][2], sb[0][3]), w2 = pg8::cvt_pk_bf16(sb[1][0], sb[1][1]), w3 = pg8::cvt_pk_bf16(sb[1][2], sb[1][3]); \
            pb = __builtin_bit_cast(bf16x8, (v4u){w0, w1, w2, w3}); } \
        _Pragma("unroll") for (int dt = 0; dt < 4; ++dt) { \
            const bf16x8 vf = (bf16x8){va[dt][0][0], va[dt][0][1], va[dt][0][2], va[dt][0][3], va[dt][1][0], va[dt][1][1], va[dt][1][2], va[dt][1][3]}; \
            oacc[dt] = __builtin_amdgcn_mfma_f32_16x16x32_bf16(vf, pb, oacc[dt], 0, 0, 0); } } while (0)
    for (int bh = F.vcu; bh < BATCH * 8; bh += F.G) {
        const int b = bh >> 3, h = bh & 7;
        const bf16* Qb = QKVp + (size_t)b * SEQ * EVEN_IN + 64 * h; const bf16* Kb = Qb + 512; const bf16* Vb = Qb + 1024;
        bf16* Ob = attn_body::O_FP8 ? (bf16*)((unsigned char*)Op + (size_t)b * SEQ * DM + 64 * h) : Op + (size_t)b * SEQ * DM + 64 * h;
        NA_BAR();
        if (tid < 465) nbt[64 + tid] = rel_bias[h * 465 + tid] * LOG2E;
#pragma unroll
        for (int kr = 0; kr < 8; ++kr) NA_DMA(kr);
        bf16x8 qn[2];
#pragma unroll
        for (int s2 = 0; s2 < 2; ++s2) qn[s2] = *(const GAS bf16x8*)(Qb + (size_t)(gq * 64 + qc) * EVEN_IN + 32 * s2 + 8 * g);
        NA_BAR();
        for (int t = 0; t < 16; ++t) {
            const int rq = 2 * t + gq, rs = NA_CLAMP(rq - 4);
            const bf16x8 qf0 = qn[0], qf1 = qn[1];
            f32x4 oacc[4]; f32x4 lsum4 = (f32x4){0.f, 0.f, 0.f, 0.f};
#pragma unroll
            for (int dt = 0; dt < 4; ++dt) oacc[dt] = (f32x4){0.f, 0.f, 0.f, 0.f};
            NA_PAIR(0); NA_PAIR(1); NA_PAIR(2);
            NA_BAR4();
            if (t + 1 < 16) { const int hi0 = NA_CLAMP(2 * t + 1 - 4) + 7, hi1 = NA_CLAMP(2 * t + 3 - 4) + 7;
                for (int kr = hi0 + 1; kr <= hi1; ++kr) NA_DMA(kr);
#pragma unroll
                for (int s2 = 0; s2 < 2; ++s2) qn[s2] = *(const GAS bf16x8*)(Qb + (size_t)((rq + 2) * 64 + qc) * EVEN_IN + 32 * s2 + 8 * g); }
            NA_PAIR(3); NA_PAIR(4); NA_PAIR(5); NA_PAIR(6); NA_PAIR(7); NA_PAIR(8); NA_PAIR(9); NA_PAIR(10); NA_PAIR(11);
            float lsum = (lsum4[0] + lsum4[1]) + (lsum4[2] + lsum4[3]); lsum += __shfl_xor(lsum, 16); lsum += __shfl_xor(lsum, 32);
            const float rl = __builtin_amdgcn_rcpf(lsum);
            if (attn_body::O_FP8) { unsigned char* orow8 = (unsigned char*)Ob + (size_t)(rq * 64 + qc) * DM + 4 * g; const float r16 = rl * 16.f;
#pragma unroll
                for (int dt = 0; dt < 4; ++dt) *(GAS unsigned*)(orow8 + 16 * dt) = pk4_fp8(oacc[dt][0] * r16, oacc[dt][1] * r16, oacc[dt][2] * r16, oacc[dt][3] * r16); }
            else { bf16* orow = Ob + (size_t)(rq * 64 + qc) * DM + 4 * g;
#pragma unroll
                for (int dt = 0; dt < 4; ++dt) { v2u ov; ov.x = pk2(oacc[dt][0] * rl, oacc[dt][1] * rl); ov.y = pk2(oacc[dt][2] * rl, oacc[dt][3] * rl); *(GAS v2u*)(orow + 16 * dt) = ov; } }
        }
    }
    NA_BAR();
#undef NA_PAIR
#undef NA_CLAMP
#undef NA_BAR
#undef NA_BAR4
#undef NA_DMA
}

struct Args { const float* in[20]; float* out; unsigned char* ws; };
__global__ void __launch_bounds__(NWAVES * 64, 2) mega_fwd(Args args) {
    extern __shared__ __attribute__((aligned(16))) unsigned char lds[];
    asm volatile("s_setreg_imm32_b32 hwreg(HW_REG_MODE, 23, 1), 1");
    bool sat_bad; { float big = 1000.f, nbig = -3.0e9f; asm volatile("" : "+v"(big), "+v"(nbig)); const int tw = __builtin_amdgcn_cvt_pk_fp8_f32(big, nbig, 0, false); sat_bad = (tw & 0xffff) != 0xfe7e; }
    Frame F;
    F.lds = (LAS unsigned char*)lds;
    volatile LAS unsigned* MISC = (volatile LAS unsigned*)(F.lds + MISC_OFF);
    F.tid = threadIdx.x; F.lane = F.tid & 63; F.wave = __builtin_amdgcn_readfirstlane(F.tid >> 6);
    F.G = gridDim.x; { const int bx = blockIdx.x; F.vcu = (F.G % 8 == 0) ? (bx % 8) * (F.G / 8) + bx / 8 : bx; }
    unsigned char* ws = args.ws;
    gu32* ctl = (gu32*)(ws + WS_CTL);
    for (int u = F.tid; u < (LDS_BYTES - LDSCTL_OFF) / 4; u += NWAVES * 64) ((LAS unsigned*)(F.lds + LDSCTL_OFF))[u] = 0u;
    __syncthreads();
    XcdBarrier bar = xcd_barrier_post((unsigned*)(ctl + CW_BAR), MISC + 8);
#define GRID_BAR() xcd_barrier(bar)
    const float* x_in = args.in[0]; float* xres = args.out; bf16* XB = (bf16*)(ws + WS_XB);
    bf16* Hb = (bf16*)(ws + WS_H); bf16* QKV = (bf16*)(ws + WS_QKV); unsigned char* HID = ws + WS_QKV; unsigned char* Yb = ws + WS_Y; unsigned char* H8 = ws + WS_H8;
    float* tab = (float*)(ws + WS_TAB); float* aff = (float*)(ws + WS_AFF); int* selrow = (int*)(ws + WS_SELROW); float* gate = (float*)(ws + WS_GATE); int* inv = (int*)(ws + WS_INV);

    prep_small_weights(F, args.in[2], args.in[9], args.in[11], args.in[14], ws);
    prep_tables(F, tab);
    norm_rows(F, x_in, args.in[1], H8);
#if PROBE & 2
    norm_rows(F, x_in, args.in[1], H8);
#endif
    GRID_BAR();

    { constexpr int L = 0;
        const int NQ = L == 0 ? EVEN_IN : ODD_IN;
        { pg8::Gemm g{(const bf16*)H8, (const bf16*)(ws + (L == 0 ? WS_WIN0 : WS_WIN1)), DM / 2, nullptr}; pg8::StaticOrder S; S.init(NTOK, NQ, F.G, (int)blockIdx.x);
          if (L == 0) { pg8::EpiQKV<0> E{QKV, NQ, tab, args.in[3], args.in[4], args.in[6], args.in[7], QSCALE};
            pg8::gemm_phase<pg8::EpiQKV<0>, pg8::StaticOrder, true, false, true>(F.lds + RING_OFF, g, S, E); }
          else { pg8::EpiQKV<1> E{QKV, NQ, tab, args.in[12], args.in[13], args.in[12], args.in[13], QSCALE};
            pg8::gemm_phase<pg8::EpiQKV<1>, pg8::StaticOrder, true, false, true>(F.lds + RING_OFF, g, S, E); } }

        GRID_BAR();
#define O_AT(off) (attn_body::O_FP8 ? (attn_body::bf16*)((unsigned char*)Hb + (off)) : (attn_body::bf16*)Hb + (off))
        if (L == 0) {
            const attn_body::lds_fptr btab = (attn_body::lds_fptr)(F.lds + BIAS_OFF) + BIAS_PAD;
            na_phase(F, QKV, Hb, args.in[5]);
            attn_body::i32x8a qnx_ = {0, 0, 0, 0, 0, 0, 0, 0};
            for (int n = F.vcu, ui_ = 0; n < BATCH * 8 * 8; n += F.G, ++ui_) {
                if (ui_ == 2 * (F.vcu & 3)) prep_moe_layer(F, 0, args.in[17], args.in[18], args.in[19], ws);
                const int grp = n >> 5, j = n & 31, b = grp >> 1, kvh = grp & 1, hp = j >> 4, qb = j & 15, hq = kvh * 4 + 2 * hp;
                const int t0 = 2 * qb - 2 < 0 ? 0 : 2 * qb - 2, t1 = 2 * qb + 3 > 31 ? 31 : 2 * qb + 3;
                const attn_body::bf16* base = (const attn_body::bf16*)QKV + (size_t)b * SEQ * EVEN_IN;
                const float* sk_ = args.in[8] + hq; const float sinkl2 = ((F.wave >> 2) ? sk_[1] : sk_[0]) * LOG2E;
                const int n2 = n + F.G; const bool pre = n2 < BATCH * 8 * 8;
                const int grp2 = n2 >> 5, j2 = n2 & 31, b2 = grp2 >> 1, kvh2 = grp2 & 1, hp2 = j2 >> 4, qb2 = j2 & 15, hq2 = kvh2 * 4 + 2 * hp2, t02 = 2 * qb2 - 2 < 0 ? 0 : 2 * qb2 - 2;
                const char* base2 = (const char*)((const attn_body::bf16*)QKV + (size_t)(pre ? b2 : b) * SEQ * EVEN_IN);
                attn_body::attn_unit<1, EVEN_IN, 8>(attn_body::QK_FP8 ? (const attn_body::bf16*)((const char*)base + 3072 + 64 * hq) : base + 1536 + 64 * hq, attn_body::QK_FP8 ? (const attn_body::bf16*)((const char*)base + 4096 + 64 * kvh) : base + 2048 + 64 * kvh,
                                                    attn_body::QK_FP8 ? (const attn_body::bf16*)((const char*)base + 4352 + 64 * kvh) : base + 2176 + 64 * kvh, O_AT((size_t)b * SEQ * DM + 512 + 64 * hq), 128 * qb, t0, t1 - t0 + 1,
                                                    sinkl2, btab, (char*)lds + RING_OFF, ui_ > 0, pre, (const attn_body::bf16*)(base2 + 3072 + 64 * hq2), (const attn_body::bf16*)(base2 + 4096 + 64 * kvh2), 128 * qb2, t02, &qnx_);
            }
        } else {
            const attn_body::lds_fptr btab = (attn_body::lds_fptr)(F.lds + BIAS_OFF) + BIAS_PAD;
            attn_body::i32x8a qnx_ = {0, 0, 0, 0, 0, 0, 0, 0};
            for (int n = F.vcu, ui_ = 0; n < BATCH * 16 * 8; n += F.G, ++ui_) {
                if (ui_ == 4 * (F.vcu & 3)) prep_moe_layer(F, 1, args.in[17], args.in[18], args.in[19], ws);
                const int grp = n >> 5, j = n & 31, b = grp >> 2, kvh = grp & 3, hq = kvh * 4 + (j >> 3), qb = j & 7;
                const attn_body::bf16* base = (const attn_body::bf16*)QKV + (size_t)b * SEQ * ODD_IN;
                const int n2 = n + F.G; const bool pre = n2 < BATCH * 16 * 8;
                const int grp2 = n2 >> 5, j2 = n2 & 31, b2 = grp2 >> 2, kvh2 = grp2 & 3, hq2 = kvh2 * 4 + (j2 >> 3), qb2 = j2 & 7;
                const char* base2 = (const char*)((const attn_body::bf16*)QKV + (size_t)(pre ? b2 : b) * SEQ * ODD_IN);
                attn_body::attn_unit<2, ODD_IN, 8>(attn_body::QK_FP8 ? (const attn_body::bf16*)((const char*)base + 64 * hq) : base + 64 * hq, attn_body::QK_FP8 ? (const attn_body::bf16*)((const char*)base + 2048 + 64 * kvh) : base + 1024 + 64 * kvh, attn_body::QK_FP8 ? (const attn_body::bf16*)((const char*)base + 2560 + 64 * kvh) : base + 1280 + 64 * kvh, O_AT((size_t)b * SEQ * DM + 64 * hq), 256 * qb, 0, 32, 0.f, btab, (char*)lds + RING_OFF,
                                                   ui_ > 0, pre, (const attn_body::bf16*)(base2 + 64 * hq2), (const attn_body::bf16*)(base2 + 2048 + 64 * kvh2), 256 * qb2, 0, &qnx_);
            }
        }

        GRID_BAR();
        { pg8::Gemm g{Hb, (const bf16*)(ws + (L == 0 ? WS_WOUT0 : WS_WOUT1)), DM / 2, nullptr, 0x7b7b7b7b}; pg8::StaticOrder S; S.init(NTOK, DM, F.G, (int)blockIdx.x);
          if (L == 0) { pg8::EpiRes<false> E{(const void*)x_in, XB, DM}; pg8::gemm_phase<pg8::EpiRes<false>, pg8::StaticOrder, true, false, true>(F.lds + RING_OFF, g, S, E); }
          else { pg8::EpiRes<true> E{(const void*)XB, XB, DM}; pg8::gemm_phase<pg8::EpiRes<true>, pg8::StaticOrder, true, false, true>(F.lds + RING_OFF, g, S, E); } }

        GRID_BAR();
        norm_router_phase(F, XB, args.in[15] + L * DM, args.in[16] + (size_t)L * DM * NE, H8, aff);
        GRID_BAR();
        select_phase(F, aff, selrow, gate, inv);


        GRID_BAR();
        { pg8::Gemm g{(const bf16*)H8, (const bf16*)(ws + WS_WGU + (size_t)L * NE * 4096 * DM), DM / 2, selrow}; pg8::StaticOrder S; S.init(NE * BATCH * CAP, 2 * DFF, F.G, (int)blockIdx.x, BATCH, BATCH, 0);
          pg8::EpiGU8 E{HID, DFF};
          pg8::gemm_phase<pg8::EpiGU8, pg8::StaticOrder, true, true, true>(F.lds + RING_OFF, g, S, E); }
        GRID_BAR();
        { pg8::Gemm g{(const bf16*)HID, (const bf16*)(ws + WS_WD + (size_t)L * NE * DM * DFF), DFF / 2, nullptr}; pg8::StaticOrder S; S.init(NE * BATCH * CAP, DM, F.G, (int)blockIdx.x, BATCH, BATCH, 0);
          pg8::EpiY E{Yb, DM, gate};
          pg8::gemm_phase<pg8::EpiY, pg8::StaticOrder, true, false, true>(F.lds + RING_OFF, g, S, E); }
        GRID_BAR();
        combine_phase(F, XB, xres, Yb, inv, args.in[10], H8, L == 0);
        if (L == 0) GRID_BAR();
    }
    if (sat_bad) { GRID_BAR(); if (blockIdx.x == 0 && threadIdx.x == 0) xres[0] = __builtin_nanf("");     }
    { constexpr int L = 1;
        const int NQ = L == 0 ? EVEN_IN : ODD_IN;
        { pg8::Gemm g{(const bf16*)H8, (const bf16*)(ws + (L == 0 ? WS_WIN0 : WS_WIN1)), DM / 2, nullptr}; pg8::StaticOrder S; S.init(NTOK, NQ, F.G, (int)blockIdx.x);
          if (L == 0) { pg8::EpiQKV<0> E{QKV, NQ, tab, args.in[3], args.in[4], args.in[6], args.in[7], QSCALE};
            pg8::gemm_phase<pg8::EpiQKV<0>, pg8::StaticOrder, true, false, true>(F.lds + RING_OFF, g, S, E); }
          else { pg8::EpiQKV<1> E{QKV, NQ, tab, args.in[12], args.in[13], args.in[12], args.in[13], QSCALE};
            pg8::gemm_phase<pg8::EpiQKV<1>, pg8::StaticOrder, true, false, true>(F.lds + RING_OFF, g, S, E); } }

        GRID_BAR();
#define O_AT(off) (attn_body::O_FP8 ? (attn_body::bf16*)((unsigned char*)Hb + (off)) : (attn_body::bf16*)Hb + (off))
        if (L == 0) {
            const attn_body::lds_fptr btab = (attn_body::lds_fptr)(F.lds + BIAS_OFF) + BIAS_PAD;
            na_phase(F, QKV, Hb, args.in[5]);
            attn_body::i32x8a qnx_ = {0, 0, 0, 0, 0, 0, 0, 0};
            for (int n = F.vcu, ui_ = 0; n < BATCH * 8 * 8; n += F.G, ++ui_) {
                if (ui_ == 2 * (F.vcu & 3)) prep_moe_layer(F, 0, args.in[17], args.in[18], args.in[19], ws);
                const int grp = n >> 5, j = n & 31, b = grp >> 1, kvh = grp & 1, hp = j >> 4, qb = j & 15, hq = kvh * 4 + 2 * hp;
                const int t0 = 2 * qb - 2 < 0 ? 0 : 2 * qb - 2, t1 = 2 * qb + 3 > 31 ? 31 : 2 * qb + 3;
                const attn_body::bf16* base = (const attn_body::bf16*)QKV + (size_t)b * SEQ * EVEN_IN;
                const float* sk_ = args.in[8] + hq; const float sinkl2 = ((F.wave >> 2) ? sk_[1] : sk_[0]) * LOG2E;
                const int n2 = n + F.G; const bool pre = n2 < BATCH * 8 * 8;
                const int grp2 = n2 >> 5, j2 = n2 & 31, b2 = grp2 >> 1, kvh2 = grp2 & 1, hp2 = j2 >> 4, qb2 = j2 & 15, hq2 = kvh2 * 4 + 2 * hp2, t02 = 2 * qb2 - 2 < 0 ? 0 : 2 * qb2 - 2;
                const char* base2 = (const char*)((const attn_body::bf16*)QKV + (size_t)(pre ? b2 : b) * SEQ * EVEN_IN);
                attn_body::attn_unit<1, EVEN_IN, 8>(attn_body::QK_FP8 ? (const attn_body::bf16*)((const char*)base + 3072 + 64 * hq) : base + 1536 + 64 * hq, attn_body::QK_FP8 ? (const attn_body::bf16*)((const char*)base + 4096 + 64 * kvh) : base + 2048 + 64 * kvh,
                                                    attn_body::QK_FP8 ? (const attn_body::bf16*)((const char*)base + 4352 + 64 * kvh) : base + 2176 + 64 * kvh, O_AT((size_t)b * SEQ * DM + 512 + 64 * hq), 128 * qb, t0, t1 - t0 + 1,
                                                    sinkl2, btab, (char*)lds + RING_OFF, ui_ > 0, pre, (const attn_body::bf16*)(base2 + 3072 + 64 * hq2), (const attn_body::bf16*)(base2 + 4096 + 64 * kvh2), 128 * qb2, t02, &qnx_);
            }
        } else {
            const attn_body::lds_fptr btab = (attn_body::lds_fptr)(F.lds + BIAS_OFF) + BIAS_PAD;
            attn_body::i32x8a qnx_ = {0, 0, 0, 0, 0, 0, 0, 0};
            for (int n = F.vcu, ui_ = 0; n < BATCH * 16 * 8; n += F.G, ++ui_) {
                if (ui_ == 4 * (F.vcu & 3)) prep_moe_layer(F, 1, args.in[17], args.in[18], args.in[19], ws);
                const int grp = n >> 5, j = n & 31, b = grp >> 2, kvh = grp & 3, hq = kvh * 4 + (j >> 3), qb = j & 7;
                const attn_body::bf16* base = (const attn_body::bf16*)QKV + (size_t)b * SEQ * ODD_IN;
                const int n2 = n + F.G; const bool pre = n2 < BATCH * 16 * 8;
                const int grp2 = n2 >> 5, j2 = n2 & 31, b2 = grp2 >> 2, kvh2 = grp2 & 3, hq2 = kvh2 * 4 + (j2 >> 3), qb2 = j2 & 7;
                const char* base2 = (const char*)((const attn_body::bf16*)QKV + (size_t)(pre ? b2 : b) * SEQ * ODD_IN);
                attn_body::attn_unit<2, ODD_IN, 8>(attn_body::QK_FP8 ? (const attn_body::bf16*)((const char*)base + 64 * hq) : base + 64 * hq, attn_body::QK_FP8 ? (const attn_body::bf16*)((const char*)base + 2048 + 64 * kvh) : base + 1024 + 64 * kvh, attn_body::QK_FP8 ? (const attn_body::bf16*)((const char*)base + 2560 + 64 * kvh) : base + 1280 + 64 * kvh, O_AT((size_t)b * SEQ * DM + 64 * hq), 256 * qb, 0, 32, 0.f, btab, (char*)lds + RING_OFF,
                                                   ui_ > 0, pre, (const attn_body::bf16*)(base2 + 64 * hq2), (const attn_body::bf16*)(base2 + 2048 + 64 * kvh2), 256 * qb2, 0, &qnx_);
            }
        }

        GRID_BAR();
        { pg8::Gemm g{Hb, (const bf16*)(ws + (L == 0 ? WS_WOUT0 : WS_WOUT1)), DM / 2, nullptr, 0x7b7b7b7b}; pg8::StaticOrder S; S.init(NTOK, DM, F.G, (int)blockIdx.x);
          if (L == 0) { pg8::EpiRes<false> E{(const void*)x_in, XB, DM}; pg8::gemm_phase<pg8::EpiRes<false>, pg8::StaticOrder, true, false, true>(F.lds + RING_OFF, g, S, E); }
          else { pg8::EpiRes<true> E{(const void*)XB, XB, DM}; pg8::gemm_phase<pg8::EpiRes<true>, pg8::StaticOrder, true, false, true>(F.lds + RING_OFF, g, S, E); } }

        GRID_BAR();
        norm_router_phase(F, XB, args.in[15] + L * DM, args.in[16] + (size_t)L * DM * NE, H8, aff);
        GRID_BAR();
        select_phase(F, aff, selrow, gate, inv);


        GRID_BAR();
        { pg8::Gemm g{(const bf16*)H8, (const bf16*)(ws + WS_WGU + (size_t)L * NE * 4096 * DM), DM / 2, selrow}; pg8::StaticOrder S; S.init(NE * BATCH * CAP, 2 * DFF, F.G, (int)blockIdx.x, BATCH, BATCH, 0);
          pg8::EpiGU8 E{HID, DFF};
          pg8::gemm_phase<pg8::EpiGU8, pg8::StaticOrder, true, true, true>(F.lds + RING_OFF, g, S, E); }
        GRID_BAR();
        { pg8::Gemm g{(const bf16*)HID, (const bf16*)(ws + WS_WD + (size_t)L * NE * DM * DFF), DFF / 2, nullptr}; pg8::StaticOrder S; S.init(NE * BATCH * CAP, DM, F.G, (int)blockIdx.x, BATCH, BATCH, 0);
          pg8::EpiY E{Yb, DM, gate};
          pg8::gemm_phase<pg8::EpiY, pg8::StaticOrder, true, false, true>(F.lds + RING_OFF, g, S, E); }
        GRID_BAR();
        combine_phase(F, XB, xres, Yb, inv, args.in[10], H8, L == 0);
        if (L == 0) GRID_BAR();
    }
    if (sat_bad) { GRID_BAR(); if (blockIdx.x == 0 && threadIdx.x == 0) xres[0] = __builtin_nanf("");     }
#undef GRID_BAR
}

extern "C" void kernel_launch(void* const* d_in, const int* in_sizes, int n_in, void* d_out, int out_size, void* d_ws, size_t ws_size, hipStream_t stream) {
    static int grid = 0;
    if (grid == 0) {
        if (n_in != 20 || in_sizes[0] != NTOK * DM || out_size != NTOK * DM || ws_size < WS_END) { fprintf(stderr, "kernel_launch: unexpected shapes (n_in %d, in0 %d, out %d, ws %zu); nothing launched\n", n_in, n_in > 0 ? in_sizes[0] : -1, out_size, ws_size); grid = -1; return; }
        int dev = 0, cus = 0, per_cu = 0;
        if (hipGetDevice(&dev) != hipSuccess || hipDeviceGetAttribute(&cus, hipDeviceAttributeMultiprocessorCount, dev) != hipSuccess) { fprintf(stderr, "kernel_launch: device query failed\n"); grid = -1; return; }
        if (hipFuncSetAttribute((const void*)mega_fwd, hipFuncAttributeMaxDynamicSharedMemorySize, LDS_BYTES) != hipSuccess) { fprintf(stderr, "kernel_launch: hipFuncSetAttribute failed\n"); grid = -1; return; }
        if (hipOccupancyMaxActiveBlocksPerMultiprocessor(&per_cu, (const void*)mega_fwd, NWAVES * 64, LDS_BYTES) != hipSuccess || per_cu < 1)
            fprintf(stderr, "kernel_launch: note: occupancy query reports %d workgroups per CU\n", per_cu);
        (void)hipGetLastError();
        grid = cus;
    }
    if (grid < 0) return;
    if (hipMemsetAsync((char*)d_ws + WS_CTL, 0, CTL_ZERO_BYTES, stream) != hipSuccess) { fprintf(stderr, "kernel_launch: memset failed\n"); return; }
    Args a{};
    for (int i = 0; i < 20; ++i) a.in[i] = (const float*)d_in[i];
    a.out = (float*)d_out; a.ws = (unsigned char*)d_ws;
    hipLaunchKernelGGL(mega_fwd, dim3(grid), dim3(NWAVES * 64), LDS_BYTES, stream, a);
    const hipError_t le = hipPeekAtLastError();
    if (le != hipSuccess) fprintf(stderr, "kernel_launch: launch failed: %s\n", hipGetErrorName(le));
}
```

```cpp
#include <hip/hip_runtime.h>
#include <hip/hip_bf16.h>
#include <cstdio>
#include <cstdint>
#include <cmath>
#ifndef PROBE
#define PROBE 0
#endif
namespace pg8 {
#define PG8_LAS __attribute__((address_space(3)))
typedef unsigned short bf16_t;
typedef short bf16x8 __attribute__((ext_vector_type(8)));
typedef float f32x4 __attribute__((ext_vector_type(4)));
typedef unsigned u32x4 __attribute__((ext_vector_type(4)));
typedef int i32x4 __attribute__((ext_vector_type(4)));
typedef int i32x8 __attribute__((ext_vector_type(8)));
typedef unsigned u32x2 __attribute__((ext_vector_type(2)));
constexpr int BM = 256, BK = 64, HALF = 128, HTB = HALF * BK * 2  , STAGE_BYTES = 8 * HTB, NXCD = 8, WGM = 8;

__host__ __device__ __forceinline__ int lds_byte(int r, int c) { const int st = (r >> 4) * 2 + (c >> 5), rr = r & 15, cc = c & 31, ob = rr * 64 + cc * 2; return st * 1024 + (ob ^ (((ob >> 9) & 1) << 5)); }
__host__ __device__ __forceinline__ void stage_rc(int b, int& R, int& C) { const int st = b / 1024, sb = b % 1024, swz = sb ^ (((sb >> 9) & 1) << 5); R = (st >> 1) * 16 + swz / 64; C = (st & 1) * 32 + (swz % 64) / 2; }
__host__ __device__ __forceinline__ int perm32(int rho) { const int n = rho >> 4, i = rho & 15; return 8 * (i >> 2) + 4 * n + (i & 3); }

struct Unit { int pm, pn, bt, am; };
struct Gemm { const bf16_t* A; const bf16_t* Bt; int K; const int* gidx; int scx = 0x7f7f7f7f; };

struct StaticOrder {
    int nM, nN, nwg, G, c, ediv, amul, aoff, rev;
    __device__ void init(int M, int N, int G_, int c_, int ediv_ = (1 << 30), int amul_ = 0, int aoff_ = 0, int rev_ = 0) { nM = M / BM; nN = N / BM; nwg = nM * nN; G = G_; c = c_; ediv = ediv_; amul = amul_; aoff = aoff_; rev = rev_; }
    __device__ bool next(int i, Unit& u) const {
        const long L = (long)i * G + c; if (L >= nwg) return false;
        int wgid = (int)L; { const int q = nwg / NXCD, r = nwg % NXCD, xcd = wgid % NXCD, off = wgid / NXCD; wgid = (xcd < r ? xcd * (q + 1) : r * (q + 1) + (xcd - r) * q) + off; }
        const int nig = WGM * nN, gid = wgid / nig, fm = gid * WGM, gsz = (nM - fm) < WGM ? (nM - fm) : WGM;
        u.pm = fm + ((wgid % nig) % gsz); u.pn = (wgid % nig) / gsz; if (rev) u.pm = nM - 1 - u.pm;
        const int e = u.pm / ediv, bl = u.pm - e * ediv; u.bt = e * nN + u.pn; u.am = e * amul + aoff + bl;
        return true;
    }
};

__device__ __forceinline__ unsigned cvt_pk_bf16(float lo, float hi) { unsigned r; asm volatile("v_cvt_pk_bf16_f32 %0, %1, %2" : "=v"(r) : "v"(lo), "v"(hi)); return r; }

__device__ __forceinline__ unsigned pk4_fp8(float a, float b, float c, float d) { int w = 0; w = __builtin_amdgcn_cvt_pk_fp8_f32(a, b, w, false); w = __builtin_amdgcn_cvt_pk_fp8_f32(c, d, w, true); return (unsigned)w; }
struct EpiBf16 {
    static constexpr bool PERM = true;
    bf16_t* O; int ldc;
    __device__ __forceinline__ void operator()(const f32x4 (&acc)[2][2][4][2], const Unit& u, int wr, int wc, int fr, int fq) const {
        const int row0 = u.pm * BM + wr * 64 + fr, col0 = u.pn * BM + wc * 32 + 8 * fq;
#pragma unroll
        for (int ai = 0; ai < 2; ++ai)
#pragma unroll
            for (int m = 0; m < 4; ++m) { bf16_t* rowp = O + (size_t)(row0 + ai * HALF + m * 16) * ldc + col0;
#pragma unroll
                for (int bj = 0; bj < 2; ++bj) { const f32x4 v0 = acc[ai][bj][m][0], v1 = acc[ai][bj][m][1];
                    u32x4 w; w.x = cvt_pk_bf16(v0[0], v0[1]); w.y = cvt_pk_bf16(v0[2], v0[3]); w.z = cvt_pk_bf16(v1[0], v1[1]); w.w = cvt_pk_bf16(v1[2], v1[3]);
                    *(u32x4*)(rowp + bj * HALF) = w; } }
    }
};
template <int LAYER> struct EpiQKV {
    static constexpr bool PERM = true;
    bf16_t* O; int ldc; const float* tab; const float* g0; const float* g1; const float* g2; const float* g3; float qscale;
    template <int KIND, bool F8OUT> __device__ __forceinline__ void body(const f32x4 (&acc)[2][2][4][2], const Unit& u, int wr, int wc, int fr, int fq, const float* gp, const float sc, const int f8col = 0) const {
        const int d0 = LAYER == 0 ? 8 * fq : 32 * (fq >> 1) + 8 * (fq & 1), dstep = LAYER == 0 ? 32 : 16;
        const int row0 = u.pm * BM + wr * 64 + fr, col0 = u.pn * BM + wc * 64 + d0;
        f32x4 gv[2][2];
        if (KIND != 0) {
#pragma unroll
            for (int bj = 0; bj < 2; ++bj)
#pragma unroll
                for (int n = 0; n < 2; ++n) gv[bj][n] = *(const f32x4*)(gp + d0 + dstep * bj + 4 * n) * sc;
        }
        u32x4 tq[4][2][2]; u32x4 w[8][2];
#define QKV_LOADT(ch) do { if (KIND == 2) { _Pragma("unroll") for (int r_ = 0; r_ < 2; ++r_) { const int mm_ = (ch) * 2 + r_; const int s_ = (row0 + (mm_ >> 2) * HALF + (mm_ & 3) * 16) & 2047; const unsigned* tcp; \
            if (LAYER == 0) { tcp = (const unsigned*)tab + s_ * 32 + 8 * fq; } else { const int pos_ = (fq >> 1) ? (s_ & 63) : (s_ >> 6); tcp = (const unsigned*)tab + 65536 + pos_ * 16 + 8 * (fq & 1); } \
            _Pragma("unroll") for (int n = 0; n < 2; ++n) tq[ch][r_][n] = *(const u32x4*)(tcp + 4 * n); } } } while (0)
#define QKV_STORE(mm) do { if constexpr (F8OUT) { unsigned char* rowp_ = (unsigned char*)O + (size_t)(row0 + ((mm) >> 2) * HALF + ((mm) & 3) * 16) * (ldc * 2) + f8col + wc * 64 + d0; \
            *(u32x2*)(rowp_) = (u32x2){w[mm][0].x, w[mm][0].y}; *(u32x2*)(rowp_ + dstep) = (u32x2){w[mm][1].x, w[mm][1].y}; } \
        else { bf16_t* rowp_ = O + (size_t)(row0 + ((mm) >> 2) * HALF + ((mm) & 3) * 16) * ldc + col0; *(u32x4*)(rowp_) = w[mm][0]; *(u32x4*)(rowp_ + dstep) = w[mm][1]; } } while (0)
        QKV_LOADT(0); QKV_LOADT(1);
#pragma unroll
        for (int ch = 0; ch < 4; ++ch) {
#pragma unroll
            for (int r_ = 0; r_ < 2; ++r_) { const int mm = ch * 2 + r_, ai = mm >> 2, m = mm & 3;
                f32x4 x[2][2];
#pragma unroll
                for (int bj = 0; bj < 2; ++bj)
#pragma unroll
                    for (int n = 0; n < 2; ++n) x[bj][n] = acc[ai][bj][m][n];
                if (KIND == 0 && F8OUT) {
#pragma unroll
                    for (int bj = 0; bj < 2; ++bj)
#pragma unroll
                        for (int n = 0; n < 2; ++n) x[bj][n] = x[bj][n] * sc;
                }
                if (KIND != 0) {
                    float ss = 0.f;
#pragma unroll
                    for (int bj = 0; bj < 2; ++bj)
#pragma unroll
                        for (int n = 0; n < 2; ++n) ss += (x[bj][n][0] * x[bj][n][0] + x[bj][n][1] * x[bj][n][1]) + (x[bj][n][2] * x[bj][n][2] + x[bj][n][3] * x[bj][n][3]);
                    { auto p16 = __builtin_amdgcn_permlane16_swap(__float_as_uint(ss), __float_as_uint(ss), false, false); ss = __uint_as_float(p16[0]) + __uint_as_float(p16[1]); }
                    { auto p32 = __builtin_amdgcn_permlane32_swap(__float_as_uint(ss), __float_as_uint(ss), false, false); ss = __uint_as_float(p32[0]) + __uint_as_float(p32[1]); }
                    const float rr = __builtin_amdgcn_rsqf(ss * (1.f / 64.f) + 1e-6f);
#pragma unroll
                    for (int bj = 0; bj < 2; ++bj)
#pragma unroll
                        for (int n = 0; n < 2; ++n) x[bj][n] = x[bj][n] * rr * gv[bj][n];
                    if (KIND == 2) {
#pragma unroll
                        for (int n = 0; n < 2; ++n) { const unsigned q0 = tq[ch][r_][n].x, q1 = tq[ch][r_][n].y, q2 = tq[ch][r_][n].z, q3 = tq[ch][r_][n].w;
                            const f32x4 c = (f32x4){__uint_as_float(q0 << 16), __uint_as_float(q1 << 16), __uint_as_float(q2 << 16), __uint_as_float(q3 << 16)};
                            const f32x4 sn = (f32x4){__uint_as_float(q0 & 0xffff0000u), __uint_as_float(q1 & 0xffff0000u), __uint_as_float(q2 & 0xffff0000u), __uint_as_float(q3 & 0xffff0000u)};
                            const f32x4 x1 = x[0][n], x2 = x[1][n];
                            x[0][n] = x1 * c - x2 * sn; x[1][n] = x1 * sn + x2 * c; }
                    }
                }
#pragma unroll
                for (int bj = 0; bj < 2; ++bj) { const f32x4 v0 = x[bj][0], v1 = x[bj][1];
                    if constexpr (F8OUT) { w[mm][bj].x = pk4_fp8(v0[0], v0[1], v0[2], v0[3]); w[mm][bj].y = pk4_fp8(v1[0], v1[1], v1[2], v1[3]); w[mm][bj].z = 0u; w[mm][bj].w = 0u; }
                    else { w[mm][bj].x = cvt_pk_bf16(v0[0], v0[1]); w[mm][bj].y = cvt_pk_bf16(v0[2], v0[3]); w[mm][bj].z = cvt_pk_bf16(v1[0], v1[1]); w[mm][bj].w = cvt_pk_bf16(v1[2], v1[3]); } }
            }
            if (ch == 0) { QKV_LOADT(2); QKV_LOADT(3); }
            QKV_STORE(2 * ch); QKV_STORE(2 * ch + 1);
        }
#undef QKV_LOADT
#undef QKV_STORE
    }
    __device__ __forceinline__ void operator()(const f32x4 (&acc)[2][2][4][2], const Unit& u, int wr, int wc, int fr, int fq) const {
        int kind; const float* gp; float sc = 1.f; int f8col = 0;
        if (LAYER == 0) { const int pn = u.pn;
            if (pn < 2) { kind = 1; gp = g0; sc = qscale; } else if (pn < 4) { kind = 1; gp = g1; } else if (pn < 6) { kind = 0; gp = g0; }
            else if (pn < 8) { kind = 2; gp = g2; sc = qscale * 16.f; f8col = 3072 + (pn - 6) * 256; } else if (wc < 2) { kind = 2; gp = g3; f8col = 4096; } else { kind = 0; gp = g0; sc = 8.f; f8col = 4224; } }
        if (LAYER != 0) { const int pn = u.pn; const bool isq = pn < 4, isk = pn == 4;
            kind = (isq || isk) ? 2 : 0; gp = isk ? g1 : g0; sc = isq ? qscale * 16.f : (isk ? 1.f : 8.f); f8col = isq ? pn * 256 : (isk ? 2048 : 2560); }
        if (kind == 2) body<2, true>(acc, u, wr, wc, fr, fq, gp, sc, f8col);
        else if (LAYER == 0 && kind == 1) body<1, false>(acc, u, wr, wc, fr, fq, gp, sc);
        else if (f8col != 0) body<0, true>(acc, u, wr, wc, fr, fq, gp, sc, f8col);
        else body<0, false>(acc, u, wr, wc, fr, fq, gp, sc);
    }
};
struct EpiGU {
    static constexpr bool PERM = true;
    bf16_t* Hd; int ldh;
    __device__ __forceinline__ void operator()(const f32x4 (&acc)[2][2][4][2], const Unit& u, int wr, int wc, int fr, int fq) const {
        const int row0 = u.pm * BM + wr * 64 + fr, col0 = u.pn * HALF + wc * 32 + 8 * fq;
#pragma unroll
        for (int ai = 0; ai < 2; ++ai)
#pragma unroll
            for (int m = 0; m < 4; ++m) { bf16_t* rowp = Hd + (size_t)(row0 + ai * HALF + m * 16) * ldh + col0; float h[8];
#pragma unroll
                for (int n = 0; n < 2; ++n)
#pragma unroll
                    for (int j = 0; j < 4; ++j) { const float gv = acc[ai][0][m][n][j], uv = acc[ai][1][m][n][j];
                        const float sg = gv * __builtin_amdgcn_rcpf(1.0f + __builtin_amdgcn_exp2f(-1.4426950408889634f * gv)); h[n * 4 + j] = sg * uv; }
                u32x4 w; w.x = cvt_pk_bf16(h[0], h[1]); w.y = cvt_pk_bf16(h[2], h[3]); w.z = cvt_pk_bf16(h[4], h[5]); w.w = cvt_pk_bf16(h[6], h[7]);
                *(u32x4*)rowp = w; }
    }
};
struct EpiGU8 {
    static constexpr bool PERM = true;
    unsigned char* Hd; int ldh;
    __device__ __forceinline__ void operator()(const f32x4 (&acc)[2][2][4][2], const Unit& u, int wr, int wc, int fr, int fq) const {
        const int row0 = u.pm * BM + wr * 64 + fr, col0 = u.pn * HALF + wc * 32 + 8 * fq;
#pragma unroll
        for (int ai = 0; ai < 2; ++ai)
#pragma unroll
            for (int m = 0; m < 4; ++m) { unsigned char* rowp = Hd + (size_t)(row0 + ai * HALF + m * 16) * ldh + col0; float h[8];
#pragma unroll
                for (int n = 0; n < 2; ++n)
#pragma unroll
                    for (int j = 0; j < 4; ++j) { const float gv = acc[ai][0][m][n][j], uv = acc[ai][1][m][n][j];
                        h[n * 4 + j] = (gv * uv) * __builtin_amdgcn_rcpf(1.0f + __builtin_amdgcn_exp2f(gv)); }
                u32x2 w; w.x = pk4_fp8(h[0], h[1], h[2], h[3]); w.y = pk4_fp8(h[4], h[5], h[6], h[7]);
                *(u32x2*)rowp = w; }
    }
};
struct EpiY {
    static constexpr bool PERM = true;
    unsigned char* Y; int ldc; const float* gate;
    __device__ __forceinline__ void operator()(const f32x4 (&acc)[2][2][4][2], const Unit& u, int wr, int wc, int fr, int fq) const {
        const int row0 = u.am * BM + wr * 64 + fr, col0 = u.pn * BM + wc * 32 + 8 * fq;
        float gs[2][4];
#pragma unroll
        for (int ai = 0; ai < 2; ++ai)
#pragma unroll
            for (int m = 0; m < 4; ++m) gs[ai][m] = gate[row0 + ai * HALF + m * 16];
#pragma unroll
        for (int ai = 0; ai < 2; ++ai)
#pragma unroll
            for (int m = 0; m < 4; ++m) { const int row = row0 + ai * HALF + m * 16; const float g16 = gs[ai][m] * 16.0f; unsigned char* rowp = Y + (size_t)row * ldc + col0;
#pragma unroll
                for (int bj = 0; bj < 2; ++bj) { const f32x4 v0 = acc[ai][bj][m][0] * g16, v1 = acc[ai][bj][m][1] * g16;
                    u32x2 w; w.x = pk4_fp8(v0[0], v0[1], v0[2], v0[3]); w.y = pk4_fp8(v1[0], v1[1], v1[2], v1[3]);
                    *(u32x2*)(rowp + bj * HALF) = w; } }
    }
};
template <bool RES_BF16> struct EpiRes {
    static constexpr bool PERM = true;
    const void* res; bf16_t* out; int ldc;
    __device__ __forceinline__ void operator()(const f32x4 (&acc)[2][2][4][2], const Unit& u, int wr, int wc, int fr, int fq) const {
        const int row0 = u.pm * BM + wr * 64 + fr, col0 = u.pn * BM + wc * 32 + 8 * fq;
        if constexpr (RES_BF16) {
            u32x4 w[2][4][2];
#pragma unroll
            for (int ai = 0; ai < 2; ++ai)
#pragma unroll
                for (int m = 0; m < 4; ++m) { const size_t off = (size_t)(row0 + ai * HALF + m * 16) * ldc + col0;
#pragma unroll
                    for (int bj = 0; bj < 2; ++bj) w[ai][m][bj] = *(const u32x4*)((const bf16_t*)res + off + bj * HALF); }
#pragma unroll
            for (int ai = 0; ai < 2; ++ai)
#pragma unroll
                for (int m = 0; m < 4; ++m) { const size_t off = (size_t)(row0 + ai * HALF + m * 16) * ldc + col0;
#pragma unroll
                    for (int bj = 0; bj < 2; ++bj) { const unsigned wx = w[ai][m][bj].x, wy = w[ai][m][bj].y, wz = w[ai][m][bj].z, ww = w[ai][m][bj].w;
                        const f32x4 r0 = (f32x4){__uint_as_float(wx << 16), __uint_as_float(wx & 0xffff0000u), __uint_as_float(wy << 16), __uint_as_float(wy & 0xffff0000u)};
                        const f32x4 r1 = (f32x4){__uint_as_float(wz << 16), __uint_as_float(wz & 0xffff0000u), __uint_as_float(ww << 16), __uint_as_float(ww & 0xffff0000u)};
                        const f32x4 v0 = r0 + acc[ai][bj][m][0], v1 = r1 + acc[ai][bj][m][1];
                        u32x4 o; o.x = cvt_pk_bf16(v0[0], v0[1]); o.y = cvt_pk_bf16(v0[2], v0[3]); o.z = cvt_pk_bf16(v1[0], v1[1]); o.w = cvt_pk_bf16(v1[2], v1[3]);
                        *(u32x4*)(out + off + bj * HALF) = o; } }
        } else {
            f32x4 r[2][4][2][2]; u32x4 o[4][2];
#pragma unroll
            for (int m = 0; m < 4; ++m) { const size_t off = (size_t)(row0 + m * 16) * ldc + col0;
#pragma unroll
                for (int bj = 0; bj < 2; ++bj) { r[0][m][bj][0] = *(const f32x4*)((const float*)res + off + bj * HALF); r[0][m][bj][1] = *(const f32x4*)((const float*)res + off + bj * HALF + 4); } }
#pragma unroll
            for (int m = 0; m < 4; ++m)
#pragma unroll
                for (int bj = 0; bj < 2; ++bj) { const f32x4 v0 = r[0][m][bj][0] + acc[0][bj][m][0], v1 = r[0][m][bj][1] + acc[0][bj][m][1];
                    o[m][bj].x = cvt_pk_bf16(v0[0], v0[1]); o[m][bj].y = cvt_pk_bf16(v0[2], v0[3]); o[m][bj].z = cvt_pk_bf16(v1[0], v1[1]); o[m][bj].w = cvt_pk_bf16(v1[2], v1[3]); }
#pragma unroll
            for (int m = 0; m < 4; ++m) { const size_t off = (size_t)(row0 + HALF + m * 16) * ldc + col0;
#pragma unroll
                for (int bj = 0; bj < 2; ++bj) { r[1][m][bj][0] = *(const f32x4*)((const float*)res + off + bj * HALF); r[1][m][bj][1] = *(const f32x4*)((const float*)res + off + bj * HALF + 4); } }
#pragma unroll
            for (int m = 0; m < 4; ++m) { const size_t off = (size_t)(row0 + m * 16) * ldc + col0;
#pragma unroll
                for (int bj = 0; bj < 2; ++bj) *(u32x4*)(out + off + bj * HALF) = o[m][bj]; }
#pragma unroll
            for (int m = 0; m < 4; ++m) { const size_t off = (size_t)(row0 + HALF + m * 16) * ldc + col0;
#pragma unroll
                for (int bj = 0; bj < 2; ++bj) { const f32x4 v0 = r[1][m][bj][0] + acc[1][bj][m][0], v1 = r[1][m][bj][1] + acc[1][bj][m][1];
                    u32x4 q; q.x = cvt_pk_bf16(v0[0], v0[1]); q.y = cvt_pk_bf16(v0[2], v0[3]); q.z = cvt_pk_bf16(v1[0], v1[1]); q.w = cvt_pk_bf16(v1[2], v1[3]);
                    *(u32x4*)(out + off + bj * HALF) = q; } }
        }
    }
};

template <class Epi, class Sched, bool ALIGN_EPI, bool GATHER, bool F8 = false>
__device__ __forceinline__ void gemm_phase(PG8_LAS unsigned char* lds, const Gemm g, const Sched& S, const Epi& E) {
    int tid = threadIdx.x; asm volatile("" : "+v"(tid));
    const int wid = __builtin_amdgcn_readfirstlane(tid >> 6), lane = tid & 63, wr = wid >> 2, wc = wid & 3, fr = lane & 15, fq = lane >> 4;
    const int K = g.K, nt = K / BK;
    unsigned voffA[2], voffB[2], gC[2]; int gR[2];
#pragma unroll
    for (int i = 0; i < 2; ++i) { int R, C; stage_rc(tid * 16 + i * 8192, R, C); const int Rb = Epi::PERM ? ((R & ~31) + perm32(R & 31)) : R;
        voffA[i] = (unsigned)(R * K + C) * 2u; voffB[i] = (unsigned)(Rb * K + C) * 2u; gR[i] = R; gC[i] = (unsigned)C * 2u; }
    const size_t kstep = (size_t)(BK * 2);
    const size_t hstep = (size_t)HALF * K * 2;
    const size_t tstep = 2 * hstep;
    const unsigned K2 = (unsigned)K * 2u;
    const unsigned ldsw = (unsigned)wid * 1024u;
    const unsigned ldsbase = (unsigned)__builtin_amdgcn_readfirstlane((int)((unsigned)(uintptr_t)lds + ldsw));
    const int aoff = lds_byte(wr * 64 + fr, fq * 8), boff = lds_byte(wc * 32 + fr, fq * 8);
#define PG8_SA(b, h) (((b) * 2 + (h)) * HTB)
#define PG8_SB(b, h) ((4 + (b) * 2 + (h)) * HTB)
#define PG8_STAGE(bufoff, gbase, voff) do { _Pragma("unroll") for (int _i = 0; _i < 2; ++_i) \
        asm volatile("s_mov_b32 m0, %2\n\ts_nop 0\n\tglobal_load_lds_dwordx4 %0, %1" :: "v"((voff)[_i]), "s"((const char*)(gbase)), "s"(ldsbase + (unsigned)((bufoff) + _i * 8192)) : "memory", "m0"); } while (0)
#define PG8_STAGE_A(bufoff, kptr, h, VG) do { if constexpr (GATHER) { PG8_STAGE(bufoff, kptr, (VG)[h]); } else { PG8_STAGE(bufoff, (kptr) + (h) * hstep, voffA); } } while (0)
#define PG8_LD8(p) __builtin_shufflevector(*(const PG8_LAS i32x4*)(p), *(const PG8_LAS i32x4*)((p) + 1024), 0, 1, 2, 3, 4, 5, 6, 7)
#define PG8_LDA(dst, b, h) do { if constexpr (F8) { _Pragma("unroll") for (int m = 0; m < 4; ++m) dst##8[m] = PG8_LD8(lds + PG8_SA(b, h) + aoff + m * 2048); } \
        else { _Pragma("unroll") for (int m = 0; m < 4; ++m) _Pragma("unroll") for (int k = 0; k < 2; ++k) dst[m][k] = *(const PG8_LAS bf16x8*)(lds + PG8_SA(b, h) + aoff + m * 2048 + k * 1024); } } while (0)
#define PG8_LDB(dst, b, h) do { if constexpr (F8) { _Pragma("unroll") for (int n = 0; n < 2; ++n) dst##8[n] = PG8_LD8(lds + PG8_SB(b, h) + boff + n * 2048); } \
        else { _Pragma("unroll") for (int n = 0; n < 2; ++n) _Pragma("unroll") for (int k = 0; k < 2; ++k) dst[n][k] = *(const PG8_LAS bf16x8*)(lds + PG8_SB(b, h) + boff + n * 2048 + k * 1024); } } while (0)
#define PG8_MMA(ai, bj, At, Bt, Z) do { __builtin_amdgcn_s_setprio(1); _Pragma("unroll") for (int m = 0; m < 4; ++m) _Pragma("unroll") for (int n = 0; n < 2; ++n) { \
        if constexpr (F8) { if (Z) asm volatile("v_mfma_scale_f32_16x16x128_f8f6f4 %0, %1, %2, 0, %3, %4 op_sel_hi:[0,0,0]" : "=&v"(acc[ai][bj][m][n]) : "v"(Bt##8[n]), "v"(At##8[m]), "v"(sc_w), "v"(sc_x));   \
            else asm volatile("v_mfma_scale_f32_16x16x128_f8f6f4 %0, %1, %2, %0, %3, %4 op_sel_hi:[0,0,0]" : "+v"(acc[ai][bj][m][n]) : "v"(Bt##8[n]), "v"(At##8[m]), "v"(sc_w), "v"(sc_x)); } \
        else { if (Z) acc[ai][bj][m][n] = (f32x4){0.f, 0.f, 0.f, 0.f}; _Pragma("unroll") for (int k = 0; k < 2; ++k) acc[ai][bj][m][n] = __builtin_amdgcn_mfma_f32_16x16x32_bf16(Bt[n][k], At[m][k], acc[ai][bj][m][n], 0, 0, 0); } } \
        __builtin_amdgcn_s_setprio(0); } while (0)
#define PG8_WAIT_V(n) asm volatile("s_waitcnt vmcnt(" #n ")" ::: "memory")
#define PG8_WAIT_L(n) asm volatile("s_waitcnt lgkmcnt(" #n ")" ::: "memory")
#define PG8_BAR __builtin_amdgcn_s_barrier()
#define PG8_SCHED __builtin_amdgcn_sched_barrier(0)
    Unit cur, nxt; int ui = 0;
    if (!S.next(0, cur)) return;
    f32x4 acc[2][2][4][2];
    bf16x8 At[4][2], B0[2][2], B1[2][2]; i32x8 At8[4], B08[2], B18[2];
    int sc_w = 0x79797979, sc_x = g.scx; if constexpr (F8) asm volatile("" : "+v"(sc_w), "+v"(sc_x));
    unsigned vGc[2][2] = {{0u, 0u}, {0u, 0u}}, vGn[2][2] = {{0u, 0u}, {0u, 0u}};
    if constexpr (GATHER) {
        Unit t1; const bool h1 = S.next(1, t1);
#pragma unroll
        for (int h = 0; h < 2; ++h)
#pragma unroll
            for (int i = 0; i < 2; ++i) { vGc[h][i] = (unsigned)g.gidx[cur.am * BM + h * HALF + gR[i]] * K2 + gC[i];
                vGn[h][i] = h1 ? (unsigned)g.gidx[t1.am * BM + h * HALF + gR[i]] * K2 + gC[i] : vGc[h][i]; }
    }
    const char* cA = GATHER ? (const char*)g.A : (const char*)g.A + (size_t)cur.pm * tstep; const char* cB = (const char*)g.Bt + (size_t)cur.bt * tstep;
    PG8_STAGE(PG8_SB(0, 0), cB, voffB); PG8_STAGE(PG8_SB(0, 1), cB + hstep, voffB); PG8_STAGE_A(PG8_SA(0, 0), cA, 0, vGc); PG8_STAGE_A(PG8_SA(0, 1), cA, 1, vGc);
    if (wr == 1) PG8_BAR;
    PG8_WAIT_V(2); PG8_BAR;
    PG8_STAGE(PG8_SB(1, 0), cB + kstep, voffB); PG8_STAGE_A(PG8_SA(1, 0), cA + kstep, 0, vGc); PG8_STAGE(PG8_SB(1, 1), cB + hstep + kstep, voffB);
    PG8_WAIT_V(6); PG8_BAR;
    for (;;) {
        const bool has_next = S.next(ui + 1, nxt);
        const char* nA = has_next ? (GATHER ? (const char*)g.A : (const char*)g.A + (size_t)nxt.pm * tstep) : cA; const char* nB = has_next ? (const char*)g.Bt + (size_t)nxt.bt * tstep : cB;
#define PG8_ITER(t, Z) do { \
            const bool last = ((t) == nt - 2); \
            const char* a1 = cA + (size_t)((t) + 1) * kstep;                                             \
            const char* a2 = last ? nA : cA + (size_t)((t) + 2) * kstep; const char* b2 = last ? nB : cB + (size_t)((t) + 2) * kstep;     \
            const char* a3 = a2 + kstep; const char* b3 = b2 + kstep;                                \
            unsigned vGs[2][2] = {{0u, 0u}, {0u, 0u}}; \
            if constexpr (GATHER) { const bool usen = last && has_next; \
                _Pragma("unroll") for (int h = 0; h < 2; ++h) _Pragma("unroll") for (int i = 0; i < 2; ++i) vGs[h][i] = usen ? vGn[h][i] : vGc[h][i]; } \
              \
            PG8_LDB(B0, 0, 0); PG8_LDB(B1, 0, 1); PG8_SCHED; PG8_LDA(At, 0, 0); PG8_STAGE_A(PG8_SA(1, 1), a1, 1, vGc); \
            PG8_WAIT_V(8); PG8_WAIT_L(0); PG8_BAR; PG8_MMA(0, 0, At, B0, Z); PG8_MMA(0, 1, At, B1, Z); PG8_BAR; PG8_SCHED; \
              \
            PG8_LDA(At, 0, 1); PG8_STAGE(PG8_SB(0, 0), b2, voffB); PG8_STAGE(PG8_SB(0, 1), b2 + hstep, voffB); PG8_STAGE_A(PG8_SA(0, 0), a2, 0, vGs); \
            PG8_WAIT_V(8); PG8_WAIT_L(0); PG8_BAR; PG8_MMA(1, 0, At, B0, Z); PG8_MMA(1, 1, At, B1, Z); PG8_BAR; PG8_SCHED; \
              \
            PG8_LDB(B0, 1, 0); PG8_LDB(B1, 1, 1); PG8_SCHED; PG8_LDA(At, 1, 0); PG8_STAGE_A(PG8_SA(0, 1), a2, 1, vGs); \
            PG8_WAIT_V(8); PG8_WAIT_L(0); PG8_BAR; PG8_MMA(0, 0, At, B0, false); PG8_MMA(0, 1, At, B1, false); PG8_BAR; PG8_SCHED; \
              \
            PG8_LDA(At, 1, 1); PG8_STAGE(PG8_SB(1, 0), b3, voffB); PG8_STAGE(PG8_SB(1, 1), b3 + hstep, voffB); PG8_STAGE_A(PG8_SA(1, 0), a3, 0, vGs); \
            PG8_WAIT_V(8); PG8_WAIT_L(0); PG8_BAR; PG8_MMA(1, 0, At, B0, false); PG8_MMA(1, 1, At, B1, false); PG8_BAR; PG8_SCHED; } while (0)
        PG8_ITER(0, true);
        for (int t = 2; t < nt; t += 2) PG8_ITER(t, false);
#undef PG8_ITER
        if constexpr (F8) asm volatile("s_nop 15\n\ts_nop 7" ::: "memory");
        if constexpr (ALIGN_EPI) { if (wr == 0) PG8_BAR; }
        int raw[2][2] = {{0, 0}, {0, 0}}; bool has_nn = false;
        if constexpr (GATHER) { Unit nn; has_nn = has_next && S.next(ui + 2, nn);
            if (has_nn) {
#pragma unroll
                for (int h = 0; h < 2; ++h)
#pragma unroll
                    for (int i = 0; i < 2; ++i) raw[h][i] = g.gidx[nn.am * BM + h * HALF + gR[i]]; } }
        E(acc, cur, wr, wc, fr, fq);
        if (!has_next) break;
        if constexpr (GATHER) {
#pragma unroll
            for (int h = 0; h < 2; ++h)
#pragma unroll
                for (int i = 0; i < 2; ++i) { vGc[h][i] = vGn[h][i]; if (has_nn) vGn[h][i] = (unsigned)raw[h][i] * K2 + gC[i]; asm volatile("" : "+v"(vGn[h][i])); } }
        cur = nxt; cA = nA; cB = nB; ++ui;
        if constexpr (ALIGN_EPI) { if (wr == 1) PG8_BAR; }
    }
    PG8_WAIT_V(0);
    if constexpr (!ALIGN_EPI) { if (wr == 0) PG8_BAR; }
    PG8_BAR;
#undef PG8_SA
#undef PG8_SB
#undef PG8_STAGE
#undef PG8_STAGE_A
#undef PG8_LDA
#undef PG8_LDB
#undef PG8_MMA
#undef PG8_WAIT_V
#undef PG8_WAIT_L
#undef PG8_BAR
#undef PG8_SCHED
}
}

namespace attn_body {
using bf16=__hip_bfloat16;
using bf16x8=__attribute__((ext_vector_type(8)))short;
using s16x4=__attribute__((ext_vector_type(4)))short;
using f32x16=__attribute__((ext_vector_type(16)))float;
using u32x4=__attribute__((ext_vector_type(4)))unsigned;
constexpr int D=64,OPITCH=1024;
constexpr int NW=8,QBLK=32,QB=QBLK*NW,KVBLK=64;
__device__ __forceinline__ int crow(int r,int hi){return (r&3)+8*(r>>2)+4*hi;}
#define SBAR() __builtin_amdgcn_sched_barrier(0)
typedef const __attribute__((address_space(3))) float* lds_fptr;
template<int MODE> __device__ __forceinline__ void amask(f32x16&p0,f32x16&p1,int tabs,int q0,int wid,int r32,int hi,lds_fptr btab){
  const float NEG=-INFINITY;
  if(MODE==1){
    const int qw=q0+wid*QBLK,k0=64*tabs;
    if((k0+63-qw<=128)&&(qw+31-k0<=128)) return;
    int base=k0+4*hi-(qw+r32)+128; asm volatile("":"+v"(base));
    #pragma unroll
    for(int r=0;r<16;++r){const int off=(r&3)+8*(r>>2); if((unsigned)(base+off)>256u)p0[r]=NEG; if((unsigned)(base+off+32)>256u)p1[r]=NEG;}
  } else if(MODE==0){
    const int qr=(q0>>6)+(wid>>1),kr=tabs; int rs=qr-4; rs=rs<0?0:(rs>24?24:rs);
    if(kr<rs||kr>=rs+8){
      #pragma unroll
      for(int r=0;r<16;++r){p0[r]=NEG;p1[r]=NEG;}
    } else {
      const int qc=32*(wid&1)+r32; int cs=qc-8; cs=cs<0?0:(cs>48?48:cs);
      int cb=4*hi-cs,tpo=(kr-qr+7)*31+15-qc+4*hi; asm volatile("":"+v"(cb),"+v"(tpo));
      lds_fptr tp=btab+tpo;
      #pragma unroll
      for(int r=0;r<16;++r){const int off=(r&3)+8*(r>>2); const float b0=tp[off],b1=tp[off+32];
        p0[r]=((unsigned)(off+cb)<16u)?p0[r]+b0:NEG; p1[r]=((unsigned)(off+32+cb)<16u)?p1[r]+b1:NEG;}
    }
  }
}
constexpr bool MFREE=true;
constexpr bool ATTN_PRIO_HALF=true;
constexpr bool QK_FP8=true;
using i32x2a=__attribute__((ext_vector_type(2)))int; using i32x4a=__attribute__((ext_vector_type(4)))int; using i32x8a=__attribute__((ext_vector_type(8)))int;
constexpr bool LSUM_MFMA=MFREE;
using f32x4a=__attribute__((ext_vector_type(4)))float;
constexpr bool O_FP8=true;
constexpr int NSLOT=3, SLOTB=8192;
constexpr int LDS_K=0, LDS_V=NSLOT*SLOTB, LDS_WS=2*NSLOT*SLOTB, LDS_OST=LDS_WS+NW*64*4, LDS_BYTES=LDS_OST+NW*4096;
constexpr float C2=0.125f*1.4426950408889634f;
__device__ __forceinline__ void glds16(const void*gsrc,unsigned lds_dst){unsigned keep;
  asm volatile("s_mov_b32 %0, m0\n\ts_mov_b32 m0, %2\n\ts_nop 0\n\tglobal_load_lds_dwordx4 %1, off\n\ts_mov_b32 m0, %0":"=&s"(keep):"v"(gsrc),"s"(lds_dst):"memory");}
__device__ __forceinline__ float max3f(float a,float b,float c){float r;asm("v_max3_f32 %0, %1, %2, %3":"=v"(r):"v"(a),"v"(b),"v"(c));return r;}
__device__ __forceinline__ float max2f(float a,float b){float r;asm("v_max_f32_e32 %0, %1, %2":"=v"(r):"v"(a),"v"(b));return r;}
__device__ __forceinline__ float fadd_s(float a,float b){float r;asm("v_add_f32_e32 %0, %1, %2":"=v"(r):"v"(a),"v"(b));return r;}
__device__ __forceinline__ float fsub_s(float a,float b){float r;asm("v_sub_f32_e32 %0, %1, %2":"=v"(r):"v"(a),"v"(b));return r;}
typedef float f32x2_t __attribute__((ext_vector_type(2))); typedef __bf16 bf16x2_t __attribute__((ext_vector_type(2)));
__device__ __forceinline__ unsigned cvtpk_s(float lo,float hi){f32x2_t v={lo,hi};bf16x2_t b=__builtin_convertvector(v,bf16x2_t);return __builtin_bit_cast(unsigned,b);}
#define WAIT_BAR(N) asm volatile("s_waitcnt vmcnt(" #N ") lgkmcnt(0)\n\ts_barrier":::"memory")

__device__ __forceinline__ void qkt(f32x16&p0,f32x16&p1,const char*Kslot,const bf16x8*qr,const f32x16&negm,int r32,int hi){
  const char*kb=Kslot+hi*1024+r32*16;
  #pragma unroll
  for(int d0=0;d0<4;++d0){
    const bf16x8 b0=*reinterpret_cast<const bf16x8*>(kb+d0*2048);
    const bf16x8 b1=*reinterpret_cast<const bf16x8*>(kb+d0*2048+512);
    if(d0==0){p0=__builtin_amdgcn_mfma_f32_32x32x16_bf16(b0,qr[0],negm,0,0,0);p1=__builtin_amdgcn_mfma_f32_32x32x16_bf16(b1,qr[0],negm,0,0,0);}
    else{p0=__builtin_amdgcn_mfma_f32_32x32x16_bf16(b0,qr[d0],p0,0,0,0);p1=__builtin_amdgcn_mfma_f32_32x32x16_bf16(b1,qr[d0],p1,0,0,0);}}
}
typedef __attribute__((address_space(3))) const char* lds_cptr;
typedef short v4i16_t __attribute__((ext_vector_type(4)));
__device__ __forceinline__ void kload8(bf16x8*kf,lds_cptr kp){
  kf[0]=*(const __attribute__((address_space(3))) bf16x8*)(kp);      kf[1]=*(const __attribute__((address_space(3))) bf16x8*)(kp+512);
  kf[2]=*(const __attribute__((address_space(3))) bf16x8*)(kp+2048); kf[3]=*(const __attribute__((address_space(3))) bf16x8*)(kp+2560);
  kf[4]=*(const __attribute__((address_space(3))) bf16x8*)(kp+4096); kf[5]=*(const __attribute__((address_space(3))) bf16x8*)(kp+4608);
  kf[6]=*(const __attribute__((address_space(3))) bf16x8*)(kp+6144); kf[7]=*(const __attribute__((address_space(3))) bf16x8*)(kp+6656);
}
__device__ __forceinline__ void kload2(bf16x8*kf,lds_cptr kp,int j){ kf[2*j]=*(const __attribute__((address_space(3))) bf16x8*)(kp+j*2048); kf[2*j+1]=*(const __attribute__((address_space(3))) bf16x8*)(kp+j*2048+512); }
__device__ __forceinline__ s16x4 vtr(lds_cptr p){ return __builtin_bit_cast(s16x4,__builtin_amdgcn_ds_read_tr16_b64_v4i16((__attribute__((address_space(3))) v4i16_t*)p)); }
__device__ __forceinline__ float rowmax(const f32x16&p0,const f32x16&p1){
  float a=max3f(p0[0],p0[1],p1[0]),b=max3f(p0[2],p0[3],p1[1]);a=max3f(a,p1[2],p1[3]);
  #pragma unroll
  for(int r=4;r<16;r+=4){a=max3f(a,p0[r],p0[r+1]);b=max3f(b,p0[r+2],p0[r+3]);a=max3f(a,p1[r],p1[r+1]);b=max3f(b,p1[r+2],p1[r+3]);}
  const float m=max2f(a,b);
  auto rr=__builtin_amdgcn_permlane32_swap(__float_as_uint(m),__float_as_uint(m),false,false);
  return max2f(__uint_as_float(rr[0]),__uint_as_float(rr[1]));
}
__device__ __forceinline__ void pv(f32x16*o,int vb,bf16x8 pa0,bf16x8 pa1,bf16x8 pa2,bf16x8 pa3){
  #pragma unroll
  for(int d0=0;d0<2;++d0){s16x4 lo[4],hi[4];
    #pragma unroll
    for(int ks=0;ks<4;++ks){
      asm volatile("ds_read_b64_tr_b16 %0,%1 offset:%c2":"=&v"(lo[ks]):"v"(vb),"i"(d0*4096+ks*1024):"memory");
      asm volatile("ds_read_b64_tr_b16 %0,%1 offset:%c2":"=&v"(hi[ks]):"v"(vb),"i"(d0*4096+ks*1024+512):"memory");}
    asm volatile("s_waitcnt lgkmcnt(0)":::"memory");SBAR();
    #define PK(k) (bf16x8){lo[k][0],lo[k][1],lo[k][2],lo[k][3],hi[k][0],hi[k][1],hi[k][2],hi[k][3]}
    o[d0]=__builtin_amdgcn_mfma_f32_32x32x16_bf16(pa0,PK(0),o[d0],0,0,0);
    o[d0]=__builtin_amdgcn_mfma_f32_32x32x16_bf16(pa1,PK(1),o[d0],0,0,0);
    o[d0]=__builtin_amdgcn_mfma_f32_32x32x16_bf16(pa2,PK(2),o[d0],0,0,0);
    o[d0]=__builtin_amdgcn_mfma_f32_32x32x16_bf16(pa3,PK(3),o[d0],0,0,0);
    #undef PK
  }
}

#ifndef ATTN_STORE16
#define ATTN_STORE16(p,v) (*(u32x4*)(p)=(v))
#endif
template<int MODE,int PITCH,int THRL> __device__ __forceinline__ void attn_unit(const bf16*Qb,const bf16*__restrict__ Kb,const bf16*__restrict__ Vb,bf16*Ob,const int q0,const int t0,const int NT,const float sinkl2,lds_fptr btab,char*shm,
    const bool warm=false,const bool pre=false,const bf16*Qn=nullptr,const bf16*Kn=nullptr,const int q0n=0,const int t0n=0,i32x8a*qnx=nullptr){
  int tid=threadIdx.x; asm volatile("":"+v"(tid)); const int lane=tid&63,r32=lane&31,hi=lane>>5; const int wid=__builtin_amdgcn_readfirstlane(tid>>6);
  constexpr bool QK8=(MODE==2||MODE==1)&&QK_FP8;
  const int wrow=(MODE==1)?(wid&3)*QBLK:wid*QBLK, whead=(MODE==1)?(wid>>2)*D:0;
  const bf16*Qw=Qb+(long)(q0+wrow)*PITCH+whead;
  const bf16*Kh=Kb+(long)t0*KVBLK*PITCH,*Vh=Vb+(long)t0*KVBLK*PITCH;
  const unsigned lds0=(unsigned)(uintptr_t)shm;
  float*wsf=(float*)(shm+LDS_WS)+wid*64;
  const bf16*ksrc=Kh+(long)lane*PITCH+wid*8;
  const char*ksrc8=(const char*)Kb+(long)(t0*KVBLK+lane)*(PITCH*2)+16*(wid&3);
  const bf16*vsrc=Vh+(long)(16*(wid&3)+(lane>>2))*PITCH+(wid>>2)*32+(lane&3)*8;
  const char*vsrc8=(const char*)Vb+(long)(t0*KVBLK+16*(wid&3)+(lane>>2))*(PITCH*2)+16*((lane&3)^((lane>>5)<<1));
  const unsigned kdst=QK8?lds0+LDS_K+(wid&3)*1024:lds0+LDS_K+wid*1024, vdst=QK8?lds0+LDS_V+(wid&3)*1024:lds0+LDS_V+wid*1024;
  #define DMA_K(t,slot) do{ if(QK8){ if(wid<4) glds16(ksrc8+(long)(t)*KVBLK*(PITCH*2),(unsigned)__builtin_amdgcn_readfirstlane(kdst+(slot))); } else glds16(ksrc+(long)(t)*KVBLK*PITCH,(unsigned)__builtin_amdgcn_readfirstlane(kdst+(slot))); }while(0)
  #define DMA_V(t,slot) do{ if(QK8){ if(wid>=4) glds16(vsrc8+(long)(t)*KVBLK*(PITCH*2),(unsigned)__builtin_amdgcn_readfirstlane(vdst+(slot))); } else glds16(vsrc+(long)(t)*KVBLK*PITCH,(unsigned)__builtin_amdgcn_readfirstlane(vdst+(slot))); }while(0)
  const int vb0=(int)(lds0+LDS_V)+((lane>>4)&1)*32+(lane&3)*8+(4*hi+((lane&15)>>2))*64;
  const char*Kbase=shm+LDS_K; bf16x8 kf[8]; i32x8a kf8[2]; i32x8a qr8;
  const lds_cptr shm3=(lds_cptr)shm; const lds_cptr kp0=QK8?shm3+LDS_K+hi*2048+r32*16:shm3+LDS_K+hi*1024+r32*16; const lds_cptr vp0=shm3+LDS_V+((lane>>4)&1)*32+(lane&3)*8+(4*hi+((lane&15)>>2))*64;
  const int k8_=(lane&15)>>1, c8_=lane&1, g8_=(lane>>4)&1, sw8_=(k8_>>2)&1, row8_=(k8_&3)+8*(k8_>>2)+4*hi;
  const lds_cptr vb8a=shm3+LDS_V+row8_*64+((g8_^(sw8_<<1))*16)+8*c8_, vb8b=shm3+LDS_V+row8_*64+(((g8_+2)^(sw8_<<1))*16)+8*c8_;
  i32x8a ones8f; { const int o1=(((lane>>4)&1)==((lane>>3)&1))?0x38383838:0; ones8f=(i32x8a){o1,o1,o1,o1,o1,o1,o1,o1}; asm volatile("":"+v"(ones8f)); }
  if(ATTN_PRIO_HALF && wid>=4) __builtin_amdgcn_s_setprio(1);
  const bool hot=QK8&&warm;
  if(hot){ DMA_V(0,0); } else { DMA_K(0,0);DMA_V(0,0);DMA_K(1,SLOTB); }
  bf16x8 qr[4];
  #pragma unroll
  for(int d0=0;d0<4;++d0)qr[d0]=QK8?bf16x8{}:*reinterpret_cast<const bf16x8*>(&Qw[(long)r32*PITCH+d0*16+hi*8]);
  if(QK8){ if(hot){ qr8=*qnx; } else { const char*qp=(const char*)Qb+(long)(q0+wrow+r32)*(PITCH*2)+whead+32*hi; const i32x4a qa=*(const i32x4a*)qp, qb_=*(const i32x4a*)(qp+16); qr8=__builtin_shufflevector(qa,qb_,0,1,2,3,4,5,6,7); } }
  f32x4a lacc={0.f,0.f,0.f,0.f}; bf16x8 ones8; { const short o1=(short)((((lane>>4)&1)==((lane>>3)&1))?0x3F80:0); ones8=(bf16x8){o1,o1,o1,o1,o1,o1,o1,o1}; asm volatile("":"+v"(ones8)); }
  float mhat=0.f,l_reg=0.f;f32x16 o[2];o[0]=f32x16{};o[1]=f32x16{};f32x16 negm=f32x16{}; if(QK8){ _Pragma("unroll") for(int r=0;r<16;++r) negm[r]=-4.f; } if(MODE==2&&!MFREE) asm volatile("":"+v"(negm));
  const int qrel=wid*QBLK+r32;
  #define CMASK(P0,P1,t) do{ if(MODE!=2) amask<MODE>(P0,P1,t0+(t),q0,(MODE==1)?(wid&3):wid,r32,hi,btab); }while(0)
  bool resc=false;
  #define START(P0,P1) do{ resc=false; if(!MFREE){ const float rm=rowmax(P0,P1); \
      const float dl=__builtin_fmaxf(rm,-64.f); mhat=fadd_s(mhat,dl); \
      _Pragma("unroll") for(int r=0;r<16;++r){P0[r]=fsub_s(P0[r],dl);P1[r]=fsub_s(P1[r],dl);} \
      if(MODE==2){ _Pragma("unroll") for(int r=0;r<16;++r)negm[r]=-mhat; asm volatile("":"+v"(negm)); } } \
    _Pragma("unroll") for(int r=0;r<16;++r)P0[r]=__builtin_amdgcn_exp2f(P0[r]); }while(0)
  #define RESC() do{ if(resc){ asm volatile("s_waitcnt lgkmcnt(0)":::"memory"); \
      _Pragma("unroll") for(int d_=0;d_<2;++d_) _Pragma("unroll") for(int r=0;r<16;++r)o[d_][r]*=wsf[crow(r,hi)]; } }while(0)
  f32x16 pA0,pA1,pB0,pB1;
  int sl_prev=0,sl_cur=0,sl_next=SLOTB;
  #define ROT() do{sl_prev=sl_cur;sl_cur=sl_next;sl_next=(sl_next==(NSLOT-1)*SLOTB)?0:sl_next+SLOTB;}while(0)
  if(!hot){ DMA_K(2,2*SLOTB); }
  if(hot){WAIT_BAR(4);}
  else if(QK8){WAIT_BAR(2);}else{WAIT_BAR(3);}
  #define KLD8(j,base) __builtin_shufflevector(*(const __attribute__((address_space(3))) i32x4a*)((base)+(j)*512),*(const __attribute__((address_space(3))) i32x4a*)((base)+(j)*512+1024),0,1,2,3,4,5,6,7)
  #define MF8(j) __builtin_amdgcn_mfma_scale_f32_32x32x64_f8f6f4(kf8[j],qr8,negm,0,0,0,0x7f7f7f7f,0,0x7b7b7b7b)
  if(QK8){ kf8[0]=KLD8(0,kp0); kf8[1]=KLD8(1,kp0); pA0=MF8(0); pA1=MF8(1); } else qkt(pA0,pA1,Kbase,qr,negm,r32,hi);
  asm volatile("s_nop 15\n\ts_nop 7":"+v"(pA0),"+v"(pA1));CMASK(pA0,pA1,0);
  START(pA0,pA1);
  _Pragma("unroll") for(int r=0;r<16;++r)pA1[r]=__builtin_amdgcn_exp2f(pA1[r]);
  WAIT_BAR(0);
  DMA_K(3,0);DMA_V(1,SLOTB);
  ROT();
  if(QK8){ kf8[0]=KLD8(0,kp0+sl_cur); kf8[1]=KLD8(1,kp0+sl_cur); } else kload8(kf,kp0+sl_cur);
  WAIT_BAR(2);
  s16x4 vlo[8],vhi[8]; u32x4 pw0,pw1,pw2,pw3;
  #define PKW(P,B) cvtpk_s(P[B],P[B+1])
  #define PAF(k) __builtin_bit_cast(bf16x8,pw##k)
  #define VFR(i) (bf16x8){vlo[i][0],vlo[i][1],vlo[i][2],vlo[i][3],vhi[i][0],vhi[i][1],vhi[i][2],vhi[i][3]}
  #define PIN(x) asm volatile("":"+v"(x))
  #define MX3(a,b,c) __builtin_fmaxf(__builtin_fmaxf((a),(b)),(c))
  #define GAPA(MF,A0,A1,A2,A3,W0,W1,PW) do{ MF; if(!LSUM_MFMA){ sacc+=A0; sacc+=A1; sacc+=A2; sacc+=A3; PIN(sacc); } W0; W1; PIN(PW); SBAR(); }while(0)
  #define LMF(k) do{ if(LSUM_MFMA) lacc=__builtin_amdgcn_mfma_f32_16x16x32_bf16(PAF(k),ones8,lacc,0,0,0); }while(0)
  #define QKMF(F8S,B16S) do{ if(QK8){ F8S; } else { B16S; } }while(0)
  #define EX(v) __builtin_amdgcn_exp2f(v)
  #define GAPB(MF,X,B) do{ MF; X[B]=EX(X[B]); X[B+1]=EX(X[B+1]); X[B+2]=EX(X[B+2]); X[B+3]=EX(X[B+3]); PIN(X); SBAR(); }while(0)
  #define VRD(i) do{ vlo[i]=vtr(vp_+(((i)>>2)*4096+((i)&3)*1024)); vhi[i]=vtr(vp_+(((i)>>2)*4096+((i)&3)*1024+512)); }while(0)
  #define KRD(G,j) do{ if(G){ if(QK8){ if((j)<2){ kf8[(j)&1]=KLD8((j)&1,kp0+sl_next); SBAR(); } } else { kload2(kf,kp0+sl_next,j); SBAR(); } } }while(0)
  #define STEP(C0,C1,P0,P1,t,GK,GV,GL) do{ SBAR(); \
    const lds_cptr vp_=vp0+sl_prev; \
    VRD(0); SBAR(); float sacc=LSUM_MFMA?0.f:(P0[0]+P0[1]); \
    GAPA(QKMF(C0=MF8(0), C0=__builtin_amdgcn_mfma_f32_32x32x16_bf16(kf[0],qr[0],negm,0,0,0)), P0[2],P0[3],P0[4],P0[5],     pw0[0]=PKW(P0,0), pw0[1]=PKW(P0,2), pw0); \
    VRD(4); SBAR(); GAPA(QKMF((void)0, C1=__builtin_amdgcn_mfma_f32_32x32x16_bf16(kf[1],qr[0],negm,0,0,0)), P0[6],P0[7],P0[8],P0[9],     pw0[2]=PKW(P0,4), pw0[3]=PKW(P0,6), pw0); \
    VRD(1); SBAR(); GAPA(QKMF((void)0, C0=__builtin_amdgcn_mfma_f32_32x32x16_bf16(kf[2],qr[1],C0,0,0,0)); LMF(0),   P0[10],P0[11],P0[12],P0[13], pw1[0]=PKW(P0,8), pw1[1]=PKW(P0,10), pw1); \
    VRD(5); SBAR(); GAPA(QKMF((void)0, C1=__builtin_amdgcn_mfma_f32_32x32x16_bf16(kf[3],qr[1],C1,0,0,0)),   P0[14],P0[15],P1[0],P1[1],   pw1[2]=PKW(P0,12),pw1[3]=PKW(P0,14), pw1); \
    VRD(2); SBAR(); GAPA(QKMF(C1=MF8(1), C0=__builtin_amdgcn_mfma_f32_32x32x16_bf16(kf[4],qr[2],C0,0,0,0)); LMF(1),   P1[2],P1[3],P1[4],P1[5],     pw2[0]=PKW(P1,0), pw2[1]=PKW(P1,2), pw2); \
    VRD(6); SBAR(); GAPA(QKMF((void)0, C1=__builtin_amdgcn_mfma_f32_32x32x16_bf16(kf[5],qr[2],C1,0,0,0)),   P1[6],P1[7],P1[8],P1[9],     pw2[2]=PKW(P1,4), pw2[3]=PKW(P1,6), pw2); \
    VRD(3); SBAR(); GAPA(QKMF((void)0, C0=__builtin_amdgcn_mfma_f32_32x32x16_bf16(kf[6],qr[3],C0,0,0,0)); LMF(2),   P1[10],P1[11],P1[12],P1[13], pw3[0]=PKW(P1,8), pw3[1]=PKW(P1,10), pw3); \
    VRD(7); SBAR(); GAPA(QKMF((void)0, C1=__builtin_amdgcn_mfma_f32_32x32x16_bf16(kf[7],qr[3],C1,0,0,0)),   P1[14],P1[15],0.f,0.f,       pw3[2]=PKW(P1,12),pw3[3]=PKW(P1,14), pw3); \
    if(!LSUM_MFMA) l_reg+=sacc; \
    if(GK){DMA_K((t)+3,sl_cur);} if(GV){DMA_V((t)+1,sl_next);} \
    CMASK(C0,C1,t); \
    if(MODE!=2&&!MFREE){ _Pragma("unroll") for(int r=0;r<16;++r){C0[r]-=mhat;C1[r]-=mhat;} } \
    if(!MFREE){ float a=MX3(C0[0],C0[1],C1[0]),b=MX3(C0[2],C0[3],C1[1]); a=MX3(a,C1[2],C1[3]); \
      _Pragma("unroll") for(int r=4;r<16;r+=4){a=MX3(a,C0[r],C0[r+1]);b=MX3(b,C0[r+2],C0[r+3]);a=MX3(a,C1[r],C1[r+1]);b=MX3(b,C1[r+2],C1[r+3]);} \
      float rm=__builtin_fmaxf(a,b); { auto rr=__builtin_amdgcn_permlane32_swap(__float_as_uint(rm),__float_as_uint(rm),false,false); rm=__builtin_fmaxf(__uint_as_float(rr[0]),__uint_as_float(rr[1])); } \
      resc=false; \
      if(__builtin_expect(__any(rm>(float)THRL),0)){ const float dl=__builtin_fmaxf(rm,0.f); mhat+=dl; \
        _Pragma("unroll") for(int r=0;r<16;++r){C0[r]-=dl;C1[r]-=dl;} \
        if(MODE==2){ _Pragma("unroll") for(int r=0;r<16;++r)negm[r]=-mhat; asm volatile("":"+v"(negm)); } \
        const float f=__builtin_amdgcn_exp2f(-dl); l_reg*=f; if(hi==0)wsf[r32]=f; resc=true; } } \
    SBAR(); \
    GAPB(o[0]=__builtin_amdgcn_mfma_f32_32x32x16_bf16(PAF(0),VFR(0),o[0],0,0,0); LMF(3), C0,0); \
    GAPB(o[1]=__builtin_amdgcn_mfma_f32_32x32x16_bf16(PAF(0),VFR(4),o[1],0,0,0), C0,4); \
    KRD(GL,0); GAPB(o[0]=__builtin_amdgcn_mfma_f32_32x32x16_bf16(PAF(1),VFR(1),o[0],0,0,0), C0,8); \
    KRD(GL,1); GAPB(o[1]=__builtin_amdgcn_mfma_f32_32x32x16_bf16(PAF(1),VFR(5),o[1],0,0,0), C0,12); \
    KRD(GL,2); GAPB(o[0]=__builtin_amdgcn_mfma_f32_32x32x16_bf16(PAF(2),VFR(2),o[0],0,0,0), C1,0); \
    KRD(GL,3); GAPB(o[1]=__builtin_amdgcn_mfma_f32_32x32x16_bf16(PAF(2),VFR(6),o[1],0,0,0), C1,4); \
    GAPB(o[0]=__builtin_amdgcn_mfma_f32_32x32x16_bf16(PAF(3),VFR(3),o[0],0,0,0), C1,8); \
    GAPB(o[1]=__builtin_amdgcn_mfma_f32_32x32x16_bf16(PAF(3),VFR(7),o[1],0,0,0), C1,12); \
    }while(0)
  i32x2a vr8[2][4]; i32x8a pw8; int sc1_=0x7f7f7f7f, scv_=0x7c7c7c7c, scq_=0x7b7b7b7b; asm volatile("":"+v"(sc1_),"+v"(scv_),"+v"(scq_));
  #define PK4E(P,B) ({ int w_; asm("v_cvt_pk_fp8_f32 %0, %1, %2":"=v"(w_):"v"(P[B]),"v"(P[(B)+1])); asm("v_cvt_pk_fp8_f32 %0, %1, %2 op_sel:[0,0,1]":"+v"(w_):"v"(P[(B)+2]),"v"(P[(B)+3])); w_; })
  #define MF8A(j,CX) asm volatile("v_mfma_scale_f32_32x32x64_f8f6f4 %0, %1, %2, -4.0, %3, %4 op_sel_hi:[0,0,0]":"=&v"(CX):"v"(kf8[j]),"v"(qr8),"v"(sc1_),"v"(scq_))
  #define PK8E(P,B,M) do{ int w0_,w1_; asm("v_cvt_pk_fp8_f32 %0, %2, %3\n\tv_cvt_pk_fp8_f32 %1, %6, %7\n\tv_cvt_pk_fp8_f32 %0, %4, %5 op_sel:[0,0,1]\n\tv_cvt_pk_fp8_f32 %1, %8, %9 op_sel:[0,0,1]":"=&v"(w0_),"=&v"(w1_):"v"(P[B]),"v"(P[(B)+1]),"v"(P[(B)+2]),"v"(P[(B)+3]),"v"(P[(B)+4]),"v"(P[(B)+5]),"v"(P[(B)+6]),"v"(P[(B)+7])); pw8[M]=w0_; pw8[(M)+1]=w1_; }while(0)
  #define VTR8(p) __builtin_amdgcn_ds_read_tr8_b64_v2i32((__attribute__((address_space(3))) i32x2a*)(p))
  #define VB8(b) (i32x8a){vr8[b][0][0],vr8[b][0][1],vr8[b][1][0],vr8[b][1][1],vr8[b][2][0],vr8[b][2][1],vr8[b][3][0],vr8[b][3][1]}
  #define PVMF(b) do{ const i32x8a vb_op_=VB8(b); asm volatile("v_mfma_scale_f32_32x32x64_f8f6f4 %0, %1, %2, %0, %3, %4 op_sel_hi:[0,0,0]":"+v"(o[b]):"v"(pw8),"v"(vb_op_),"v"(sc1_),"v"(scv_)); }while(0)
  #define LMF8() asm volatile("v_mfma_scale_f32_16x16x128_f8f6f4 %0, %1, %2, %0, %3, %3 op_sel_hi:[0,0,0]":"+v"(lacc):"v"(pw8),"v"(ones8f),"v"(sc1_))
  #define G8A(MF,RD,W) do{ RD; SBAR(); MF; W; PIN(pw8); SBAR(); }while(0)
  #define STEP8(C0,C1,P0,P1,t,GK,GV,GL) do{ SBAR(); \
    const lds_cptr va_=vb8a+sl_prev, vb_=vb8b+sl_prev; \
    G8A(MF8A(0,C0), vr8[0][0]=VTR8(va_); vr8[0][1]=VTR8(va_+1024),      PK8E(P0,0,0)); \
    G8A((void)0,   vr8[0][2]=VTR8(va_+2048); vr8[0][3]=VTR8(va_+3072), PK8E(P0,8,2)); \
    G8A(MF8A(1,C1), vr8[1][0]=VTR8(vb_); vr8[1][1]=VTR8(vb_+1024),      PK8E(P1,0,4)); \
    G8A((void)0,   vr8[1][2]=VTR8(vb_+2048); vr8[1][3]=VTR8(vb_+3072), PK8E(P1,8,6)); \
    if(GK){DMA_K((t)+3,sl_cur);} if(GV){DMA_V((t)+1,sl_next);} \
    if(MODE!=2){ asm volatile("s_nop 15\n\ts_nop 15\n\ts_nop 15":"+v"(C0),"+v"(C1)); CMASK(C0,C1,t); }     \
    SBAR(); \
    GAPB(PVMF(0), C0,0); \
    GAPB((void)0, C0,4); \
    KRD(GL,0); GAPB(LMF8(), C0,8); \
    KRD(GL,1); GAPB((void)0, C0,12); \
    GAPB(PVMF(1), C1,0); \
    GAPB((void)0, C1,4); \
    GAPB((void)0, C1,8); \
    GAPB((void)0, C1,12); \
    }while(0)
  #define STEPX(C0,C1,P0,P1,t,GK,GV,GL) do{ if(QK8){ STEP8(C0,C1,P0,P1,t,GK,GV,GL); } else { STEP(C0,C1,P0,P1,t,GK,GV,GL); } }while(0)
  int t=1;
  for(;t+5<NT;t+=2){
    STEPX(pB0,pB1,pA0,pA1,t,true,true,true);     if(QK8){WAIT_BAR(1);}else{WAIT_BAR(2);} RESC(); ROT();
    STEPX(pA0,pA1,pB0,pB1,t+1,true,true,true);   if(QK8){WAIT_BAR(1);}else{WAIT_BAR(2);} RESC(); ROT();
  }
  #define ENDW(tt) do{ if(QK8){ if((tt)+3<NT){WAIT_BAR(1);} else {WAIT_BAR(0);} } else if((tt)+3<NT){WAIT_BAR(2);} else if((tt)+2<NT){WAIT_BAR(1);} else {WAIT_BAR(0);} }while(0)
  for(;t+1<NT;t+=2){
    STEPX(pB0,pB1,pA0,pA1,t,(t+3<NT),(t+1<NT),(t+1<NT));       ENDW(t);   RESC(); ROT();
    STEPX(pA0,pA1,pB0,pB1,t+1,(t+4<NT),(t+2<NT),(t+2<NT));     ENDW(t+1); RESC(); ROT();
  }
  if(QK8&&pre){
    const char*ksn=(const char*)Kn+(long)(t0n*KVBLK+lane)*(PITCH*2)+16*(wid&3);
    if(wid<4){ glds16(ksn,(unsigned)__builtin_amdgcn_readfirstlane(kdst)); glds16(ksn+(long)KVBLK*(PITCH*2),(unsigned)__builtin_amdgcn_readfirstlane(kdst+SLOTB)); glds16(ksn+(long)2*KVBLK*(PITCH*2),(unsigned)__builtin_amdgcn_readfirstlane(kdst+2*SLOTB)); }
    const char*qpn=(const char*)Qn+(long)(q0n+wrow+r32)*(PITCH*2)+whead+32*hi; const i32x4a qa=*(const i32x4a*)qpn, qb_=*(const i32x4a*)(qpn+16); *qnx=__builtin_shufflevector(qa,qb_,0,1,2,3,4,5,6,7); }
  STEPX(pB0,pB1,pA0,pA1,NT-1,false,false,false); RESC();
  { if(!LSUM_MFMA){ float sacc=pB0[0]+pB0[1]; _Pragma("unroll") for(int r=2;r<16;++r)sacc+=pB0[r]; _Pragma("unroll") for(int r=0;r<16;++r)sacc+=pB1[r]; l_reg+=sacc; }
    pw0=(u32x4){PKW(pB0,0),PKW(pB0,2),PKW(pB0,4),PKW(pB0,6)};pw1=(u32x4){PKW(pB0,8),PKW(pB0,10),PKW(pB0,12),PKW(pB0,14)};pw2=(u32x4){PKW(pB1,0),PKW(pB1,2),PKW(pB1,4),PKW(pB1,6)};pw3=(u32x4){PKW(pB1,8),PKW(pB1,10),PKW(pB1,12),PKW(pB1,14)};
    if(QK8){ PK8E(pB0,0,0); PK8E(pB0,8,2); PK8E(pB1,0,4); PK8E(pB1,8,6);
      const lds_cptr va_=vb8a+sl_cur, vb_=vb8b+sl_cur; _Pragma("unroll") for(int q_=0;q_<4;++q_){ vr8[0][q_]=VTR8(va_+q_*1024); vr8[1][q_]=VTR8(vb_+q_*1024); }
      LMF8(); PVMF(0); PVMF(1); asm volatile("s_nop 15\n\ts_nop 7":"+v"(o[0]),"+v"(o[1]),"+v"(lacc)); }
    else { LMF(0); LMF(1); LMF(2); LMF(3);
    SBAR(); pv(o,vb0+sl_cur,PAF(0),PAF(1),PAF(2),PAF(3)); } }
  #undef PKW
  #undef PAF
  #undef VFR
  #undef PIN
  #undef MX3
  #undef GAPA
  #undef MF8A
  #undef STEP8
  #undef STEPX
  #undef G8A
  #undef PK4E
  #undef PK8E
  #undef VTR8
  #undef VB8
  #undef PVMF
  #undef LMF8
  #undef QKMF
  #undef KLD8
  #undef MF8
  #undef LMF
  #undef GAPB
  #undef EX
  #undef VRD
  #undef KRD
  #undef STEP
  #undef ENDW
  if(LSUM_MFMA){ const float sk=(MODE==1)?__builtin_amdgcn_exp2f(sinkl2-(QK8?4.f:mhat)):0.f;
    if((lane&7)==0){ const int qb=((lane>>3)&1)*16+(lane>>4)*4; wsf[32+qb]=lacc[0]+sk; wsf[32+qb+1]=lacc[1]+sk; wsf[32+qb+2]=lacc[2]+sk; wsf[32+qb+3]=lacc[3]+sk; } }
  else{
  {auto rr=__builtin_amdgcn_permlane32_swap(__float_as_uint(l_reg),__float_as_uint(l_reg),false,false);l_reg=__uint_as_float(rr[0])+__uint_as_float(rr[1]);}
  if(MODE==1) l_reg+=__builtin_amdgcn_exp2f(sinkl2-mhat);
  if(hi==0)wsf[32+r32]=l_reg; }
  asm volatile("s_waitcnt lgkmcnt(0)":::"memory");
  float rli[16];
  #pragma unroll
  for(int r=0;r<16;++r)rli[r]=__builtin_amdgcn_rcpf(wsf[32+crow(r,hi)]);
  bf16*Ow=Ob+(long)(q0+wrow)*OPITCH+whead; unsigned char*Ow8=(unsigned char*)Ob+(long)(q0+wrow)*OPITCH+whead;
  if(O_FP8){ unsigned char*stg8=(unsigned char*)(shm+LDS_OST)+wid*4096;
    #pragma unroll
    for(int r=0;r<16;++r){const int orow=crow(r,hi); const float s16=rli[r]*16.f;
      const float a_=__builtin_amdgcn_fmed3f(o[0][r]*s16,-448.f,448.f), b_=__builtin_amdgcn_fmed3f(o[1][r]*s16,-448.f,448.f);
      const unsigned w_=(unsigned)__builtin_amdgcn_cvt_pk_fp8_f32(a_,b_,0,false);
      stg8[orow*64+r32]=(unsigned char)(w_&0xffu); stg8[orow*64+32+r32]=(unsigned char)((w_>>8)&0xffu);}
    asm volatile("s_waitcnt lgkmcnt(0)":::"memory");
    #pragma unroll
    for(int i=0;i<2;++i){const int row=i*16+(lane>>2),ch=lane&3; const u32x4 v=*(const u32x4*)(stg8+row*64+ch*16); ATTN_STORE16(Ow8+(long)row*OPITCH+ch*16,v);} }
  else   { bf16*stg=(bf16*)(shm+LDS_OST)+wid*2048;
    #pragma unroll
    for(int r=0;r<16;++r){const int orow=crow(r,hi);
      #pragma unroll
      for(int d0=0;d0<2;++d0)stg[orow*64+d0*32+r32]=__float2bfloat16(o[d0][r]*rli[r]);}
    asm volatile("s_waitcnt lgkmcnt(0)":::"memory");
    #pragma unroll
    for(int i=0;i<4;++i){const int row=i*8+(lane>>3),ch=lane&7; const u32x4 v=*(const u32x4*)(stg+row*64+ch*8); ATTN_STORE16(Ow+(long)row*OPITCH+ch*8,v);} }
  if(ATTN_PRIO_HALF && wid>=4) __builtin_amdgcn_s_setprio(0);
  asm volatile("s_waitcnt lgkmcnt(0)\n\ts_barrier":::"memory");
  #undef DMA_K
  #undef DMA_V
  #undef CMASK
  #undef START
  #undef RESC
  #undef ROT
}
constexpr int ATTN_LDS_BYTES=LDS_BYTES;
#undef SBAR
#undef WAIT_BAR
}

constexpr int NWAVES = 8;
constexpr int BATCH = 32, SEQ = 2048, DM = 1024, NTOK = BATCH * SEQ;
constexpr int EVEN_IN = 2304, ODD_IN = 1536, NE = 16, CAP = 256, DFF = 2048;
constexpr float RMS_EPS = 1e-6f, LOG2E = 1.4426950408889634f, QSCALE = 0.125f * 1.4426950408889634f;

constexpr size_t MiB = 1u << 20;
constexpr size_t WS_CTL = 0, CTL_ZERO_BYTES = 32768;
constexpr size_t WS_TAB = 1 * MiB;
constexpr size_t WS_WIN0 = 2 * MiB, WS_WOUT0 = 7 * MiB, WS_WIN1 = 9 * MiB, WS_WOUT1 = 12 * MiB;
constexpr size_t WS_SELROW = 14 * MiB, WS_GATE = 14 * MiB + 512 * 1024;
constexpr size_t WS_INV = 15 * MiB;
constexpr size_t WS_AFF = 19 * MiB;
constexpr size_t WS_WGU = 24 * MiB;
constexpr size_t WS_WD = 152 * MiB;
constexpr size_t WS_H = 216 * MiB;
constexpr size_t WS_QKV = 344 * MiB;
constexpr size_t WS_Y = 632 * MiB;
constexpr size_t WS_XB = 760 * MiB;
constexpr size_t WS_H8 = 888 * MiB;
constexpr size_t WS_END = 952 * MiB;
constexpr int CW_BAR = 4096;
constexpr int TAB_COS = 0, TAB_SIN = 65536, TAB_ACOS = 131072, TAB_ASIN = 131072 + 1024;

constexpr int RING_OFF = 0, RING_BYTES = 131072;
constexpr int BIAS_OFF = 86016, BIAS_PAD = 64;
constexpr int LDS_BYTES = 159744;
constexpr int LDSCTL_OFF = LDS_BYTES - 512, MISC_OFF = LDSCTL_OFF + 320;
constexpr int NA_SLOT = 16384, NA_XO = 9 * NA_SLOT, NA_XL = NA_XO + 8192, NA_BT = NA_XL + 1024;
static_assert(NA_BT + 2400 <= LDSCTL_OFF, "mixer A LDS map");
static_assert(MISC_OFF + 128 <= LDS_BYTES && attn_body::ATTN_LDS_BYTES <= BIAS_OFF && BIAS_OFF + 4 * (465 + 2 * BIAS_PAD + 64) <= RING_BYTES, "LDS map");

#define GAS __attribute__((address_space(1)))
#define LAS __attribute__((address_space(3)))
typedef unsigned short bf16;
typedef unsigned v4u __attribute__((ext_vector_type(4)));
typedef unsigned v2u __attribute__((ext_vector_type(2)));
typedef float f32x4 __attribute__((ext_vector_type(4)));
typedef GAS unsigned gu32;
#define RLX_AGENT __ATOMIC_RELAXED, __HIP_MEMORY_SCOPE_AGENT
#define LDS_WAIT() asm volatile("s_waitcnt lgkmcnt(0)" ::: "memory")
__device__ __forceinline__ unsigned f2bf(float f) { unsigned u = __builtin_bit_cast(unsigned, f); return (u + 0x7fffu + ((u >> 16) & 1u)) >> 16; }
__device__ __forceinline__ unsigned pk2(float lo, float hi) { return f2bf(lo) | (f2bf(hi) << 16); }
__device__ __forceinline__ float bf_lo(unsigned w) { return __builtin_bit_cast(float, w << 16); }
__device__ __forceinline__ float bf_hi(unsigned w) { return __builtin_bit_cast(float, w & 0xffff0000u); }

#define XB_TMO      128
#define XB_XCNT(j)  (256  + 64 * (j))
#define XB_XSUB(j)  (1280 + 64 * (j))
#define XB_XGEN(j)  (2304 + 64 * (j))
#define XB_TOP      3328
#define XB_TOPGEN   3392
#define XCD_BAR_WORDS 3456
#define XB_SPIN_CAP (1u << 18)

__device__ __forceinline__ unsigned xb_ld(unsigned* p)              { return __hip_atomic_load(p, __ATOMIC_RELAXED, __HIP_MEMORY_SCOPE_AGENT); }
__device__ __forceinline__ unsigned xb_add(unsigned* p, unsigned v) { return __hip_atomic_fetch_add(p, v, __ATOMIC_RELAXED, __HIP_MEMORY_SCOPE_AGENT); }
__device__ __forceinline__ unsigned xb_xcc_id() { return (unsigned)__builtin_amdgcn_s_getreg((3 << 11) | 20) & 0xFu; }
#define XB_SPIN(cond, bar) do { unsigned _sp = 0; while (cond) { __builtin_amdgcn_s_sleep(1); \
    if ((++_sp & 255u) == 0u) { if (xb_ld(&(bar)[XB_TMO])) break; if (_sp > XB_SPIN_CAP) { atomicAdd(&(bar)[XB_TMO], 1u); break; } } } } while (0)

struct XcdBarrier {
    unsigned* bar; unsigned x;
    volatile LAS unsigned* st;
};

__device__ __forceinline__ XcdBarrier xcd_barrier_post(unsigned* bar, volatile LAS unsigned* st) {
    XcdBarrier b; b.bar = bar; b.x = xb_xcc_id(); b.st = st;
    if (threadIdx.x == 0) (void)xb_add(&bar[XB_XCNT(b.x)], 1u);
    return b;
}
__device__ __forceinline__ void xcd_barrier_complete(unsigned* bar, unsigned x, unsigned& nloc, unsigned& nx) {
    const unsigned G = gridDim.x * gridDim.y * gridDim.z;
    unsigned sum, cnt, mine, sp = 0u;
    for (;;) {
        sum = 0u; cnt = 0u; mine = 0u;
#pragma unroll
        for (unsigned j = 0; j < 16; ++j) { const unsigned c = xb_ld(&bar[XB_XCNT(j)]); sum += c; cnt += (c > 0u) ? 1u : 0u; mine = (j == x) ? c : mine; }
        if (sum == G) break;
        __builtin_amdgcn_s_sleep(1);
        if ((++sp & 255u) == 0u) { if (xb_ld(&bar[XB_TMO])) break; if (sp > XB_SPIN_CAP) { atomicAdd(&bar[XB_TMO], 1u); break; } }
    }
    nloc = mine > 0u ? mine : 1u; nx = cnt > 0u ? cnt : 1u;
}

__device__ __forceinline__ void xcd_barrier(const XcdBarrier& b) {
    asm volatile("s_waitcnt vmcnt(0)" ::: "memory");
    __syncthreads();
    if (threadIdx.x == 0) {
        unsigned* bar = b.bar;
        __builtin_amdgcn_s_waitcnt(0);
        unsigned nloc = b.st[0], nx = b.st[1];
        if (nloc == 0u) { xcd_barrier_complete(bar, b.x, nloc, nx); b.st[0] = nloc; b.st[1] = nx; }
        const unsigned old = xb_add(&bar[XB_XSUB(b.x)], 1u);
        const unsigned gen = old / nloc;
        if (old + 1u == (gen + 1u) * nloc) {
            __builtin_amdgcn_fence(__ATOMIC_RELEASE, "agent");
            asm volatile("s_waitcnt vmcnt(0)" ::: "memory");
            const unsigned og = xb_add(&bar[XB_TOP], 1u);
            const unsigned tg = og / nx;
            if (og + 1u == (tg + 1u) * nx) xb_add(&bar[XB_TOPGEN], 1u);
            else XB_SPIN(xb_ld(&bar[XB_TOPGEN]) == tg, bar);
            __builtin_amdgcn_fence(__ATOMIC_ACQUIRE, "agent");
            xb_add(&bar[XB_XGEN(b.x)], 1u);
            asm volatile("s_waitcnt vmcnt(0)" ::: "memory");
        } else {
            XB_SPIN(xb_ld(&bar[XB_XGEN(b.x)]) == gen, bar);
            __builtin_amdgcn_fence(__ATOMIC_ACQUIRE, "agent");
            asm volatile("s_waitcnt vmcnt(0)" ::: "memory");
        }
    }
    __syncthreads();
}

struct Frame {
    LAS unsigned char* lds;
    int tid, lane, wave;
    int vcu, G;
};

__device__ __forceinline__ float wave_sum(float v) {
#pragma unroll
    for (int o = 1; o < 64; o <<= 1) v += __shfl_xor(v, o);
    return v;
}
__device__ __forceinline__ void transpose_item(const float* W, int K, int N, bf16* WT, int k0, int n0, int drow0, LAS float* scr, int lane, int hi_step = 16) {
#pragma unroll 8
    for (int i = 0; i < 32; ++i) { const int kk = 2 * i + (lane >> 5); scr[kk * 33 + (lane & 31)] = W[(size_t)(k0 + kk) * N + n0 + (lane & 31)]; }
    LDS_WAIT(); asm volatile("" ::: "memory");
    const int c = lane & 7;
#pragma unroll
    for (int j = 0; j < 4; ++j) { const int n = (lane >> 3) + 8 * j; const LAS float* s = scr + (8 * c) * 33 + n;
        v4u o; o.x = pk2(s[0 * 33], s[1 * 33]); o.y = pk2(s[2 * 33], s[3 * 33]); o.z = pk2(s[4 * 33], s[5 * 33]); o.w = pk2(s[6 * 33], s[7 * 33]);
        *(GAS v4u*)(WT + (size_t)(drow0 + (n & 15) + (n >> 4) * hi_step) * K + k0 + 8 * c) = o; }
    LDS_WAIT(); asm volatile("" ::: "memory");
}
__device__ __forceinline__ unsigned pk4_fp8(float a, float b, float c, float d) {
    a = __builtin_amdgcn_fmed3f(a, -448.f, 448.f); b = __builtin_amdgcn_fmed3f(b, -448.f, 448.f); c = __builtin_amdgcn_fmed3f(c, -448.f, 448.f); d = __builtin_amdgcn_fmed3f(d, -448.f, 448.f);
    int w = 0; w = __builtin_amdgcn_cvt_pk_fp8_f32(a, b, w, false); w = __builtin_amdgcn_cvt_pk_fp8_f32(c, d, w, true); return (unsigned)w; }
__device__ __forceinline__ void transpose_item8(const float* W, int K, int N, unsigned char* WT, int k0, int n0, int drow0, LAS float* scr, int lane, int hi_step = 16) {
#pragma unroll 8
    for (int i = 0; i < 32; ++i) { const int kk = 2 * i + (lane >> 5); scr[kk * 33 + (lane & 31)] = W[(size_t)(k0 + kk) * N + n0 + (lane & 31)]; }
    LDS_WAIT(); asm volatile("" ::: "memory");
    const int c = lane & 7;
#pragma unroll
    for (int j = 0; j < 4; ++j) { const int n = (lane >> 3) + 8 * j; const LAS float* s = scr + (8 * c) * 33 + n;
        v2u o; o.x = pk4_fp8(s[0 * 33] * 64.f, s[1 * 33] * 64.f, s[2 * 33] * 64.f, s[3 * 33] * 64.f); o.y = pk4_fp8(s[4 * 33] * 64.f, s[5 * 33] * 64.f, s[6 * 33] * 64.f, s[7 * 33] * 64.f);
        *(GAS v2u*)(WT + (size_t)(drow0 + (n & 15) + (n >> 4) * hi_step) * K + k0 + 8 * c) = o; }
    LDS_WAIT(); asm volatile("" ::: "memory");
}
__device__ __forceinline__ void prep_small_weights(Frame& F, const float* win0, const float* wout0, const float* win1, const float* wout1, unsigned char* ws) {
    int lane_ = F.lane, tid_ = F.tid; asm volatile("" : "+v"(lane_), "+v"(tid_));
    LAS float* scr = (LAS float*)(F.lds + RING_OFF + F.wave * 16384);
    const int gw = F.vcu * NWAVES + F.wave, NGW = F.G * NWAVES;
    constexpr int I0 = 16 * (EVEN_IN / 32), I1 = 16 * (DM / 32), I2 = 16 * (ODD_IN / 32), I3 = 16 * (DM / 32);
    for (int it = gw; it < I0 + I1 + I2 + I3; it += NGW) {
        int r = it; const float* W; bf16* WT; int N;
        if (r < I0) { W = win0; WT = (bf16*)(ws + WS_WIN0); N = EVEN_IN; }
        else if ((r -= I0) < I1) { W = wout0; WT = (bf16*)(ws + WS_WOUT0); N = DM; }
        else if ((r -= I1) < I2) { W = win1; WT = (bf16*)(ws + WS_WIN1); N = ODD_IN; }
        else { r -= I2; W = wout1; WT = (bf16*)(ws + WS_WOUT1); N = DM; }
        const int nblk = N / 32, kb = r / nblk, nb = r % nblk, n0 = 32 * nb;
        if (N == EVEN_IN) transpose_item8(W, DM, N, (unsigned char*)WT, 64 * kb, n0, (n0 & ~255) + 128 * ((n0 >> 5) & 1) + 32 * ((n0 >> 6) & 3), scr, lane_);
        else if (N == ODD_IN) transpose_item8(W, DM, N, (unsigned char*)WT, 64 * kb, n0, (n0 & ~255) + 32 * ((n0 >> 6) & 3) + 16 * ((n0 >> 5) & 1), scr, lane_, 128);
        else transpose_item8(W, DM, N, (unsigned char*)WT, 64 * kb, n0, n0, scr, lane_);
    }
}
__device__ __forceinline__ void xpose8_block(const float* W, int N, unsigned char* WT, int Kb, int k0, int n0, int drow0, int lane, const float sc = 64.f) {
    const int g = lane >> 4, c = lane & 15;
    const GAS f32x4* src = (const GAS f32x4*)(W + (size_t)(k0 + 16 * g) * N + n0 + 4 * c);
    f32x4 v[16];
#pragma unroll
    for (int i = 0; i < 16; ++i) v[i] = __builtin_nontemporal_load(&src[(size_t)i * (N / 4)]);
#pragma unroll
    for (int jn = 0; jn < 4; ++jn) { v4u w;
        w.x = pk4_fp8(v[0][jn] * sc, v[1][jn] * sc, v[2][jn] * sc, v[3][jn] * sc); w.y = pk4_fp8(v[4][jn] * sc, v[5][jn] * sc, v[6][jn] * sc, v[7][jn] * sc);
        w.z = pk4_fp8(v[8][jn] * sc, v[9][jn] * sc, v[10][jn] * sc, v[11][jn] * sc); w.w = pk4_fp8(v[12][jn] * sc, v[13][jn] * sc, v[14][jn] * sc, v[15][jn] * sc);
        *(GAS v4u*)(WT + (size_t)(drow0 + 4 * c + jn) * Kb + k0 + 16 * g) = w; }
}
__device__ __forceinline__ void prep_moe_weights(Frame& F, const float* wg, const float* wu, const float* wd, unsigned char* ws) {
    int lane_ = F.lane; asm volatile("" : "+v"(lane_));
    const int gw = F.vcu * NWAVES + F.wave, NGW = F.G * NWAVES;
    constexpr int IG = (DM / 64) * (DFF / 64), ID = (DFF / 64) * (DM / 64), IE = 2 * IG + ID;
    for (int it = gw; it < 2 * NE * IE; it += NGW) {
        const int e = it / IE; int r = it % IE;
        if (r < 2 * IG) { const int up = r >= IG; r -= up * IG; const int kb = r / (DFF / 64), nb = r % (DFF / 64), n0 = 64 * nb;
            xpose8_block((up ? wu : wg) + (size_t)e * DM * DFF, DFF, ws + WS_WGU + (size_t)e * 4096 * DM, DM, 64 * kb, n0, (n0 >> 7) * 256 + (n0 & 127) + up * 128, lane_, up ? -0.6931471805599453f * 64.f : -1.4426950408889634f * 64.f); }
        else { r -= 2 * IG; const int kb = r / (DM / 64), nb = r % (DM / 64);
            xpose8_block(wd + (size_t)e * DFF * DM, DM, ws + WS_WD + (size_t)e * DM * DFF, DFF, 64 * kb, 64 * nb, 64 * nb, lane_); }
    }
}
__device__ __forceinline__ void prep_moe_layer(Frame& F, const int LY, const float* wg, const float* wu, const float* wd, unsigned char* ws) {
    int lane_ = F.lane; asm volatile("" : "+v"(lane_));
    const int gw = F.vcu * NWAVES + F.wave, NGW = F.G * NWAVES;
    constexpr int IG = (DM / 64) * (DFF / 64), ID = (DFF / 64) * (DM / 64), IE = 2 * IG + ID;
    for (int it = LY * NE * IE + gw; it < (LY + 1) * NE * IE; it += NGW) {
        const int e = it / IE; int r = it % IE;
        if (r < 2 * IG) { const int up = r >= IG; r -= up * IG; const int kb = r / (DFF / 64), nb = r % (DFF / 64), n0 = 64 * nb;
            xpose8_block((up ? wu : wg) + (size_t)e * DM * DFF, DFF, ws + WS_WGU + (size_t)e * 4096 * DM, DM, 64 * kb, n0, (n0 >> 7) * 256 + (n0 & 127) + up * 128, lane_, up ? -0.6931471805599453f * 64.f : -1.4426950408889634f * 64.f); }
        else { r -= 2 * IG; const int kb = r / (DM / 64), nb = r % (DM / 64);
            xpose8_block(wd + (size_t)e * DFF * DM, DM, ws + WS_WD + (size_t)e * DM * DFF, DFF, 64 * kb, 64 * nb, 64 * nb, lane_); }
    }
}
__device__ __forceinline__ void prep_tables(Frame& F, float* tab) {
    int lane_ = F.lane, tid_ = F.tid; asm volatile("" : "+v"(lane_), "+v"(tid_));
    const int gt = F.vcu * (NWAVES * 64) + tid_, NGT = F.G * NWAVES * 64;
    for (int idx = gt; idx < SEQ * 32 + 64 * 16; idx += NGT) {
        if (idx < SEQ * 32) { const int pos = idx >> 5, i = idx & 31; const float inv = powf(10000.0f, -(float)i / 32.0f), ang = (float)pos * inv; ((unsigned*)tab)[idx] = pg8::cvt_pk_bf16(cosf(ang), sinf(ang)); }
        else { const int j = idx - SEQ * 32, pos = j >> 4, i = j & 15; const float inv = powf(10000.0f, -(float)i / 16.0f), ang = (float)pos * inv; ((unsigned*)tab)[65536 + j] = pg8::cvt_pk_bf16(cosf(ang), sinf(ang)); }
    }
}
__device__ __forceinline__ void norm_rows(Frame& F, const float* x, const float* gain, unsigned char* H8) {
    int lane_ = F.lane, tid_ = F.tid; asm volatile("" : "+v"(lane_), "+v"(tid_));
    const int gw = F.vcu * NWAVES + F.wave, NGW = F.G * NWAVES;
    f32x4 gv[4];
#pragma unroll
    for (int j = 0; j < 4; ++j) gv[j] = ((const f32x4*)gain)[lane_ + 64 * j];
    int m0 = 2 * gw; f32x4 nv[2][4];
#pragma unroll
    for (int q = 0; q < 2; ++q)
#pragma unroll
        for (int j = 0; j < 4; ++j) nv[q][j] = m0 < NTOK ? __builtin_nontemporal_load(&((const GAS f32x4*)(x + (size_t)(m0 + q) * DM) + lane_)[64 * j]) : (f32x4){0.f, 0.f, 0.f, 0.f};
    for (; m0 < NTOK; m0 += 2 * NGW) {
        f32x4 v[2][4]; const int mn = m0 + 2 * NGW;
#pragma unroll
        for (int q = 0; q < 2; ++q)
#pragma unroll
            for (int j = 0; j < 4; ++j) v[q][j] = nv[q][j];
        if (mn < NTOK) {
#pragma unroll
            for (int q = 0; q < 2; ++q)
#pragma unroll
                for (int j = 0; j < 4; ++j) nv[q][j] = __builtin_nontemporal_load(&((const GAS f32x4*)(x + (size_t)(mn + q) * DM) + lane_)[64 * j]); }
#pragma unroll
        for (int q = 0; q < 2; ++q) { float s = 0.f;
#pragma unroll
            for (int j = 0; j < 4; ++j) s += (v[q][j].x * v[q][j].x + v[q][j].y * v[q][j].y) + (v[q][j].z * v[q][j].z + v[q][j].w * v[q][j].w);
            const float r = rsqrtf(wave_sum(s) * (1.f / DM) + RMS_EPS);
            GAS unsigned* o4 = (GAS unsigned*)(H8 + (size_t)(m0 + q) * DM) + lane_;
#pragma unroll
            for (int j = 0; j < 4; ++j) { const f32x4 o = v[q][j] * r * gv[j]; o4[64 * j] = pk4_fp8(o.x, o.y, o.z, o.w); } }
    }
}
__device__ __forceinline__ void norm_router_phase(Frame& F, const bf16* x, const float* gain, const float* wr, unsigned char* H8, float* aff) {
    typedef short bf16x8 __attribute__((ext_vector_type(8)));
    int lane_ = F.lane, tid_ = F.tid; asm volatile("" : "+v"(lane_), "+v"(tid_));
    constexpr int WROW = 1032;
    LAS bf16* whi = (LAS bf16*)(F.lds + RING_OFF); LAS bf16* wlo = whi + 16 * WROW; LAS float* gl = (LAS float*)(wlo + 16 * WROW);
    { float wv[32], gk[32];
#pragma unroll
      for (int q = 0; q < 32; ++q) { const int i = tid_ + 512 * q; wv[q] = wr[i]; gk[q] = gain[i >> 4]; }
      const float g0_ = gain[tid_], g1_ = gain[tid_ + 512];
#pragma unroll
      for (int q = 0; q < 32; ++q) { const int i = tid_ + 512 * q, k = i >> 4, e = i & 15; const float w = wv[q] * gk[q]; const unsigned hb = f2bf(w); const float hf = __uint_as_float(hb << 16);
          whi[e * WROW + k] = (bf16)hb; wlo[e * WROW + k] = (bf16)f2bf(w - hf); }
      gl[tid_] = g0_; gl[tid_ + 512] = g1_; }
    LDS_WAIT(); __syncthreads();
    const int gw = F.vcu * NWAVES + F.wave, NGW = F.G * NWAVES, r_ = lane_ & 15, g_ = lane_ >> 4;
    for (int grp = gw; grp < NTOK / 16; grp += NGW) {
        asm volatile("" ::: "memory");
        const int m0 = grp * 16;
        const GAS v4u* xr = (const GAS v4u*)(x + (size_t)(m0 + r_) * DM + 8 * g_);
        v4u xf[32];
#pragma unroll
        for (int s2 = 0; s2 < 32; ++s2) xf[s2] = __builtin_nontemporal_load(&xr[4 * s2]);
        f32x4 acc = (f32x4){0.f, 0.f, 0.f, 0.f}; float ss = 0.f;
#pragma unroll
        for (int s2 = 0; s2 < 32; ++s2) { if ((s2 & 3) == 0) asm volatile("" ::: "memory");     const bf16x8 xa = __builtin_bit_cast(bf16x8, xf[s2]);
            const bf16x8 bh = *(const LAS bf16x8*)(whi + r_ * WROW + 32 * s2 + 8 * g_), bl = *(const LAS bf16x8*)(wlo + r_ * WROW + 32 * s2 + 8 * g_);
            acc = __builtin_amdgcn_mfma_f32_16x16x32_bf16(xa, bh, acc, 0, 0, 0); acc = __builtin_amdgcn_mfma_f32_16x16x32_bf16(xa, bl, acc, 0, 0, 0);
            const v4u w_ = xf[s2]; const unsigned w0 = w_.x, w1 = w_.y, w2 = w_.z, w3 = w_.w;
            const float a0 = bf_lo(w0), a1 = bf_hi(w0), a2 = bf_lo(w1), a3 = bf_hi(w1), a4 = bf_lo(w2), a5 = bf_hi(w2), a6 = bf_lo(w3), a7 = bf_hi(w3);
            ss += ((a0 * a0 + a1 * a1) + (a2 * a2 + a3 * a3)) + ((a4 * a4 + a5 * a5) + (a6 * a6 + a7 * a7)); }
#pragma unroll
        for (int s2 = 0; s2 < 32; ++s2) asm volatile("" : "+v"(xf[s2]));
        ss += __shfl_xor(ss, 16); ss += __shfl_xor(ss, 32);
        const float rr = rsqrtf(ss * (1.f / DM) + RMS_EPS);
        float pe[4], sm[4];
#pragma unroll
        for (int rg = 0; rg < 4; ++rg) { const float lg = acc[rg] * __shfl(rr, 4 * g_ + rg); float mx = lg;
#pragma unroll
            for (int o = 1; o <= 8; o <<= 1) mx = fmaxf(mx, __shfl_xor(mx, o));
            pe[rg] = expf(lg - mx); float su = pe[rg];
#pragma unroll
            for (int o = 1; o <= 8; o <<= 1) su += __shfl_xor(su, o);
            sm[rg] = su; }
        { const int b = m0 >> 11, sq = (m0 & (SEQ - 1)) + 4 * g_;
          *(GAS f32x4*)(aff + ((size_t)(b * NE + r_)) * SEQ + sq) = (f32x4){pe[0] / sm[0], pe[1] / sm[1], pe[2] / sm[2], pe[3] / sm[3]}; }
        GAS v2u* orow = (GAS v2u*)(H8 + (size_t)(m0 + r_) * DM + 8 * g_);
#pragma unroll
        for (int s2 = 0; s2 < 32; ++s2) { if ((s2 & 3) == 0) asm volatile("" ::: "memory"); const v4u w_ = xf[s2]; const unsigned w0 = w_.x, w1 = w_.y, w2 = w_.z, w3 = w_.w;
            const f32x4 g0 = *(const LAS f32x4*)(gl + 32 * s2 + 8 * g_), g1 = *(const LAS f32x4*)(gl + 32 * s2 + 8 * g_ + 4);
            v2u o; o.x = pk4_fp8(bf_lo(w0) * rr * g0.x, bf_hi(w0) * rr * g0.y, bf_lo(w1) * rr * g0.z, bf_hi(w1) * rr * g0.w);
            o.y = pk4_fp8(bf_lo(w2) * rr * g1.x, bf_hi(w2) * rr * g1.y, bf_lo(w3) * rr * g1.z, bf_hi(w3) * rr * g1.w);
            orow[4 * s2] = o; }
    }
    __syncthreads();
}
__device__ __forceinline__ void select_phase(Frame& F, const float* aff, int* selrow, float* gate, int* inv) {
    int lane_ = F.lane, tid_ = F.tid; asm volatile("" : "+v"(lane_), "+v"(tid_));
    LAS unsigned* hist = (LAS unsigned*)(F.lds + RING_OFF);
    LAS unsigned* bc = hist + 256;
    LAS unsigned* wsum = hist + 272;
    for (int u = F.vcu; u < BATCH * NE; u += F.G) {
        const int b = u >> 4, e = u & 15;
        const f32x4 a4 = ((const GAS f32x4*)(aff + (size_t)u * SEQ))[tid_];
        const float a0_ = a4[0], a1_ = a4[1], a2_ = a4[2], a3_ = a4[3];
        unsigned k[4] = {__float_as_uint(a0_), __float_as_uint(a1_), __float_as_uint(a2_), __float_as_uint(a3_)};
        unsigned prefix = 0u, need = CAP;
#pragma unroll
        for (int pass = 0; pass < 4; ++pass) { const int shift = 24 - 8 * pass;
            if (tid_ < 256) hist[tid_] = 0u;
            LDS_WAIT(); __syncthreads();
#pragma unroll
            for (int i = 0; i < 4; ++i) if (pass == 0 || (k[i] >> (shift + 8)) == prefix) __hip_atomic_fetch_add(&hist[(k[i] >> shift) & 255u], 1u, __ATOMIC_RELAXED, __HIP_MEMORY_SCOPE_WORKGROUP);
            LDS_WAIT(); __syncthreads();
            if (F.wave == 0) { unsigned c[4];
#pragma unroll
                for (int i = 0; i < 4; ++i) c[i] = hist[4 * lane_ + i];
                const unsigned sl = (c[0] + c[1]) + (c[2] + c[3]); unsigned suf = sl;
#pragma unroll
                for (int o = 1; o < 64; o <<= 1) { const unsigned t = __shfl_down(suf, o); if (lane_ + o < 64) suf += t; }
                unsigned run = suf - sl;
#pragma unroll
                for (int bi = 3; bi >= 0; --bi) { if (run < need && need <= run + c[bi]) { bc[0] = (prefix << 8) | (unsigned)(4 * lane_ + bi); bc[1] = need - run; } run += c[bi]; }
            }
            LDS_WAIT(); __syncthreads();
            prefix = bc[0]; need = bc[1];
        }
        unsigned cg = 0u, ce = 0u;
#pragma unroll
        for (int i = 0; i < 4; ++i) { cg += (k[i] > prefix) ? 1u : 0u; ce += (k[i] == prefix) ? 1u : 0u; }
        unsigned pk = cg | (ce << 16), inc = pk;
#pragma unroll
        for (int o = 1; o < 64; o <<= 1) { const unsigned t = __shfl_up(inc, o); if (lane_ >= o) inc += t; }
        if (lane_ == 63) wsum[F.wave] = inc;
        LDS_WAIT(); __syncthreads();
        unsigned base = 0u, tot = 0u;
#pragma unroll
        for (int w = 0; w < NWAVES; ++w) { const unsigned t = wsum[w]; if (w < F.wave) base += t; tot += t; }
        const unsigned ex = base + inc - pk; unsigned pg = ex & 0xffffu, pe = ex >> 16; const unsigned ngt = tot & 0xffffu;
#pragma unroll
        for (int i = 0; i < 4; ++i) { const int sq = 4 * tid_ + i; int slot = -1;
            if (k[i] > prefix) { slot = (int)pg; ++pg; } else if (k[i] == prefix) { if (pe < need) slot = (int)(ngt + pe); ++pe; }
            if (slot >= 0) { selrow[(e * BATCH + b) * CAP + slot] = b * SEQ + sq; gate[(e * BATCH + b) * CAP + slot] = __uint_as_float(k[i]); }
            inv[(size_t)(b * SEQ + sq) * NE + e] = slot; }
        LDS_WAIT(); __syncthreads();
    }
}
__device__ __forceinline__ void combine_phase(Frame& F, bf16* x, float* xout, const unsigned char* Y, const int* inv, const float* gain, unsigned char* H8, bool with_norm) {
    int lane_ = F.lane, tid_ = F.tid; asm volatile("" : "+v"(lane_), "+v"(tid_));
    const int gw = F.vcu * NWAVES + F.wave, NGW = F.G * NWAVES;
    f32x4 gv[4];
#pragma unroll
    for (int j = 0; j < 4; ++j) gv[j] = with_norm ? ((const f32x4*)gain)[lane_ + 64 * j] : (f32x4){0.f, 0.f, 0.f, 0.f};
    int m = gw; int niv = -1; v2u nv[4];
    if (m < NTOK) { niv = inv[(size_t)m * NE + (lane_ & 15)];
#pragma unroll
        for (int j = 0; j < 4; ++j) nv[j] = __builtin_nontemporal_load(&((const GAS v2u*)(x + (size_t)m * DM) + lane_)[64 * j]); }
    for (; m < NTOK; m += NGW) {
        const int b = m >> 11, iv = niv, mn = m + NGW;
        f32x4 v[4];
#pragma unroll
        for (int j = 0; j < 4; ++j) { const v2u w_ = nv[j]; v[j] = (f32x4){bf_lo(w_.x), bf_hi(w_.x), bf_lo(w_.y), bf_hi(w_.y)}; }
        if (mn < NTOK) { niv = inv[(size_t)mn * NE + (lane_ & 15)];
#pragma unroll
            for (int j = 0; j < 4; ++j) nv[j] = __builtin_nontemporal_load(&((const GAS v2u*)(x + (size_t)mn * DM) + lane_)[64 * j]); }
        unsigned mask = (unsigned)(__builtin_amdgcn_ballot_w64(iv >= 0) & 0xffffull);
        while (mask) {
            const int e0 = __builtin_ctz(mask); mask &= mask - 1; const bool two = mask != 0u; const int e1 = two ? __builtin_ctz(mask) : e0; if (two) mask &= mask - 1;
            const int s0 = __builtin_amdgcn_readlane(iv, e0), s1 = __builtin_amdgcn_readlane(iv, e1);
            const GAS unsigned* y0 = (const GAS unsigned*)(Y + ((size_t)((e0 * BATCH + b) * CAP + s0)) * DM) + lane_; const GAS unsigned* y1 = (const GAS unsigned*)(Y + ((size_t)((e1 * BATCH + b) * CAP + s1)) * DM) + lane_;
            unsigned w0[4], w1[4];
#pragma unroll
            for (int j = 0; j < 4; ++j) w0[j] = __builtin_nontemporal_load(&y0[64 * j]);
            if (two) {
#pragma unroll
                for (int j = 0; j < 4; ++j) w1[j] = __builtin_nontemporal_load(&y1[64 * j]); }
#pragma unroll
            for (int j = 0; j < 4; ++j) { const auto lo = __builtin_amdgcn_cvt_pk_f32_fp8((int)w0[j], false), hi = __builtin_amdgcn_cvt_pk_f32_fp8((int)w0[j], true);
                v[j].x += lo[0] * 0.0625f; v[j].y += lo[1] * 0.0625f; v[j].z += hi[0] * 0.0625f; v[j].w += hi[1] * 0.0625f; }
            if (two) {
#pragma unroll
                for (int j = 0; j < 4; ++j) { const auto lo = __builtin_amdgcn_cvt_pk_f32_fp8((int)w1[j], false), hi = __builtin_amdgcn_cvt_pk_f32_fp8((int)w1[j], true);
                    v[j].x += lo[0] * 0.0625f; v[j].y += lo[1] * 0.0625f; v[j].z += hi[0] * 0.0625f; v[j].w += hi[1] * 0.0625f; } }
        }
        float s = 0.f;
#pragma unroll
        for (int j = 0; j < 4; ++j) { if (with_norm) { v2u w_; w_.x = pk2(v[j].x, v[j].y); w_.y = pk2(v[j].z, v[j].w); __builtin_nontemporal_store(w_, &((GAS v2u*)(x + (size_t)m * DM) + lane_)[64 * j]); v[j] = (f32x4){bf_lo(w_.x), bf_hi(w_.x), bf_lo(w_.y), bf_hi(w_.y)}; }
            else __builtin_nontemporal_store(v[j], &((GAS f32x4*)(xout + (size_t)m * DM) + lane_)[64 * j]);
            s += (v[j].x * v[j].x + v[j].y * v[j].y) + (v[j].z * v[j].z + v[j].w * v[j].w); }
        if (with_norm) { const float r = rsqrtf(wave_sum(s) * (1.f / DM) + RMS_EPS); GAS unsigned* o4 = (GAS unsigned*)(H8 + (size_t)m * DM) + lane_;
#pragma unroll
            for (int j = 0; j < 4; ++j) { const f32x4 o = v[j] * r * gv[j]; o4[64 * j] = pk4_fp8(o.x, o.y, o.z, o.w); } }
    }
}

__device__ __forceinline__ void na_phase(Frame& F, const bf16* QKVp, bf16* Op, const float* rel_bias) {
    typedef short bf16x8 __attribute__((ext_vector_type(8))); typedef short s16x4 __attribute__((ext_vector_type(4)));
    int tid = F.tid; asm volatile("" : "+v"(tid));
    const int lane = tid & 63, wid = F.wave, g = lane >> 4, lq = lane & 15, iq = wid & 3, gq = wid >> 2;
    const int kb0 = iq < 2 ? 0 : 1;
    LAS unsigned char* L = F.lds; const unsigned ldsbase = (unsigned)(uintptr_t)F.lds;
    LAS float* nbt = (LAS float*)(L + NA_BT);
    const int qc = 16 * iq + lq; int cs = qc - 8; cs = cs < 0 ? 0 : (cs > 48 ? 48 : cs);
    const int dkey = 8 * wid + (lane >> 3), dchunk = (lane & 7) ^ (dkey & 7);
    const size_t dsrc = (size_t)dkey * EVEN_IN + dchunk * 8;
    const unsigned kc1 = (unsigned)(kb0 * 2048 + lq * 128 + ((g ^ (lq & 7)) * 16)), kc2 = (unsigned)(kb0 * 2048 + lq * 128 + (((4 + g) ^ (lq & 7)) * 16));
    unsigned vc[4]; { const int q_ = lq >> 2, p_ = lq & 3, keyl = (4 * g + q_) & 7;
#pragma unroll
        for (int dt = 0; dt < 4; ++dt) vc[dt] = (unsigned)(8192 + kb0 * 2048 + g * 512 + q_ * 128 + (((2 * dt + (p_ >> 1)) ^ keyl) * 16) + (p_ & 1) * 8); }
    const int bc = 16 * kb0 + 4 * g - qc + 15;
    float mk[3][4];
#pragma unroll
    for (int kbi = 0; kbi < 3; ++kbi)
#pragma unroll
        for (int rg = 0; rg < 4; ++rg) mk[kbi][rg] = ((unsigned)(16 * (kb0 + kbi) + 4 * g - cs + rg) < 16u) ? 0.f : -1.0e30f;
#define NA_BAR() asm volatile("s_waitcnt vmcnt(0) lgkmcnt(0)\n\ts_barrier" ::: "memory")
#define NA_BAR4() asm volatile("s_waitcnt vmcnt(4) lgkmcnt(0)\n\ts_barrier" ::: "memory")
#define NA_DMA(kr) do { const unsigned sl_ = (unsigned)__builtin_amdgcn_readfirstlane((int)(ldsbase + (unsigned)(((kr) % 9) * NA_SLOT) + (unsigned)wid * 1024u)); \
        attn_body::glds16(Kb + (size_t)(kr) * 64 * EVEN_IN + dsrc, sl_); attn_body::glds16(Vb + (size_t)(kr) * 64 * EVEN_IN + dsrc, sl_ + 8192u); } while (0)
#define NA_CLAMP(x) ((x) < 0 ? 0 : ((x) > 24 ? 24 : (x)))
#define NA_PAIR(pr) do { f32x4 sb[2]; bf16x8 kfr[2][2]; float bia[2][4]; s16x4 va[4][2]; int kcs[2]; \
          \
        _Pragma("unroll") for (int u2 = 0; u2 < 2; ++u2) { const int n = 2 * (pr) + u2, kri = n / 3, kbi = n % 3; const int kr = rs + kri, kb = kb0 + kbi; \
            const unsigned sk = (unsigned)((kr % 9) * NA_SLOT); const int key = 16 * kb + lq; \
            kfr[u2][0] = *(const LAS bf16x8*)(L + ((sk + kc1) + kbi * 2048)); kfr[u2][1] = *(const LAS bf16x8*)(L + ((sk + kc2) + kbi * 2048)); \
            kcs[u2] = 0; const LAS float* bp = nbt + 64 + (((kr - rq + 7) * 31 + bc) + 16 * kbi); \
            _Pragma("unroll") for (int rg = 0; rg < 4; ++rg) bia[u2][rg] = bp[rg]; \
            _Pragma("unroll") for (int dt = 0; dt < 4; ++dt) va[dt][u2] = attn_body::vtr((attn_body::lds_cptr)(L + ((sk + vc[dt]) + kbi * 2048))); } \
        _Pragma("unroll") for (int u2 = 0; u2 < 2; ++u2) { \
            f32x4 sv; _Pragma("unroll") for (int rg = 0; rg < 4; ++rg) sv[rg] = bia[u2][rg] + mk[(2 * (pr) + u2) % 3][rg];     \
            sv = __builtin_amdgcn_mfma_f32_16x16x32_bf16(kfr[u2][0], qf0, sv, 0, 0, 0); sv = __builtin_amdgcn_mfma_f32_16x16x32_bf16(kfr[u2][1], qf1, sv, 0, 0, 0); \
            _Pragma("unroll") for (int rg = 0; rg < 4; ++rg) sv[rg] = __builtin_amdgcn_exp2f(sv[rg]); \
            lsum4 += sv; sb[u2] = sv; } \
        bf16x8 pb; { const unsigned w0 = pg8::cvt_pk_bf16(sb[0][0], sb[0][1]), w1 = pg8::cvt_pk_bf16(sb[0][2], sb[0][3]), w2 = pg8::cvt_pk_bf16(sb[1][0], sb[1][1]), w3 = pg8::cvt_pk_bf16(sb[1][2], sb[1][3]); \
            pb = __builtin_bit_cast(bf16x8, (v4u){w0, w1, w2, w3}); } \
        _Pragma("unroll") for (int dt = 0; dt < 4; ++dt) { \
            const bf16x8 vf = (bf16x8){va[dt][0][0], va[dt][0][1], va[dt][0][2], va[dt][0][3], va[dt][1][0], va[dt][1][1], va[dt][1][2], va[dt][1][3]}; \
            oacc[dt] = __builtin_amdgcn_mfma_f32_16x16x32_bf16(vf, pb, oacc[dt], 0, 0, 0); } } while (0)
    for (int bh = F.vcu; bh < BATCH * 8; bh += F.G) {
        const int b = bh >> 3, h = bh & 7;
        const bf16* Qb = QKVp + (size_t)b * SEQ * EVEN_IN + 64 * h; const bf16* Kb = Qb + 512; const bf16* Vb = Qb + 1024;
        bf16* Ob = attn_body::O_FP8 ? (bf16*)((unsigned char*)Op + (size_t)b * SEQ * DM + 64 * h) : Op + (size_t)b * SEQ * DM + 64 * h;
        NA_BAR();
        if (tid < 465) nbt[64 + tid] = rel_bias[h * 465 + tid] * LOG2E;
#pragma unroll
        for (int kr = 0; kr < 8; ++kr) NA_DMA(kr);
        bf16x8 qn[2];
#pragma unroll
        for (int s2 = 0; s2 < 2; ++s2) qn[s2] = *(const GAS bf16x8*)(Qb + (size_t)(gq * 64 + qc) * EVEN_IN + 32 * s2 + 8 * g);
        NA_BAR();
        for (int t = 0; t < 16; ++t) {
            const int rq = 2 * t + gq, rs = NA_CLAMP(rq - 4);
            const bf16x8 qf0 = qn[0], qf1 = qn[1];
            f32x4 oacc[4]; f32x4 lsum4 = (f32x4){0.f, 0.f, 0.f, 0.f};
#pragma unroll
            for (int dt = 0; dt < 4; ++dt) oacc[dt] = (f32x4){0.f, 0.f, 0.f, 0.f};
            NA_PAIR(0); NA_PAIR(1); NA_PAIR(2);
            NA_BAR4();
            if (t + 1 < 16) { const int hi0 = NA_CLAMP(2 * t + 1 - 4) + 7, hi1 = NA_CLAMP(2 * t + 3 - 4) + 7;
                for (int kr = hi0 + 1; kr <= hi1; ++kr) NA_DMA(kr);
#pragma unroll
                for (int s2 = 0; s2 < 2; ++s2) qn[s2] = *(const GAS bf16x8*)(Qb + (size_t)((rq + 2) * 64 + qc) * EVEN_IN + 32 * s2 + 8 * g); }
            NA_PAIR(3); NA_PAIR(4); NA_PAIR(5); NA_PAIR(6); NA_PAIR(7); NA_PAIR(8); NA_PAIR(9); NA_PAIR(10); NA_PAIR(11);
            float lsum = (lsum4[0] + lsum4[1]) + (lsum4[2] + lsum4[3]); lsum += __shfl_xor(lsum, 16); lsum += __shfl_xor(lsum, 32);
            const float rl = __builtin_amdgcn_rcpf(lsum);
            if (attn_body::O_FP8) { unsigned char* orow8 = (unsigned char*)Ob + (size_t)(rq * 64 + qc) * DM + 4 * g; const float r16 = rl * 16.f;
#pragma unroll
                for (int dt = 0; dt < 4; ++dt) *(GAS unsigned*)(orow8 + 16 * dt) = pk4_fp8(oacc[dt][0] * r16, oacc[dt][1] * r16, oacc[dt][2] * r16, oacc[dt][3] * r16); }
            else { bf16* orow = Ob + (size_t)(rq * 64 + qc) * DM + 4 * g;
#pragma unroll
                for (int dt = 0; dt < 4; ++dt) { v2u ov; ov.x = pk2(oacc[dt][0] * rl, oacc[dt][1] * rl); ov.y = pk2(oacc[dt][2] * rl, oacc[dt][3] * rl); *(GAS v2u*)(orow + 16 * dt) = ov; } }
        }
    }
    NA_BAR();
#undef NA_PAIR
#undef NA_CLAMP
#undef NA_BAR
#undef NA_BAR4
#undef NA_DMA
}

struct Args { const float* in[20]; float* out; unsigned char* ws; };
__global__ void __launch_bounds__(NWAVES * 64, 2) mega_fwd(Args args) {
    extern __shared__ __attribute__((aligned(16))) unsigned char lds[];
    asm volatile("s_setreg_imm32_b32 hwreg(HW_REG_MODE, 23, 1), 1");
    bool sat_bad; { float big = 1000.f, nbig = -3.0e9f; asm volatile("" : "+v"(big), "+v"(nbig)); const int tw = __builtin_amdgcn_cvt_pk_fp8_f32(big, nbig, 0, false); sat_bad = (tw & 0xffff) != 0xfe7e; }
    Frame F;
    F.lds = (LAS unsigned char*)lds;
    volatile LAS unsigned* MISC = (volatile LAS unsigned*)(F.lds + MISC_OFF);
    F.tid = threadIdx.x; F.lane = F.tid & 63; F.wave = __builtin_amdgcn_readfirstlane(F.tid >> 6);
    F.G = gridDim.x; { const int bx = blockIdx.x; F.vcu = (F.G % 8 == 0) ? (bx % 8) * (F.G / 8) + bx / 8 : bx; }
    unsigned char* ws = args.ws;
    gu32* ctl = (gu32*)(ws + WS_CTL);
    for (int u = F.tid; u < (LDS_BYTES - LDSCTL_OFF) / 4; u += NWAVES * 64) ((LAS unsigned*)(F.lds + LDSCTL_OFF))[u] = 0u;
    __syncthreads();
    XcdBarrier bar = xcd_barrier_post((unsigned*)(ctl + CW_BAR), MISC + 8);
#define GRID_BAR() xcd_barrier(bar)
    const float* x_in = args.in[0]; float* xres = args.out; bf16* XB = (bf16*)(ws + WS_XB);
    bf16* Hb = (bf16*)(ws + WS_H); bf16* QKV = (bf16*)(ws + WS_QKV); unsigned char* HID = ws + WS_QKV; unsigned char* Yb = ws + WS_Y; unsigned char* H8 = ws + WS_H8;
    float* tab = (float*)(ws + WS_TAB); float* aff = (float*)(ws + WS_AFF); int* selrow = (int*)(ws + WS_SELROW); float* gate = (float*)(ws + WS_GATE); int* inv = (int*)(ws + WS_INV);

    prep_small_weights(F, args.in[2], args.in[9], args.in[11], args.in[14], ws);
    prep_tables(F, tab);
    norm_rows(F, x_in, args.in[1], H8);
#if PROBE & 2
    norm_rows(F, x_in, args.in[1], H8);
#endif
    GRID_BAR();

    { constexpr int L = 0;
        const int NQ = L == 0 ? EVEN_IN : ODD_IN;
        { pg8::Gemm g{(const bf16*)H8, (const bf16*)(ws + (L == 0 ? WS_WIN0 : WS_WIN1)), DM / 2, nullptr}; pg8::StaticOrder S; S.init(NTOK, NQ, F.G, (int)blockIdx.x);
          if (L == 0) { pg8::EpiQKV<0> E{QKV, NQ, tab, args.in[3], args.in[4], args.in[6], args.in[7], QSCALE};
            pg8::gemm_phase<pg8::EpiQKV<0>, pg8::StaticOrder, true, false, true>(F.lds + RING_OFF, g, S, E); }
          else { pg8::EpiQKV<1> E{QKV, NQ, tab, args.in[12], args.in[13], args.in[12], args.in[13], QSCALE};
            pg8::gemm_phase<pg8::EpiQKV<1>, pg8::StaticOrder, true, false, true>(F.lds + RING_OFF, g, S, E); } }

        GRID_BAR();
#define O_AT(off) (attn_body::O_FP8 ? (attn_body::bf16*)((unsigned char*)Hb + (off)) : (attn_body::bf16*)Hb + (off))
        if (L == 0) {
            const attn_body::lds_fptr btab = (attn_body::lds_fptr)(F.lds + BIAS_OFF) + BIAS_PAD;
            na_phase(F, QKV, Hb, args.in[5]);
            attn_body::i32x8a qnx_ = {0, 0, 0, 0, 0, 0, 0, 0};
            for (int n = F.vcu, ui_ = 0; n < BATCH * 8 * 8; n += F.G, ++ui_) {
                if (ui_ == 2 * (F.vcu & 3)) prep_moe_layer(F, 0, args.in[17], args.in[18], args.in[19], ws);
                const int grp = n >> 5, j = n & 31, b = grp >> 1, kvh = grp & 1, hp = j >> 4, qb = j & 15, hq = kvh * 4 + 2 * hp;
                const int t0 = 2 * qb - 2 < 0 ? 0 : 2 * qb - 2, t1 = 2 * qb + 3 > 31 ? 31 : 2 * qb + 3;
                const attn_body::bf16* base = (const attn_body::bf16*)QKV + (size_t)b * SEQ * EVEN_IN;
                const float* sk_ = args.in[8] + hq; const float sinkl2 = ((F.wave >> 2) ? sk_[1] : sk_[0]) * LOG2E;
                const int n2 = n + F.G; const bool pre = n2 < BATCH * 8 * 8;
                const int grp2 = n2 >> 5, j2 = n2 & 31, b2 = grp2 >> 1, kvh2 = grp2 & 1, hp2 = j2 >> 4, qb2 = j2 & 15, hq2 = kvh2 * 4 + 2 * hp2, t02 = 2 * qb2 - 2 < 0 ? 0 : 2 * qb2 - 2;
                const char* base2 = (const char*)((const attn_body::bf16*)QKV + (size_t)(pre ? b2 : b) * SEQ * EVEN_IN);
                attn_body::attn_unit<1, EVEN_IN, 8>(attn_body::QK_FP8 ? (const attn_body::bf16*)((const char*)base + 3072 + 64 * hq) : base + 1536 + 64 * hq, attn_body::QK_FP8 ? (const attn_body::bf16*)((const char*)base + 4096 + 64 * kvh) : base + 2048 + 64 * kvh,
                                                    attn_body::QK_FP8 ? (const attn_body::bf16*)((const char*)base + 4352 + 64 * kvh) : base + 2176 + 64 * kvh, O_AT((size_t)b * SEQ * DM + 512 + 64 * hq), 128 * qb, t0, t1 - t0 + 1,
                                                    sinkl2, btab, (char*)lds + RING_OFF, ui_ > 0, pre, (const attn_body::bf16*)(base2 + 3072 + 64 * hq2), (const attn_body::bf16*)(base2 + 4096 + 64 * kvh2), 128 * qb2, t02, &qnx_);
            }
        } else {
            const attn_body::lds_fptr btab = (attn_body::lds_fptr)(F.lds + BIAS_OFF) + BIAS_PAD;
            attn_body::i32x8a qnx_ = {0, 0, 0, 0, 0, 0, 0, 0};
            for (int n = F.vcu, ui_ = 0; n < BATCH * 16 * 8; n += F.G, ++ui_) {
                if (ui_ == 4 * (F.vcu & 3)) prep_moe_layer(F, 1, args.in[17], args.in[18], args.in[19], ws);
                const int grp = n >> 5, j = n & 31, b = grp >> 2, kvh = grp & 3, hq = kvh * 4 + (j >> 3), qb = j & 7;
                const attn_body::bf16* base = (const attn_body::bf16*)QKV + (size_t)b * SEQ * ODD_IN;
                const int n2 = n + F.G; const bool pre = n2 < BATCH * 16 * 8;
                const int grp2 = n2 >> 5, j2 = n2 & 31, b2 = grp2 >> 2, kvh2 = grp2 & 3, hq2 = kvh2 * 4 + (j2 >> 3), qb2 = j2 & 7;
                const char* base2 = (const char*)((const attn_body::bf16*)QKV + (size_t)(pre ? b2 : b) * SEQ * ODD_IN);
                attn_body::attn_unit<2, ODD_IN, 8>(attn_body::QK_FP8 ? (const attn_body::bf16*)((const char*)base + 64 * hq) : base + 64 * hq, attn_body::QK_FP8 ? (const attn_body::bf16*)((const char*)base + 2048 + 64 * kvh) : base + 1024 + 64 * kvh, attn_body::QK_FP8 ? (const attn_body::bf16*)((const char*)base + 2560 + 64 * kvh) : base + 1280 + 64 * kvh, O_AT((size_t)b * SEQ * DM + 64 * hq), 256 * qb, 0, 32, 0.f, btab, (char*)lds + RING_OFF,
                                                   ui_ > 0, pre, (const attn_body::bf16*)(base2 + 64 * hq2), (const attn_body::bf16*)(base2 + 2048 + 64 * kvh2), 256 * qb2, 0, &qnx_);
            }
        }

        GRID_BAR();
        { pg8::Gemm g{Hb, (const bf16*)(ws + (L == 0 ? WS_WOUT0 : WS_WOUT1)), DM / 2, nullptr, 0x7b7b7b7b}; pg8::StaticOrder S; S.init(NTOK, DM, F.G, (int)blockIdx.x);
          if (L == 0) { pg8::EpiRes<false> E{(const void*)x_in, XB, DM}; pg8::gemm_phase<pg8::EpiRes<false>, pg8::StaticOrder, true, false, true>(F.lds + RING_OFF, g, S, E); }
          else { pg8::EpiRes<true> E{(const void*)XB, XB, DM}; pg8::gemm_phase<pg8::EpiRes<true>, pg8::StaticOrder, true, false, true>(F.lds + RING_OFF, g, S, E); } }

        GRID_BAR();
        norm_router_phase(F, XB, args.in[15] + L * DM, args.in[16] + (size_t)L * DM * NE, H8, aff);
        GRID_BAR();
        select_phase(F, aff, selrow, gate, inv);


        GRID_BAR();
        { pg8::Gemm g{(const bf16*)H8, (const bf16*)(ws + WS_WGU + (size_t)L * NE * 4096 * DM), DM / 2, selrow}; pg8::StaticOrder S; S.init(NE * BATCH * CAP, 2 * DFF, F.G, (int)blockIdx.x, BATCH, BATCH, 0);
          pg8::EpiGU8 E{HID, DFF};
          pg8::gemm_phase<pg8::EpiGU8, pg8::StaticOrder, true, true, true>(F.lds + RING_OFF, g, S, E); }
        GRID_BAR();
        { pg8::Gemm g{(const bf16*)HID, (const bf16*)(ws + WS_WD + (size_t)L * NE * DM * DFF), DFF / 2, nullptr}; pg8::StaticOrder S; S.init(NE * BATCH * CAP, DM, F.G, (int)blockIdx.x, BATCH, BATCH, 0);
          pg8::EpiY E{Yb, DM, gate};
          pg8::gemm_phase<pg8::EpiY, pg8::StaticOrder, true, false, true>(F.lds + RING_OFF, g, S, E); }
        GRID_BAR();
        combine_phase(F, XB, xres, Yb, inv, args.in[10], H8, L == 0);
        if (L == 0) GRID_BAR();
    }
    if (sat_bad) { GRID_BAR(); if (blockIdx.x == 0 && threadIdx.x == 0) xres[0] = __builtin_nanf("");     }
    { constexpr int L = 1;
        const int NQ = L == 0 ? EVEN_IN : ODD_IN;
        { pg8::Gemm g{(const bf16*)H8, (const bf16*)(ws + (L == 0 ? WS_WIN0 : WS_WIN1)), DM / 2, nullptr}; pg8::StaticOrder S; S.init(NTOK, NQ, F.G, (int)blockIdx.x);
          if (L == 0) { pg8::EpiQKV<0> E{QKV, NQ, tab, args.in[3], args.in[4], args.in[6], args.in[7], QSCALE};
            pg8::gemm_phase<pg8::EpiQKV<0>, pg8::StaticOrder, true, false, true>(F.lds + RING_OFF, g, S, E); }
          else { pg8::EpiQKV<1> E{QKV, NQ, tab, args.in[12], args.in[13], args.in[12], args.in[13], QSCALE};
            pg8::gemm_phase<pg8::EpiQKV<1>, pg8::StaticOrder, true, false, true>(F.lds + RING_OFF, g, S, E); } }

        GRID_BAR();
#define O_AT(off) (attn_body::O_FP8 ? (attn_body::bf16*)((unsigned char*)Hb + (off)) : (attn_body::bf16*)Hb + (off))
        if (L == 0) {
            const attn_body::lds_fptr btab = (attn_body::lds_fptr)(F.lds + BIAS_OFF) + BIAS_PAD;
            na_phase(F, QKV, Hb, args.in[5]);
            attn_body::i32x8a qnx_ = {0, 0, 0, 0, 0, 0, 0, 0};
            for (int n = F.vcu, ui_ = 0; n < BATCH * 8 * 8; n += F.G, ++ui_) {
                if (ui_ == 2 * (F.vcu & 3)) prep_moe_layer(F, 0, args.in[17], args.in[18], args.in[19], ws);
                const int grp = n >> 5, j = n & 31, b = grp >> 1, kvh = grp & 1, hp = j >> 4, qb = j & 15, hq = kvh * 4 + 2 * hp;
                const int t0 = 2 * qb - 2 < 0 ? 0 : 2 * qb - 2, t1 = 2 * qb + 3 > 31 ? 31 : 2 * qb + 3;
                const attn_body::bf16* base = (const attn_body::bf16*)QKV + (size_t)b * SEQ * EVEN_IN;
                const float* sk_ = args.in[8] + hq; const float sinkl2 = ((F.wave >> 2) ? sk_[1] : sk_[0]) * LOG2E;
                const int n2 = n + F.G; const bool pre = n2 < BATCH * 8 * 8;
                const int grp2 = n2 >> 5, j2 = n2 & 31, b2 = grp2 >> 1, kvh2 = grp2 & 1, hp2 = j2 >> 4, qb2 = j2 & 15, hq2 = kvh2 * 4 + 2 * hp2, t02 = 2 * qb2 - 2 < 0 ? 0 : 2 * qb2 - 2;
                const char* base2 = (const char*)((const attn_body::bf16*)QKV + (size_t)(pre ? b2 : b) * SEQ * EVEN_IN);
                attn_body::attn_unit<1, EVEN_IN, 8>(attn_body::QK_FP8 ? (const attn_body::bf16*)((const char*)base + 3072 + 64 * hq) : base + 1536 + 64 * hq, attn_body::QK_FP8 ? (const attn_body::bf16*)((const char*)base + 4096 + 64 * kvh) : base + 2048 + 64 * kvh,
                                                    attn_body::QK_FP8 ? (const attn_body::bf16*)((const char*)base + 4352 + 64 * kvh) : base + 2176 + 64 * kvh, O_AT((size_t)b * SEQ * DM + 512 + 64 * hq), 128 * qb, t0, t1 - t0 + 1,
                                                    sinkl2, btab, (char*)lds + RING_OFF, ui_ > 0, pre, (const attn_body::bf16*)(base2 + 3072 + 64 * hq2), (const attn_body::bf16*)(base2 + 4096 + 64 * kvh2), 128 * qb2, t02, &qnx_);
            }
        } else {
            const attn_body::lds_fptr btab = (attn_body::lds_fptr)(F.lds + BIAS_OFF) + BIAS_PAD;
            attn_body::i32x8a qnx_ = {0, 0, 0, 0, 0, 0, 0, 0};
            for (int n = F.vcu, ui_ = 0; n < BATCH * 16 * 8; n += F.G, ++ui_) {
                if (ui_ == 4 * (F.vcu & 3)) prep_moe_layer(F, 1, args.in[17], args.in[18], args.in[19], ws);
                const int grp = n >> 5, j = n & 31, b = grp >> 2, kvh = grp & 3, hq = kvh * 4 + (j >> 3), qb = j & 7;
                const attn_body::bf16* base = (const attn_body::bf16*)QKV + (size_t)b * SEQ * ODD_IN;
                const int n2 = n + F.G; const bool pre = n2 < BATCH * 16 * 8;
                const int grp2 = n2 >> 5, j2 = n2 & 31, b2 = grp2 >> 2, kvh2 = grp2 & 3, hq2 = kvh2 * 4 + (j2 >> 3), qb2 = j2 & 7;
                const char* base2 = (const char*)((const attn_body::bf16*)QKV + (size_t)(pre ? b2 : b) * SEQ * ODD_IN);
                attn_body::attn_unit<2, ODD_IN, 8>(attn_body::QK_FP8 ? (const attn_body::bf16*)((const char*)base + 64 * hq) : base + 64 * hq, attn_body::QK_FP8 ? (const attn_body::bf16*)((const char*)base + 2048 + 64 * kvh) : base + 1024 + 64 * kvh, attn_body::QK_FP8 ? (const attn_body::bf16*)((const char*)base + 2560 + 64 * kvh) : base + 1280 + 64 * kvh, O_AT((size_t)b * SEQ * DM + 64 * hq), 256 * qb, 0, 32, 0.f, btab, (char*)lds + RING_OFF,
                                                   ui_ > 0, pre, (const attn_body::bf16*)(base2 + 64 * hq2), (const attn_body::bf16*)(base2 + 2048 + 64 * kvh2), 256 * qb2, 0, &qnx_);
            }
        }

        GRID_BAR();
        { pg8::Gemm g{Hb, (const bf16*)(ws + (L == 0 ? WS_WOUT0 : WS_WOUT1)), DM / 2, nullptr, 0x7b7b7b7b}; pg8::StaticOrder S; S.init(NTOK, DM, F.G, (int)blockIdx.x);
          if (L == 0) { pg8::EpiRes<false> E{(const void*)x_in, XB, DM}; pg8::gemm_phase<pg8::EpiRes<false>, pg8::StaticOrder, true, false, true>(F.lds + RING_OFF, g, S, E); }
          else { pg8::EpiRes<true> E{(const void*)XB, XB, DM}; pg8::gemm_phase<pg8::EpiRes<true>, pg8::StaticOrder, true, false, true>(F.lds + RING_OFF, g, S, E); } }

        GRID_BAR();
        norm_router_phase(F, XB, args.in[15] + L * DM, args.in[16] + (size_t)L * DM * NE, H8, aff);
        GRID_BAR();
        select_phase(F, aff, selrow, gate, inv);


        GRID_BAR();
        { pg8::Gemm g{(const bf16*)H8, (const bf16*)(ws + WS_WGU + (size_t)L * NE * 4096 * DM), DM / 2, selrow}; pg8::StaticOrder S; S.init(NE * BATCH * CAP, 2 * DFF, F.G, (int)blockIdx.x, BATCH, BATCH, 0);
          pg8::EpiGU8 E{HID, DFF};
          pg8::gemm_phase<pg8::EpiGU8, pg8::StaticOrder, true, true, true>(F.lds + RING_OFF, g, S, E); }
        GRID_BAR();
        { pg8::Gemm g{(const bf16*)HID, (const bf16*)(ws + WS_WD + (size_t)L * NE * DM * DFF), DFF / 2, nullptr}; pg8::StaticOrder S; S.init(NE * BATCH * CAP, DM, F.G, (int)blockIdx.x, BATCH, BATCH, 0);
          pg8::EpiY E{Yb, DM, gate};
          pg8::gemm_phase<pg8::EpiY, pg8::StaticOrder, true, false, true>(F.lds + RING_OFF, g, S, E); }
        GRID_BAR();
        combine_phase(F, XB, xres, Yb, inv, args.in[10], H8, L == 0);
        if (L == 0) GRID_BAR();
    }
    if (sat_bad) { GRID_BAR(); if (blockIdx.x == 0 && threadIdx.x == 0) xres[0] = __builtin_nanf("");     }
#undef GRID_BAR
}

extern "C" void kernel_launch(void* const* d_in, const int* in_sizes, int n_in, void* d_out, int out_size, void* d_ws, size_t ws_size, hipStream_t stream) {
    static int grid = 0;
    if (grid == 0) {
        if (n_in != 20 || in_sizes[0] != NTOK * DM || out_size != NTOK * DM || ws_size < WS_END) { fprintf(stderr, "kernel_launch: unexpected shapes (n_in %d, in0 %d, out %d, ws %zu); nothing launched\n", n_in, n_in > 0 ? in_sizes[0] : -1, out_size, ws_size); grid = -1; return; }
        int dev = 0, cus = 0, per_cu = 0;
        if (hipGetDevice(&dev) != hipSuccess || hipDeviceGetAttribute(&cus, hipDeviceAttributeMultiprocessorCount, dev) != hipSuccess) { fprintf(stderr, "kernel_launch: device query failed\n"); grid = -1; return; }
        if (hipFuncSetAttribute((const void*)mega_fwd, hipFuncAttributeMaxDynamicSharedMemorySize, LDS_BYTES) != hipSuccess) { fprintf(stderr, "kernel_launch: hipFuncSetAttribute failed\n"); grid = -1; return; }
        if (hipOccupancyMaxActiveBlocksPerMultiprocessor(&per_cu, (const void*)mega_fwd, NWAVES * 64, LDS_BYTES) != hipSuccess || per_cu < 1)
            fprintf(stderr, "kernel_launch: note: occupancy query reports %d workgroups per CU\n", per_cu);
        (void)hipGetLastError();
        grid = cus;
    }
    if (grid < 0) return;
    if (hipMemsetAsync((char*)d_ws + WS_CTL, 0, CTL_ZERO_BYTES, stream) != hipSuccess) { fprintf(stderr, "kernel_launch: memset failed\n"); return; }
    Args a{};
    for (int i = 0; i < 20; ++i) a.in[i] = (const float*)d_in[i];
    a.out = (float*)d_out; a.ws = (unsigned char*)d_ws;
    hipLaunchKernelGGL(mega_fwd, dim3(grid), dim3(NWAVES * 64), LDS_BYTES, stream, a);
    const hipError_t le = hipPeekAtLastError();
    if (le != hipSuccess) fprintf(stderr, "kernel_launch: launch failed: %s\n", hipGetErrorName(le));
}
```

```cpp
#include <hip/hip_runtime.h>
#include <hip/hip_bf16.h>
#include <cstdio>
#include <cstdint>
#include <cmath>
#ifndef PROBE
#define PROBE 0
#endif
namespace pg8 {
#define PG8_LAS __attribute__((address_space(3)))
typedef unsigned short bf16_t;
typedef short bf16x8 __attribute__((ext_vector_type(8)));
typedef float f32x4 __attribute__((ext_vector_type(4)));
typedef unsigned u32x4 __attribute__((ext_vector_type(4)));
typedef int i32x4 __attribute__((ext_vector_type(4)));
typedef int i32x8 __attribute__((ext_vector_type(8)));
typedef unsigned u32x2 __attribute__((ext_vector_type(2)));
constexpr int BM = 256, BK = 64, HALF = 128, HTB = HALF * BK * 2  , STAGE_BYTES = 8 * HTB, NXCD = 8, WGM = 8;

__host__ __device__ __forceinline__ int lds_byte(int r, int c) { const int st = (r >> 4) * 2 + (c >> 5), rr = r & 15, cc = c & 31, ob = rr * 64 + cc * 2; return st * 1024 + (ob ^ (((ob >> 9) & 1) << 5)); }
__host__ __device__ __forceinline__ void stage_rc(int b, int& R, int& C) { const int st = b / 1024, sb = b % 1024, swz = sb ^ (((sb >> 9) & 1) << 5); R = (st >> 1) * 16 + swz / 64; C = (st & 1) * 32 + (swz % 64) / 2; }
__host__ __device__ __forceinline__ int perm32(int rho) { const int n = rho >> 4, i = rho & 15; return 8 * (i >> 2) + 4 * n + (i & 3); }

struct Unit { int pm, pn, bt, am; };
struct Gemm { const bf16_t* A; const bf16_t* Bt; int K; const int* gidx; int scx = 0x7f7f7f7f; };

struct StaticOrder {
    int nM, nN, nwg, G, c, ediv, amul, aoff, rev;
    __device__ void init(int M, int N, int G_, int c_, int ediv_ = (1 << 30), int amul_ = 0, int aoff_ = 0, int rev_ = 0) { nM = M / BM; nN = N / BM; nwg = nM * nN; G = G_; c = c_; ediv = ediv_; amul = amul_; aoff = aoff_; rev = rev_; }
    __device__ bool next(int i, Unit& u) const {
        const long L = (long)i * G + c; if (L >= nwg) return false;
        int wgid = (int)L; { const int q = nwg / NXCD, r = nwg % NXCD, xcd = wgid % NXCD, off = wgid / NXCD; wgid = (xcd < r ? xcd * (q + 1) : r * (q + 1) + (xcd - r) * q) + off; }
        const int nig = WGM * nN, gid = wgid / nig, fm = gid * WGM, gsz = (nM - fm) < WGM ? (nM - fm) : WGM;
        u.pm = fm + ((wgid % nig) % gsz); u.pn = (wgid % nig) / gsz; if (rev) u.pm = nM - 1 - u.pm;
        const int e = u.pm / ediv, bl = u.pm - e * ediv; u.bt = e * nN + u.pn; u.am = e * amul + aoff + bl;
        return true;
    }
};

__device__ __forceinline__ unsigned cvt_pk_bf16(float lo, float hi) { unsigned r; asm volatile("v_cvt_pk_bf16_f32 %0, %1, %2" : "=v"(r) : "v"(lo), "v"(hi)); return r; }

__device__ __forceinline__ unsigned pk4_fp8(float a, float b, float c, float d) { int w = 0; w = __builtin_amdgcn_cvt_pk_fp8_f32(a, b, w, false); w = __builtin_amdgcn_cvt_pk_fp8_f32(c, d, w, true); return (unsigned)w; }
struct EpiBf16 {
    static constexpr bool PERM = true;
    bf16_t* O; int ldc;
    __device__ __forceinline__ void operator()(const f32x4 (&acc)[2][2][4][2], const Unit& u, int wr, int wc, int fr, int fq) const {
        const int row0 = u.pm * BM + wr * 64 + fr, col0 = u.pn * BM + wc * 32 + 8 * fq;
#pragma unroll
        for (int ai = 0; ai < 2; ++ai)
#pragma unroll
            for (int m = 0; m < 4; ++m) { bf16_t* rowp = O + (size_t)(row0 + ai * HALF + m * 16) * ldc + col0;
#pragma unroll
                for (int bj = 0; bj < 2; ++bj) { const f32x4 v0 = acc[ai][bj][m][0], v1 = acc[ai][bj][m][1];
                    u32x4 w; w.x = cvt_pk_bf16(v0[0], v0[1]); w.y = cvt_pk_bf16(v0[2], v0[3]); w.z = cvt_pk_bf16(v1[0], v1[1]); w.w = cvt_pk_bf16(v1[2], v1[3]);
                    *(u32x4*)(rowp + bj * HALF) = w; } }
    }
};
template <int LAYER> struct EpiQKV {
    static constexpr bool PERM = true;
    bf16_t* O; int ldc; const float* tab; const float* g0; const float* g1; const float* g2; const float* g3; float qscale;
    template <int KIND, bool F8OUT> __device__ __forceinline__ void body(const f32x4 (&acc)[2][2][4][2], const Unit& u, int wr, int wc, int fr, int fq, const float* gp, const float sc, const int f8col = 0) const {
        const int d0 = LAYER == 0 ? 8 * fq : 32 * (fq >> 1) + 8 * (fq & 1), dstep = LAYER == 0 ? 32 : 16;
        const int row0 = u.pm * BM + wr * 64 + fr, col0 = u.pn * BM + wc * 64 + d0;
        f32x4 gv[2][2];
        if (KIND != 0) {
#pragma unroll
            for (int bj = 0; bj < 2; ++bj)
#pragma unroll
                for (int n = 0; n < 2; ++n) gv[bj][n] = *(const f32x4*)(gp + d0 + dstep * bj + 4 * n) * sc;
        }
        u32x4 tq[4][2][2]; u32x4 w[8][2];
#define QKV_LOADT(ch) do { if (KIND == 2) { _Pragma("unroll") for (int r_ = 0; r_ < 2; ++r_) { const int mm_ = (ch) * 2 + r_; const int s_ = (row0 + (mm_ >> 2) * HALF + (mm_ & 3) * 16) & 2047; const unsigned* tcp; \
            if (LAYER == 0) { tcp = (const unsigned*)tab + s_ * 32 + 8 * fq; } else { const int pos_ = (fq >> 1) ? (s_ & 63) : (s_ >> 6); tcp = (const unsigned*)tab + 65536 + pos_ * 16 + 8 * (fq & 1); } \
            _Pragma("unroll") for (int n = 0; n < 2; ++n) tq[ch][r_][n] = *(const u32x4*)(tcp + 4 * n); } } } while (0)
#define QKV_STORE(mm) do { if constexpr (F8OUT) { unsigned char* rowp_ = (unsigned char*)O + (size_t)(row0 + ((mm) >> 2) * HALF + ((mm) & 3) * 16) * (ldc * 2) + f8col + wc * 64 + d0; \
            *(u32x2*)(rowp_) = (u32x2){w[mm][0].x, w[mm][0].y}; *(u32x2*)(rowp_ + dstep) = (u32x2){w[mm][1].x, w[mm][1].y}; } \
        else { bf16_t* rowp_ = O + (size_t)(row0 + ((mm) >> 2) * HALF + ((mm) & 3) * 16) * ldc + col0; *(u32x4*)(rowp_) = w[mm][0]; *(u32x4*)(rowp_ + dstep) = w[mm][1]; } } while (0)
        QKV_LOADT(0); QKV_LOADT(1);
#pragma unroll
        for (int ch = 0; ch < 4; ++ch) {
#pragma unroll
            for (int r_ = 0; r_ < 2; ++r_) { const int mm = ch * 2 + r_, ai = mm >> 2, m = mm & 3;
                f32x4 x[2][2];
#pragma unroll
                for (int bj = 0; bj < 2; ++bj)
#pragma unroll
                    for (int n = 0; n < 2; ++n) x[bj][n] = acc[ai][bj][m][n];
                if (KIND == 0 && F8OUT) {
#pragma unroll
                    for (int bj = 0; bj < 2; ++bj)
#pragma unroll
                        for (int n = 0; n < 2; ++n) x[bj][n] = x[bj][n] * sc;
                }
                if (KIND != 0) {
                    float ss = 0.f;
#pragma unroll
                    for (int bj = 0; bj < 2; ++bj)
#pragma unroll
                        for (int n = 0; n < 2; ++n) ss += (x[bj][n][0] * x[bj][n][0] + x[bj][n][1] * x[bj][n][1]) + (x[bj][n][2] * x[bj][n][2] + x[bj][n][3] * x[bj][n][3]);
                    { auto p16 = __builtin_amdgcn_permlane16_swap(__float_as_uint(ss), __float_as_uint(ss), false, false); ss = __uint_as_float(p16[0]) + __uint_as_float(p16[1]); }
                    { auto p32 = __builtin_amdgcn_permlane32_swap(__float_as_uint(ss), __float_as_uint(ss), false, false); ss = __uint_as_float(p32[0]) + __uint_as_float(p32[1]); }
                    const float rr = __builtin_amdgcn_rsqf(ss * (1.f / 64.f) + 1e-6f);
#pragma unroll
                    for (int bj = 0; bj < 2; ++bj)
#pragma unroll
                        for (int n = 0; n < 2; ++n) x[bj][n] = x[bj][n] * rr * gv[bj][n];
                    if (KIND == 2) {
#pragma unroll
                        for (int n = 0; n < 2; ++n) { const unsigned q0 = tq[ch][r_][n].x, q1 = tq[ch][r_][n].y, q2 = tq[ch][r_][n].z, q3 = tq[ch][r_][n].w;
                            const f32x4 c = (f32x4){__uint_as_float(q0 << 16), __uint_as_float(q1 << 16), __uint_as_float(q2 << 16), __uint_as_float(q3 << 16)};
                            const f32x4 sn = (f32x4){__uint_as_float(q0 & 0xffff0000u), __uint_as_float(q1 & 0xffff0000u), __uint_as_float(q2 & 0xffff0000u), __uint_as_float(q3 & 0xffff0000u)};
                            const f32x4 x1 = x[0][n], x2 = x[1][n];
                            x[0][n] = x1 * c - x2 * sn; x[1][n] = x1 * sn + x2 * c; }
                    }
                }
#pragma unroll
                for (int bj = 0; bj < 2; ++bj) { const f32x4 v0 = x[bj][0], v1 = x[bj][1];
                    if constexpr (F8OUT) { w[mm][bj].x = pk4_fp8(v0[0], v0[1], v0[2], v0[3]); w[mm][bj].y = pk4_fp8(v1[0], v1[1], v1[2], v1[3]); w[mm][bj].z = 0u; w[mm][bj].w = 0u; }
                    else { w[mm][bj].x = cvt_pk_bf16(v0[0], v0[1]); w[mm][bj].y = cvt_pk_bf16(v0[2], v0[3]); w[mm][bj].z = cvt_pk_bf16(v1[0], v1[1]); w[mm][bj].w = cvt_pk_bf16(v1[2], v1[3]); } }
            }
            if (ch == 0) { QKV_LOADT(2); QKV_LOADT(3); }
            QKV_STORE(2 * ch); QKV_STORE(2 * ch + 1);
        }
#undef QKV_LOADT
#undef QKV_STORE
    }
    __device__ __forceinline__ void operator()(const f32x4 (&acc)[2][2][4][2], const Unit& u, int wr, int wc, int fr, int fq) const {
        int kind; const float* gp; float sc = 1.f; int f8col = 0;
        if (LAYER == 0) { const int pn = u.pn;
            if (pn < 2) { kind = 1; gp = g0; sc = qscale; } else if (pn < 4) { kind = 1; gp = g1; } else if (pn < 6) { kind = 0; gp = g0; }
            else if (pn < 8) { kind = 2; gp = g2; sc = qscale * 16.f; f8col = 3072 + (pn - 6) * 256; } else if (wc < 2) { kind = 2; gp = g3; f8col = 4096; } else { kind = 0; gp = g0; sc = 8.f; f8col = 4224; } }
        if (LAYER != 0) { const int pn = u.pn; const bool isq = pn < 4, isk = pn == 4;
            kind = (isq || isk) ? 2 : 0; gp = isk ? g1 : g0; sc = isq ? qscale * 16.f : (isk ? 1.f : 8.f); f8col = isq ? pn * 256 : (isk ? 2048 : 2560); }
        if (kind == 2) body<2, true>(acc, u, wr, wc, fr, fq, gp, sc, f8col);
        else if (LAYER == 0 && kind == 1) body<1, false>(acc, u, wr, wc, fr, fq, gp, sc);
        else if (f8col != 0) body<0, true>(acc, u, wr, wc, fr, fq, gp, sc, f8col);
        else body<0, false>(acc, u, wr, wc, fr, fq, gp, sc);
    }
};
struct EpiGU {
    static constexpr bool PERM = true;
    bf16_t* Hd; int ldh;
    __device__ __forceinline__ void operator()(const f32x4 (&acc)[2][2][4][2], const Unit& u, int wr, int wc, int fr, int fq) const {
        const int row0 = u.pm * BM + wr * 64 + fr, col0 = u.pn * HALF + wc * 32 + 8 * fq;
#pragma unroll
        for (int ai = 0; ai < 2; ++ai)
#pragma unroll
            for (int m = 0; m < 4; ++m) { bf16_t* rowp = Hd + (size_t)(row0 + ai * HALF + m * 16) * ldh + col0; float h[8];
#pragma unroll
                for (int n = 0; n < 2; ++n)
#pragma unroll
                    for (int j = 0; j < 4; ++j) { const float gv = acc[ai][0][m][n][j], uv = acc[ai][1][m][n][j];
                        const float sg = gv * __builtin_amdgcn_rcpf(1.0f + __builtin_amdgcn_exp2f(-1.4426950408889634f * gv)); h[n * 4 + j] = sg * uv; }
                u32x4 w; w.x = cvt_pk_bf16(h[0], h[1]); w.y = cvt_pk_bf16(h[2], h[3]); w.z = cvt_pk_bf16(h[4], h[5]); w.w = cvt_pk_bf16(h[6], h[7]);
                *(u32x4*)rowp = w; }
    }
};
struct EpiGU8 {
    static constexpr bool PERM = true;
    unsigned char* Hd; int ldh;
    __device__ __forceinline__ void operator()(const f32x4 (&acc)[2][2][4][2], const Unit& u, int wr, int wc, int fr, int fq) const {
        const int row0 = u.pm * BM + wr * 64 + fr, col0 = u.pn * HALF + wc * 32 + 8 * fq;
#pragma unroll
        for (int ai = 0; ai < 2; ++ai)
#pragma unroll
            for (int m = 0; m < 4; ++m) { unsigned char* rowp = Hd + (size_t)(row0 + ai * HALF + m * 16) * ldh + col0; float h[8];
#pragma unroll
                for (int n = 0; n < 2; ++n)
#pragma unroll
                    for (int j = 0; j < 4; ++j) { const float gv = acc[ai][0][m][n][j], uv = acc[ai][1][m][n][j];
                        h[n * 4 + j] = (gv * uv) * __builtin_amdgcn_rcpf(1.0f + __builtin_amdgcn_exp2f(gv)); }
                u32x2 w; w.x = pk4_fp8(h[0], h[1], h[2], h[3]); w.y = pk4_fp8(h[4], h[5], h[6], h[7]);
                *(u32x2*)rowp = w; }
    }
};
struct EpiY {
    static constexpr bool PERM = true;
    unsigned char* Y; int ldc; const float* gate;
    __device__ __forceinline__ void operator()(const f32x4 (&acc)[2][2][4][2], const Unit& u, int wr, int wc, int fr, int fq) const {
        const int row0 = u.am * BM + wr * 64 + fr, col0 = u.pn * BM + wc * 32 + 8 * fq;
        float gs[2][4];
#pragma unroll
        for (int ai = 0; ai < 2; ++ai)
#pragma unroll
            for (int m = 0; m < 4; ++m) gs[ai][m] = gate[row0 + ai * HALF + m * 16];
#pragma unroll
        for (int ai = 0; ai < 2; ++ai)
#pragma unroll
            for (int m = 0; m < 4; ++m) { const int row = row0 + ai * HALF + m * 16; const float g16 = gs[ai][m] * 16.0f; unsigned char* rowp = Y + (size_t)row * ldc + col0;
#pragma unroll
                for (int bj = 0; bj < 2; ++bj) { const f32x4 v0 = acc[ai][bj][m][0] * g16, v1 = acc[ai][bj][m][1] * g16;
                    u32x2 w; w.x = pk4_fp8(v0[0], v0[1], v0[2], v0[3]); w.y = pk4_fp8(v1[0], v1[1], v1[2], v1[3]);
                    *(u32x2*)(rowp + bj * HALF) = w; } }
    }
};
template <bool RES_BF16> struct EpiRes {
    static constexpr bool PERM = true;
    const void* res; bf16_t* out; int ldc;
    __device__ __forceinline__ void operator()(const f32x4 (&acc)[2][2][4][2], const Unit& u, int wr, int wc, int fr, int fq) const {
        const int row0 = u.pm * BM + wr * 64 + fr, col0 = u.pn * BM + wc * 32 + 8 * fq;
        if constexpr (RES_BF16) {
            u32x4 w[2][4][2];
#pragma unroll
            for (int ai = 0; ai < 2; ++ai)
#pragma unroll
                for (int m = 0; m < 4; ++m) { const size_t off = (size_t)(row0 + ai * HALF + m * 16) * ldc + col0;
#pragma unroll
                    for (int bj = 0; bj < 2; ++bj) w[ai][m][bj] = __builtin_nontemporal_load((const u32x4*)((const bf16_t*)res + off + bj * HALF)); }
#pragma unroll
            for (int ai = 0; ai < 2; ++ai)
#pragma unroll
                for (int m = 0; m < 4; ++m) { const size_t off = (size_t)(row0 + ai * HALF + m * 16) * ldc + col0;
#pragma unroll
                    for (int bj = 0; bj < 2; ++bj) { const unsigned wx = w[ai][m][bj].x, wy = w[ai][m][bj].y, wz = w[ai][m][bj].z, ww = w[ai][m][bj].w;
                        const f32x4 r0 = (f32x4){__uint_as_float(wx << 16), __uint_as_float(wx & 0xffff0000u), __uint_as_float(wy << 16), __uint_as_float(wy & 0xffff0000u)};
                        const f32x4 r1 = (f32x4){__uint_as_float(wz << 16), __uint_as_float(wz & 0xffff0000u), __uint_as_float(ww << 16), __uint_as_float(ww & 0xffff0000u)};
                        const f32x4 v0 = r0 + acc[ai][bj][m][0], v1 = r1 + acc[ai][bj][m][1];
                        u32x4 o; o.x = cvt_pk_bf16(v0[0], v0[1]); o.y = cvt_pk_bf16(v0[2], v0[3]); o.z = cvt_pk_bf16(v1[0], v1[1]); o.w = cvt_pk_bf16(v1[2], v1[3]);
                        *(u32x4*)(out + off + bj * HALF) = o; } }
        } else {
            f32x4 r[2][4][2][2]; u32x4 o[4][2];
#pragma unroll
            for (int m = 0; m < 4; ++m) { const size_t off = (size_t)(row0 + m * 16) * ldc + col0;
#pragma unroll
                for (int bj = 0; bj < 2; ++bj) { r[0][m][bj][0] = __builtin_nontemporal_load((const f32x4*)((const float*)res + off + bj * HALF)); r[0][m][bj][1] = __builtin_nontemporal_load((const f32x4*)((const float*)res + off + bj * HALF + 4)); } }
#pragma unroll
            for (int m = 0; m < 4; ++m)
#pragma unroll
                for (int bj = 0; bj < 2; ++bj) { const f32x4 v0 = r[0][m][bj][0] + acc[0][bj][m][0], v1 = r[0][m][bj][1] + acc[0][bj][m][1];
                    o[m][bj].x = cvt_pk_bf16(v0[0], v0[1]); o[m][bj].y = cvt_pk_bf16(v0[2], v0[3]); o[m][bj].z = cvt_pk_bf16(v1[0], v1[1]); o[m][bj].w = cvt_pk_bf16(v1[2], v1[3]); }
#pragma unroll
            for (int m = 0; m < 4; ++m) { const size_t off = (size_t)(row0 + HALF + m * 16) * ldc + col0;
#pragma unroll
                for (int bj = 0; bj < 2; ++bj) { r[1][m][bj][0] = __builtin_nontemporal_load((const f32x4*)((const float*)res + off + bj * HALF)); r[1][m][bj][1] = __builtin_nontemporal_load((const f32x4*)((const float*)res + off + bj * HALF + 4)); } }
#pragma unroll
            for (int m = 0; m < 4; ++m) { const size_t off = (size_t)(row0 + m * 16) * ldc + col0;
#pragma unroll
                for (int bj = 0; bj < 2; ++bj) *(u32x4*)(out + off + bj * HALF) = o[m][bj]; }
#pragma unroll
            for (int m = 0; m < 4; ++m) { const size_t off = (size_t)(row0 + HALF + m * 16) * ldc + col0;
#pragma unroll
                for (int bj = 0; bj < 2; ++bj) { const f32x4 v0 = r[1][m][bj][0] + acc[1][bj][m][0], v1 = r[1][m][bj][1] + acc[1][bj][m][1];
                    u32x4 q; q.x = cvt_pk_bf16(v0[0], v0[1]); q.y = cvt_pk_bf16(v0[2], v0[3]); q.z = cvt_pk_bf16(v1[0], v1[1]); q.w = cvt_pk_bf16(v1[2], v1[3]);
                    *(u32x4*)(out + off + bj * HALF) = q; } }
        }
    }
};

template <class Epi, class Sched, bool ALIGN_EPI, bool GATHER, bool F8 = false>
__device__ __forceinline__ void gemm_phase(PG8_LAS unsigned char* lds, const Gemm g, const Sched& S, const Epi& E) {
    int tid = threadIdx.x; asm volatile("" : "+v"(tid));
    const int wid = __builtin_amdgcn_readfirstlane(tid >> 6), lane = tid & 63, wr = wid >> 2, wc = wid & 3, fr = lane & 15, fq = lane >> 4;
    const int K = g.K, nt = K / BK;
    unsigned voffA[2], voffB[2], gC[2]; int gR[2];
#pragma unroll
    for (int i = 0; i < 2; ++i) { int R, C; stage_rc(tid * 16 + i * 8192, R, C); const int Rb = Epi::PERM ? ((R & ~31) + perm32(R & 31)) : R;
        voffA[i] = (unsigned)(R * K + C) * 2u; voffB[i] = (unsigned)(Rb * K + C) * 2u; gR[i] = R; gC[i] = (unsigned)C * 2u; }
    const size_t kstep = (size_t)(BK * 2);
    const size_t hstep = (size_t)HALF * K * 2;
    const size_t tstep = 2 * hstep;
    const unsigned K2 = (unsigned)K * 2u;
    const unsigned ldsw = (unsigned)wid * 1024u;
    const unsigned ldsbase = (unsigned)__builtin_amdgcn_readfirstlane((int)((unsigned)(uintptr_t)lds + ldsw));
    const int aoff = lds_byte(wr * 64 + fr, fq * 8), boff = lds_byte(wc * 32 + fr, fq * 8);
#define PG8_SA(b, h) (((b) * 2 + (h)) * HTB)
#define PG8_SB(b, h) ((4 + (b) * 2 + (h)) * HTB)
#define PG8_STAGE(bufoff, gbase, voff) do { _Pragma("unroll") for (int _i = 0; _i < 2; ++_i) \
        asm volatile("s_mov_b32 m0, %2\n\ts_nop 0\n\tglobal_load_lds_dwordx4 %0, %1" :: "v"((voff)[_i]), "s"((const char*)(gbase)), "s"(ldsbase + (unsigned)((bufoff) + _i * 8192)) : "memory", "m0"); } while (0)
#define PG8_STAGE_A(bufoff, kptr, h, VG) do { if constexpr (GATHER) { PG8_STAGE(bufoff, kptr, (VG)[h]); } else { PG8_STAGE(bufoff, (kptr) + (h) * hstep, voffA); } } while (0)
#define PG8_LD8(p) __builtin_shufflevector(*(const PG8_LAS i32x4*)(p), *(const PG8_LAS i32x4*)((p) + 1024), 0, 1, 2, 3, 4, 5, 6, 7)
#define PG8_LDA(dst, b, h) do { if constexpr (F8) { _Pragma("unroll") for (int m = 0; m < 4; ++m) dst##8[m] = PG8_LD8(lds + PG8_SA(b, h) + aoff + m * 2048); } \
        else { _Pragma("unroll") for (int m = 0; m < 4; ++m) _Pragma("unroll") for (int k = 0; k < 2; ++k) dst[m][k] = *(const PG8_LAS bf16x8*)(lds + PG8_SA(b, h) + aoff + m * 2048 + k * 1024); } } while (0)
#define PG8_LDB(dst, b, h) do { if constexpr (F8) { _Pragma("unroll") for (int n = 0; n < 2; ++n) dst##8[n] = PG8_LD8(lds + PG8_SB(b, h) + boff + n * 2048); } \
        else { _Pragma("unroll") for (int n = 0; n < 2; ++n) _Pragma("unroll") for (int k = 0; k < 2; ++k) dst[n][k] = *(const PG8_LAS bf16x8*)(lds + PG8_SB(b, h) + boff + n * 2048 + k * 1024); } } while (0)
#define PG8_MMA(ai, bj, At, Bt, Z) do { __builtin_amdgcn_s_setprio(1); _Pragma("unroll") for (int m = 0; m < 4; ++m) _Pragma("unroll") for (int n = 0; n < 2; ++n) { \
        if constexpr (F8) { if (Z) asm volatile("v_mfma_scale_f32_16x16x128_f8f6f4 %0, %1, %2, 0, %3, %4 op_sel_hi:[0,0,0]" : "=&v"(acc[ai][bj][m][n]) : "v"(Bt##8[n]), "v"(At##8[m]), "v"(sc_w), "v"(sc_x));   \
            else asm volatile("v_mfma_scale_f32_16x16x128_f8f6f4 %0, %1, %2, %0, %3, %4 op_sel_hi:[0,0,0]" : "+v"(acc[ai][bj][m][n]) : "v"(Bt##8[n]), "v"(At##8[m]), "v"(sc_w), "v"(sc_x)); } \
        else { if (Z) acc[ai][bj][m][n] = (f32x4){0.f, 0.f, 0.f, 0.f}; _Pragma("unroll") for (int k = 0; k < 2; ++k) acc[ai][bj][m][n] = __builtin_amdgcn_mfma_f32_16x16x32_bf16(Bt[n][k], At[m][k], acc[ai][bj][m][n], 0, 0, 0); } } \
        __builtin_amdgcn_s_setprio(0); } while (0)
#define PG8_WAIT_V(n) asm volatile("s_waitcnt vmcnt(" #n ")" ::: "memory")
#define PG8_WAIT_L(n) asm volatile("s_waitcnt lgkmcnt(" #n ")" ::: "memory")
#define PG8_BAR __builtin_amdgcn_s_barrier()
#define PG8_SCHED __builtin_amdgcn_sched_barrier(0)
    Unit cur, nxt; int ui = 0;
    if (!S.next(0, cur)) return;
    f32x4 acc[2][2][4][2];
    bf16x8 At[4][2], B0[2][2], B1[2][2]; i32x8 At8[4], B08[2], B18[2];
    int sc_w = 0x79797979, sc_x = g.scx; if constexpr (F8) asm volatile("" : "+v"(sc_w), "+v"(sc_x));
    unsigned vGc[2][2] = {{0u, 0u}, {0u, 0u}}, vGn[2][2] = {{0u, 0u}, {0u, 0u}};
    if constexpr (GATHER) {
        Unit t1; const bool h1 = S.next(1, t1);
#pragma unroll
        for (int h = 0; h < 2; ++h)
#pragma unroll
            for (int i = 0; i < 2; ++i) { vGc[h][i] = (unsigned)g.gidx[cur.am * BM + h * HALF + gR[i]] * K2 + gC[i];
                vGn[h][i] = h1 ? (unsigned)g.gidx[t1.am * BM + h * HALF + gR[i]] * K2 + gC[i] : vGc[h][i]; }
    }
    const char* cA = GATHER ? (const char*)g.A : (const char*)g.A + (size_t)cur.pm * tstep; const char* cB = (const char*)g.Bt + (size_t)cur.bt * tstep;
    PG8_STAGE(PG8_SB(0, 0), cB, voffB); PG8_STAGE(PG8_SB(0, 1), cB + hstep, voffB); PG8_STAGE_A(PG8_SA(0, 0), cA, 0, vGc); PG8_STAGE_A(PG8_SA(0, 1), cA, 1, vGc);
    if (wr == 1) PG8_BAR;
    PG8_WAIT_V(2); PG8_BAR;
    PG8_STAGE(PG8_SB(1, 0), cB + kstep, voffB); PG8_STAGE_A(PG8_SA(1, 0), cA + kstep, 0, vGc); PG8_STAGE(PG8_SB(1, 1), cB + hstep + kstep, voffB);
    PG8_WAIT_V(6); PG8_BAR;
    for (;;) {
        const bool has_next = S.next(ui + 1, nxt);
        const char* nA = has_next ? (GATHER ? (const char*)g.A : (const char*)g.A + (size_t)nxt.pm * tstep) : cA; const char* nB = has_next ? (const char*)g.Bt + (size_t)nxt.bt * tstep : cB;
#define PG8_ITER(t, Z) do { \
            const bool last = ((t) == nt - 2); \
            const char* a1 = cA + (size_t)((t) + 1) * kstep;                                             \
            const char* a2 = last ? nA : cA + (size_t)((t) + 2) * kstep; const char* b2 = last ? nB : cB + (size_t)((t) + 2) * kstep;     \
            const char* a3 = a2 + kstep; const char* b3 = b2 + kstep;                                \
            unsigned vGs[2][2] = {{0u, 0u}, {0u, 0u}}; \
            if constexpr (GATHER) { const bool usen = last && has_next; \
                _Pragma("unroll") for (int h = 0; h < 2; ++h) _Pragma("unroll") for (int i = 0; i < 2; ++i) vGs[h][i] = usen ? vGn[h][i] : vGc[h][i]; } \
              \
            PG8_LDB(B0, 0, 0); PG8_LDB(B1, 0, 1); PG8_SCHED; PG8_LDA(At, 0, 0); PG8_STAGE_A(PG8_SA(1, 1), a1, 1, vGc); \
            PG8_WAIT_V(8); PG8_WAIT_L(0); PG8_BAR; PG8_MMA(0, 0, At, B0, Z); PG8_MMA(0, 1, At, B1, Z); PG8_BAR; PG8_SCHED; \
              \
            PG8_LDA(At, 0, 1); PG8_STAGE(PG8_SB(0, 0), b2, voffB); PG8_STAGE(PG8_SB(0, 1), b2 + hstep, voffB); PG8_STAGE_A(PG8_SA(0, 0), a2, 0, vGs); \
            PG8_WAIT_V(8); PG8_WAIT_L(0); PG8_BAR; PG8_MMA(1, 0, At, B0, Z); PG8_MMA(1, 1, At, B1, Z); PG8_BAR; PG8_SCHED; \
              \
            PG8_LDB(B0, 1, 0); PG8_LDB(B1, 1, 1); PG8_SCHED; PG8_LDA(At, 1, 0); PG8_STAGE_A(PG8_SA(0, 1), a2, 1, vGs); \
            PG8_WAIT_V(8); PG8_WAIT_L(0); PG8_BAR; PG8_MMA(0, 0, At, B0, false); PG8_MMA(0, 1, At, B1, false); PG8_BAR; PG8_SCHED; \
              \
            PG8_LDA(At, 1, 1); PG8_STAGE(PG8_SB(1, 0), b3, voffB); PG8_STAGE(PG8_SB(1, 1), b3 + hstep, voffB); PG8_STAGE_A(PG8_SA(1, 0), a3, 0, vGs); \
            PG8_WAIT_V(8); PG8_WAIT_L(0); PG8_BAR; PG8_MMA(1, 0, At, B0, false); PG8_MMA(1, 1, At, B1, false); PG8_BAR; PG8_SCHED; } while (0)
        PG8_ITER(0, true);
        for (int t = 2; t < nt; t += 2) PG8_ITER(t, false);
#undef PG8_ITER
        if constexpr (F8) asm volatile("s_nop 15\n\ts_nop 7" ::: "memory");
        if constexpr (ALIGN_EPI) { if (wr == 0) PG8_BAR; }
        int raw[2][2] = {{0, 0}, {0, 0}}; bool has_nn = false;
        if constexpr (GATHER) { Unit nn; has_nn = has_next && S.next(ui + 2, nn);
            if (has_nn) {
#pragma unroll
                for (int h = 0; h < 2; ++h)
#pragma unroll
                    for (int i = 0; i < 2; ++i) raw[h][i] = g.gidx[nn.am * BM + h * HALF + gR[i]]; } }
        E(acc, cur, wr, wc, fr, fq);
        if (!has_next) break;
        if constexpr (GATHER) {
#pragma unroll
            for (int h = 0; h < 2; ++h)
#pragma unroll
                for (int i = 0; i < 2; ++i) { vGc[h][i] = vGn[h][i]; if (has_nn) vGn[h][i] = (unsigned)raw[h][i] * K2 + gC[i]; asm volatile("" : "+v"(vGn[h][i])); } }
        cur = nxt; cA = nA; cB = nB; ++ui;
        if constexpr (ALIGN_EPI) { if (wr == 1) PG8_BAR; }
    }
    PG8_WAIT_V(0);
    if constexpr (!ALIGN_EPI) { if (wr == 0) PG8_BAR; }
    PG8_BAR;
#undef PG8_SA
#undef PG8_SB
#undef PG8_STAGE
#undef PG8_STAGE_A
#undef PG8_LDA
#undef PG8_LDB
#undef PG8_MMA
#undef PG8_WAIT_V
#undef PG8_WAIT_L
#undef PG8_BAR
#undef PG8_SCHED
}
}

namespace attn_body {
using bf16=__hip_bfloat16;
using bf16x8=__attribute__((ext_vector_type(8)))short;
using s16x4=__attribute__((ext_vector_type(4)))short;
using f32x16=__attribute__((ext_vector_type(16)))float;
using u32x4=__attribute__((ext_vector_type(4)))unsigned;
constexpr int D=64,OPITCH=1024;
constexpr int NW=8,QBLK=32,QB=QBLK*NW,KVBLK=64;
__device__ __forceinline__ int crow(int r,int hi){return (r&3)+8*(r>>2)+4*hi;}
#define SBAR() __builtin_amdgcn_sched_barrier(0)
typedef const __attribute__((address_space(3))) float* lds_fptr;
template<int MODE> __device__ __forceinline__ void amask(f32x16&p0,f32x16&p1,int tabs,int q0,int wid,int r32,int hi,lds_fptr btab){
  const float NEG=-INFINITY;
  if(MODE==1){
    const int qw=q0+wid*QBLK,k0=64*tabs;
    if((k0+63-qw<=128)&&(qw+31-k0<=128)) return;
    int base=k0+4*hi-(qw+r32)+128; asm volatile("":"+v"(base));
    #pragma unroll
    for(int r=0;r<16;++r){const int off=(r&3)+8*(r>>2); if((unsigned)(base+off)>256u)p0[r]=NEG; if((unsigned)(base+off+32)>256u)p1[r]=NEG;}
  } else if(MODE==0){
    const int qr=(q0>>6)+(wid>>1),kr=tabs; int rs=qr-4; rs=rs<0?0:(rs>24?24:rs);
    if(kr<rs||kr>=rs+8){
      #pragma unroll
      for(int r=0;r<16;++r){p0[r]=NEG;p1[r]=NEG;}
    } else {
      const int qc=32*(wid&1)+r32; int cs=qc-8; cs=cs<0?0:(cs>48?48:cs);
      int cb=4*hi-cs,tpo=(kr-qr+7)*31+15-qc+4*hi; asm volatile("":"+v"(cb),"+v"(tpo));
      lds_fptr tp=btab+tpo;
      #pragma unroll
      for(int r=0;r<16;++r){const int off=(r&3)+8*(r>>2); const float b0=tp[off],b1=tp[off+32];
        p0[r]=((unsigned)(off+cb)<16u)?p0[r]+b0:NEG; p1[r]=((unsigned)(off+32+cb)<16u)?p1[r]+b1:NEG;}
    }
  }
}
constexpr bool MFREE=true;
constexpr bool ATTN_PRIO_HALF=true;
constexpr bool QK_FP8=true;
using i32x2a=__attribute__((ext_vector_type(2)))int; using i32x4a=__attribute__((ext_vector_type(4)))int; using i32x8a=__attribute__((ext_vector_type(8)))int;
constexpr bool LSUM_MFMA=MFREE;
using f32x4a=__attribute__((ext_vector_type(4)))float;
constexpr bool O_FP8=true;
constexpr int NSLOT=3, SLOTB=8192;
constexpr int LDS_K=0, LDS_V=NSLOT*SLOTB, LDS_WS=2*NSLOT*SLOTB, LDS_OST=LDS_WS+NW*64*4, LDS_BYTES=LDS_OST+NW*4096;
constexpr float C2=0.125f*1.4426950408889634f;
__device__ __forceinline__ void glds16(const void*gsrc,unsigned lds_dst){unsigned keep;
  asm volatile("s_mov_b32 %0, m0\n\ts_mov_b32 m0, %2\n\ts_nop 0\n\tglobal_load_lds_dwordx4 %1, off\n\ts_mov_b32 m0, %0":"=&s"(keep):"v"(gsrc),"s"(lds_dst):"memory");}
__device__ __forceinline__ float max3f(float a,float b,float c){float r;asm("v_max3_f32 %0, %1, %2, %3":"=v"(r):"v"(a),"v"(b),"v"(c));return r;}
__device__ __forceinline__ float max2f(float a,float b){float r;asm("v_max_f32_e32 %0, %1, %2":"=v"(r):"v"(a),"v"(b));return r;}
__device__ __forceinline__ float fadd_s(float a,float b){float r;asm("v_add_f32_e32 %0, %1, %2":"=v"(r):"v"(a),"v"(b));return r;}
__device__ __forceinline__ float fsub_s(float a,float b){float r;asm("v_sub_f32_e32 %0, %1, %2":"=v"(r):"v"(a),"v"(b));return r;}
typedef float f32x2_t __attribute__((ext_vector_type(2))); typedef __bf16 bf16x2_t __attribute__((ext_vector_type(2)));
__device__ __forceinline__ unsigned cvtpk_s(float lo,float hi){f32x2_t v={lo,hi};bf16x2_t b=__builtin_convertvector(v,bf16x2_t);return __builtin_bit_cast(unsigned,b);}
#define WAIT_BAR(N) asm volatile("s_waitcnt vmcnt(" #N ") lgkmcnt(0)\n\ts_barrier":::"memory")

__device__ __forceinline__ void qkt(f32x16&p0,f32x16&p1,const char*Kslot,const bf16x8*qr,const f32x16&negm,int r32,int hi){
  const char*kb=Kslot+hi*1024+r32*16;
  #pragma unroll
  for(int d0=0;d0<4;++d0){
    const bf16x8 b0=*reinterpret_cast<const bf16x8*>(kb+d0*2048);
    const bf16x8 b1=*reinterpret_cast<const bf16x8*>(kb+d0*2048+512);
    if(d0==0){p0=__builtin_amdgcn_mfma_f32_32x32x16_bf16(b0,qr[0],negm,0,0,0);p1=__builtin_amdgcn_mfma_f32_32x32x16_bf16(b1,qr[0],negm,0,0,0);}
    else{p0=__builtin_amdgcn_mfma_f32_32x32x16_bf16(b0,qr[d0],p0,0,0,0);p1=__builtin_amdgcn_mfma_f32_32x32x16_bf16(b1,qr[d0],p1,0,0,0);}}
}
typedef __attribute__((address_space(3))) const char* lds_cptr;
typedef short v4i16_t __attribute__((ext_vector_type(4)));
__device__ __forceinline__ void kload8(bf16x8*kf,lds_cptr kp){
  kf[0]=*(const __attribute__((address_space(3))) bf16x8*)(kp);      kf[1]=*(const __attribute__((address_space(3))) bf16x8*)(kp+512);
  kf[2]=*(const __attribute__((address_space(3))) bf16x8*)(kp+2048); kf[3]=*(const __attribute__((address_space(3))) bf16x8*)(kp+2560);
  kf[4]=*(const __attribute__((address_space(3))) bf16x8*)(kp+4096); kf[5]=*(const __attribute__((address_space(3))) bf16x8*)(kp+4608);
  kf[6]=*(const __attribute__((address_space(3))) bf16x8*)(kp+6144); kf[7]=*(const __attribute__((address_space(3))) bf16x8*)(kp+6656);
}
__device__ __forceinline__ void kload2(bf16x8*kf,lds_cptr kp,int j){ kf[2*j]=*(const __attribute__((address_space(3))) bf16x8*)(kp+j*2048); kf[2*j+1]=*(const __attribute__((address_space(3))) bf16x8*)(kp+j*2048+512); }
__device__ __forceinline__ s16x4 vtr(lds_cptr p){ return __builtin_bit_cast(s16x4,__builtin_amdgcn_ds_read_tr16_b64_v4i16((__attribute__((address_space(3))) v4i16_t*)p)); }
__device__ __forceinline__ float rowmax(const f32x16&p0,const f32x16&p1){
  float a=max3f(p0[0],p0[1],p1[0]),b=max3f(p0[2],p0[3],p1[1]);a=max3f(a,p1[2],p1[3]);
  #pragma unroll
  for(int r=4;r<16;r+=4){a=max3f(a,p0[r],p0[r+1]);b=max3f(b,p0[r+2],p0[r+3]);a=max3f(a,p1[r],p1[r+1]);b=max3f(b,p1[r+2],p1[r+3]);}
  const float m=max2f(a,b);
  auto rr=__builtin_amdgcn_permlane32_swap(__float_as_uint(m),__float_as_uint(m),false,false);
  return max2f(__uint_as_float(rr[0]),__uint_as_float(rr[1]));
}
__device__ __forceinline__ void pv(f32x16*o,int vb,bf16x8 pa0,bf16x8 pa1,bf16x8 pa2,bf16x8 pa3){
  #pragma unroll
  for(int d0=0;d0<2;++d0){s16x4 lo[4],hi[4];
    #pragma unroll
    for(int ks=0;ks<4;++ks){
      asm volatile("ds_read_b64_tr_b16 %0,%1 offset:%c2":"=&v"(lo[ks]):"v"(vb),"i"(d0*4096+ks*1024):"memory");
      asm volatile("ds_read_b64_tr_b16 %0,%1 offset:%c2":"=&v"(hi[ks]):"v"(vb),"i"(d0*4096+ks*1024+512):"memory");}
    asm volatile("s_waitcnt lgkmcnt(0)":::"memory");SBAR();
    #define PK(k) (bf16x8){lo[k][0],lo[k][1],lo[k][2],lo[k][3],hi[k][0],hi[k][1],hi[k][2],hi[k][3]}
    o[d0]=__builtin_amdgcn_mfma_f32_32x32x16_bf16(pa0,PK(0),o[d0],0,0,0);
    o[d0]=__builtin_amdgcn_mfma_f32_32x32x16_bf16(pa1,PK(1),o[d0],0,0,0);
    o[d0]=__builtin_amdgcn_mfma_f32_32x32x16_bf16(pa2,PK(2),o[d0],0,0,0);
    o[d0]=__builtin_amdgcn_mfma_f32_32x32x16_bf16(pa3,PK(3),o[d0],0,0,0);
    #undef PK
  }
}

#ifndef ATTN_STORE16
#define ATTN_STORE16(p,v) (*(u32x4*)(p)=(v))
#endif
template<int MODE,int PITCH,int THRL> __device__ __forceinline__ void attn_unit(const bf16*Qb,const bf16*__restrict__ Kb,const bf16*__restrict__ Vb,bf16*Ob,const int q0,const int t0,const int NT,const float sinkl2,lds_fptr btab,char*shm,
    const bool warm=false,const bool pre=false,const bf16*Qn=nullptr,const bf16*Kn=nullptr,const int q0n=0,const int t0n=0,i32x8a*qnx=nullptr){
  int tid=threadIdx.x; asm volatile("":"+v"(tid)); const int lane=tid&63,r32=lane&31,hi=lane>>5; const int wid=__builtin_amdgcn_readfirstlane(tid>>6);
  constexpr bool QK8=(MODE==2||MODE==1)&&QK_FP8;
  const int wrow=(MODE==1)?(wid&3)*QBLK:wid*QBLK, whead=(MODE==1)?(wid>>2)*D:0;
  const bf16*Qw=Qb+(long)(q0+wrow)*PITCH+whead;
  const bf16*Kh=Kb+(long)t0*KVBLK*PITCH,*Vh=Vb+(long)t0*KVBLK*PITCH;
  const unsigned lds0=(unsigned)(uintptr_t)shm;
  float*wsf=(float*)(shm+LDS_WS)+wid*64;
  const bf16*ksrc=Kh+(long)lane*PITCH+wid*8;
  const char*ksrc8=(const char*)Kb+(long)(t0*KVBLK+lane)*(PITCH*2)+16*(wid&3);
  const bf16*vsrc=Vh+(long)(16*(wid&3)+(lane>>2))*PITCH+(wid>>2)*32+(lane&3)*8;
  const char*vsrc8=(const char*)Vb+(long)(t0*KVBLK+16*(wid&3)+(lane>>2))*(PITCH*2)+16*((lane&3)^((lane>>5)<<1));
  const unsigned kdst=QK8?lds0+LDS_K+(wid&3)*1024:lds0+LDS_K+wid*1024, vdst=QK8?lds0+LDS_V+(wid&3)*1024:lds0+LDS_V+wid*1024;
  #define DMA_K(t,slot) do{ if(QK8){ if(wid<4) glds16(ksrc8+(long)(t)*KVBLK*(PITCH*2),(unsigned)__builtin_amdgcn_readfirstlane(kdst+(slot))); } else glds16(ksrc+(long)(t)*KVBLK*PITCH,(unsigned)__builtin_amdgcn_readfirstlane(kdst+(slot))); }while(0)
  #define DMA_V(t,slot) do{ if(QK8){ if(wid>=4) glds16(vsrc8+(long)(t)*KVBLK*(PITCH*2),(unsigned)__builtin_amdgcn_readfirstlane(vdst+(slot))); } else glds16(vsrc+(long)(t)*KVBLK*PITCH,(unsigned)__builtin_amdgcn_readfirstlane(vdst+(slot))); }while(0)
  const int vb0=(int)(lds0+LDS_V)+((lane>>4)&1)*32+(lane&3)*8+(4*hi+((lane&15)>>2))*64;
  const char*Kbase=shm+LDS_K; bf16x8 kf[8]; i32x8a kf8[2]; i32x8a qr8;
  const lds_cptr shm3=(lds_cptr)shm; const lds_cptr kp0=QK8?shm3+LDS_K+hi*2048+r32*16:shm3+LDS_K+hi*1024+r32*16; const lds_cptr vp0=shm3+LDS_V+((lane>>4)&1)*32+(lane&3)*8+(4*hi+((lane&15)>>2))*64;
  const int k8_=(lane&15)>>1, c8_=lane&1, g8_=(lane>>4)&1, sw8_=(k8_>>2)&1, row8_=(k8_&3)+8*(k8_>>2)+4*hi;
  const lds_cptr vb8a=shm3+LDS_V+row8_*64+((g8_^(sw8_<<1))*16)+8*c8_, vb8b=shm3+LDS_V+row8_*64+(((g8_+2)^(sw8_<<1))*16)+8*c8_;
  i32x8a ones8f; { const int o1=(((lane>>4)&1)==((lane>>3)&1))?0x38383838:0; ones8f=(i32x8a){o1,o1,o1,o1,o1,o1,o1,o1}; asm volatile("":"+v"(ones8f)); }
  if(ATTN_PRIO_HALF && wid>=4) __builtin_amdgcn_s_setprio(1);
  const bool hot=QK8&&warm;
  if(hot){ DMA_V(0,0); } else { DMA_K(0,0);DMA_V(0,0);DMA_K(1,SLOTB); }
  bf16x8 qr[4];
  #pragma unroll
  for(int d0=0;d0<4;++d0)qr[d0]=QK8?bf16x8{}:*reinterpret_cast<const bf16x8*>(&Qw[(long)r32*PITCH+d0*16+hi*8]);
  if(QK8){ if(hot){ qr8=*qnx; } else { const char*qp=(const char*)Qb+(long)(q0+wrow+r32)*(PITCH*2)+whead+32*hi; const i32x4a qa=*(const i32x4a*)qp, qb_=*(const i32x4a*)(qp+16); qr8=__builtin_shufflevector(qa,qb_,0,1,2,3,4,5,6,7); } }
  f32x4a lacc={0.f,0.f,0.f,0.f}; bf16x8 ones8; { const short o1=(short)((((lane>>4)&1)==((lane>>3)&1))?0x3F80:0); ones8=(bf16x8){o1,o1,o1,o1,o1,o1,o1,o1}; asm volatile("":"+v"(ones8)); }
  float mhat=0.f,l_reg=0.f;f32x16 o[2];o[0]=f32x16{};o[1]=f32x16{};f32x16 negm=f32x16{}; if(QK8){ _Pragma("unroll") for(int r=0;r<16;++r) negm[r]=-4.f; } if(MODE==2&&!MFREE) asm volatile("":"+v"(negm));
  const int qrel=wid*QBLK+r32;
  #define CMASK(P0,P1,t) do{ if(MODE!=2) amask<MODE>(P0,P1,t0+(t),q0,(MODE==1)?(wid&3):wid,r32,hi,btab); }while(0)
  bool resc=false;
  #define START(P0,P1) do{ resc=false; if(!MFREE){ const float rm=rowmax(P0,P1); \
      const float dl=__builtin_fmaxf(rm,-64.f); mhat=fadd_s(mhat,dl); \
      _Pragma("unroll") for(int r=0;r<16;++r){P0[r]=fsub_s(P0[r],dl);P1[r]=fsub_s(P1[r],dl);} \
      if(MODE==2){ _Pragma("unroll") for(int r=0;r<16;++r)negm[r]=-mhat; asm volatile("":"+v"(negm)); } } \
    _Pragma("unroll") for(int r=0;r<16;++r)P0[r]=__builtin_amdgcn_exp2f(P0[r]); }while(0)
  #define RESC() do{ if(resc){ asm volatile("s_waitcnt lgkmcnt(0)":::"memory"); \
      _Pragma("unroll") for(int d_=0;d_<2;++d_) _Pragma("unroll") for(int r=0;r<16;++r)o[d_][r]*=wsf[crow(r,hi)]; } }while(0)
  f32x16 pA0,pA1,pB0,pB1;
  int sl_prev=0,sl_cur=0,sl_next=SLOTB;
  #define ROT() do{sl_prev=sl_cur;sl_cur=sl_next;sl_next=(sl_next==(NSLOT-1)*SLOTB)?0:sl_next+SLOTB;}while(0)
  if(!hot){ DMA_K(2,2*SLOTB); }
  if(hot){WAIT_BAR(4);}
  else if(QK8){WAIT_BAR(2);}else{WAIT_BAR(3);}
  #define KLD8(j,base) __builtin_shufflevector(*(const __attribute__((address_space(3))) i32x4a*)((base)+(j)*512),*(const __attribute__((address_space(3))) i32x4a*)((base)+(j)*512+1024),0,1,2,3,4,5,6,7)
  #define MF8(j) __builtin_amdgcn_mfma_scale_f32_32x32x64_f8f6f4(kf8[j],qr8,negm,0,0,0,0x7f7f7f7f,0,0x7b7b7b7b)
  if(QK8){ kf8[0]=KLD8(0,kp0); kf8[1]=KLD8(1,kp0); pA0=MF8(0); pA1=MF8(1); } else qkt(pA0,pA1,Kbase,qr,negm,r32,hi);
  asm volatile("s_nop 15\n\ts_nop 7":"+v"(pA0),"+v"(pA1));CMASK(pA0,pA1,0);
  START(pA0,pA1);
  _Pragma("unroll") for(int r=0;r<16;++r)pA1[r]=__builtin_amdgcn_exp2f(pA1[r]);
  WAIT_BAR(0);
  DMA_K(3,0);DMA_V(1,SLOTB);
  ROT();
  if(QK8){ kf8[0]=KLD8(0,kp0+sl_cur); kf8[1]=KLD8(1,kp0+sl_cur); } else kload8(kf,kp0+sl_cur);
  WAIT_BAR(2);
  s16x4 vlo[8],vhi[8]; u32x4 pw0,pw1,pw2,pw3;
  #define PKW(P,B) cvtpk_s(P[B],P[B+1])
  #define PAF(k) __builtin_bit_cast(bf16x8,pw##k)
  #define VFR(i) (bf16x8){vlo[i][0],vlo[i][1],vlo[i][2],vlo[i][3],vhi[i][0],vhi[i][1],vhi[i][2],vhi[i][3]}
  #define PIN(x) asm volatile("":"+v"(x))
  #define MX3(a,b,c) __builtin_fmaxf(__builtin_fmaxf((a),(b)),(c))
  #define GAPA(MF,A0,A1,A2,A3,W0,W1,PW) do{ MF; if(!LSUM_MFMA){ sacc+=A0; sacc+=A1; sacc+=A2; sacc+=A3; PIN(sacc); } W0; W1; PIN(PW); SBAR(); }while(0)
  #define LMF(k) do{ if(LSUM_MFMA) lacc=__builtin_amdgcn_mfma_f32_16x16x32_bf16(PAF(k),ones8,lacc,0,0,0); }while(0)
  #define QKMF(F8S,B16S) do{ if(QK8){ F8S; } else { B16S; } }while(0)
  #define EX(v) __builtin_amdgcn_exp2f(v)
  #define GAPB(MF,X,B) do{ MF; X[B]=EX(X[B]); X[B+1]=EX(X[B+1]); X[B+2]=EX(X[B+2]); X[B+3]=EX(X[B+3]); PIN(X); SBAR(); }while(0)
  #define VRD(i) do{ vlo[i]=vtr(vp_+(((i)>>2)*4096+((i)&3)*1024)); vhi[i]=vtr(vp_+(((i)>>2)*4096+((i)&3)*1024+512)); }while(0)
  #define KRD(G,j) do{ if(G){ if(QK8){ if((j)<2){ kf8[(j)&1]=KLD8((j)&1,kp0+sl_next); SBAR(); } } else { kload2(kf,kp0+sl_next,j); SBAR(); } } }while(0)
  #define STEP(C0,C1,P0,P1,t,GK,GV,GL) do{ SBAR(); \
    const lds_cptr vp_=vp0+sl_prev; \
    VRD(0); SBAR(); float sacc=LSUM_MFMA?0.f:(P0[0]+P0[1]); \
    GAPA(QKMF(C0=MF8(0), C0=__builtin_amdgcn_mfma_f32_32x32x16_bf16(kf[0],qr[0],negm,0,0,0)), P0[2],P0[3],P0[4],P0[5],     pw0[0]=PKW(P0,0), pw0[1]=PKW(P0,2), pw0); \
    VRD(4); SBAR(); GAPA(QKMF((void)0, C1=__builtin_amdgcn_mfma_f32_32x32x16_bf16(kf[1],qr[0],negm,0,0,0)), P0[6],P0[7],P0[8],P0[9],     pw0[2]=PKW(P0,4), pw0[3]=PKW(P0,6), pw0); \
    VRD(1); SBAR(); GAPA(QKMF((void)0, C0=__builtin_amdgcn_mfma_f32_32x32x16_bf16(kf[2],qr[1],C0,0,0,0)); LMF(0),   P0[10],P0[11],P0[12],P0[13], pw1[0]=PKW(P0,8), pw1[1]=PKW(P0,10), pw1); \
    VRD(5); SBAR(); GAPA(QKMF((void)0, C1=__builtin_amdgcn_mfma_f32_32x32x16_bf16(kf[3],qr[1],C1,0,0,0)),   P0[14],P0[15],P1[0],P1[1],   pw1[2]=PKW(P0,12),pw1[3]=PKW(P0,14), pw1); \
    VRD(2); SBAR(); GAPA(QKMF(C1=MF8(1), C0=__builtin_amdgcn_mfma_f32_32x32x16_bf16(kf[4],qr[2],C0,0,0,0)); LMF(1),   P1[2],P1[3],P1[4],P1[5],     pw2[0]=PKW(P1,0), pw2[1]=PKW(P1,2), pw2); \
    VRD(6); SBAR(); GAPA(QKMF((void)0, C1=__builtin_amdgcn_mfma_f32_32x32x16_bf16(kf[5],qr[2],C1,0,0,0)),   P1[6],P1[7],P1[8],P1[9],     pw2[2]=PKW(P1,4), pw2[3]=PKW(P1,6), pw2); \
    VRD(3); SBAR(); GAPA(QKMF((void)0, C0=__builtin_amdgcn_mfma_f32_32x32x16_bf16(kf[6],qr[3],C0,0,0,0)); LMF(2),   P1[10],P1[11],P1[12],P1[13], pw3[0]=PKW(P1,8), pw3[1]=PKW(P1,10), pw3); \
    VRD(7); SBAR(); GAPA(QKMF((void)0, C1=__builtin_amdgcn_mfma_f32_32x32x16_bf16(kf[7],qr[3],C1,0,0,0)),   P1[14],P1[15],0.f,0.f,       pw3[2]=PKW(P1,12),pw3[3]=PKW(P1,14), pw3); \
    if(!LSUM_MFMA) l_reg+=sacc; \
    if(GK){DMA_K((t)+3,sl_cur);} if(GV){DMA_V((t)+1,sl_next);} \
    CMASK(C0,C1,t); \
    if(MODE!=2&&!MFREE){ _Pragma("unroll") for(int r=0;r<16;++r){C0[r]-=mhat;C1[r]-=mhat;} } \
    if(!MFREE){ float a=MX3(C0[0],C0[1],C1[0]),b=MX3(C0[2],C0[3],C1[1]); a=MX3(a,C1[2],C1[3]); \
      _Pragma("unroll") for(int r=4;r<16;r+=4){a=MX3(a,C0[r],C0[r+1]);b=MX3(b,C0[r+2],C0[r+3]);a=MX3(a,C1[r],C1[r+1]);b=MX3(b,C1[r+2],C1[r+3]);} \
      float rm=__builtin_fmaxf(a,b); { auto rr=__builtin_amdgcn_permlane32_swap(__float_as_uint(rm),__float_as_uint(rm),false,false); rm=__builtin_fmaxf(__uint_as_float(rr[0]),__uint_as_float(rr[1])); } \
      resc=false; \
      if(__builtin_expect(__any(rm>(float)THRL),0)){ const float dl=__builtin_fmaxf(rm,0.f); mhat+=dl; \
        _Pragma("unroll") for(int r=0;r<16;++r){C0[r]-=dl;C1[r]-=dl;} \
        if(MODE==2){ _Pragma("unroll") for(int r=0;r<16;++r)negm[r]=-mhat; asm volatile("":"+v"(negm)); } \
        const float f=__builtin_amdgcn_exp2f(-dl); l_reg*=f; if(hi==0)wsf[r32]=f; resc=true; } } \
    SBAR(); \
    GAPB(o[0]=__builtin_amdgcn_mfma_f32_32x32x16_bf16(PAF(0),VFR(0),o[0],0,0,0); LMF(3), C0,0); \
    GAPB(o[1]=__builtin_amdgcn_mfma_f32_32x32x16_bf16(PAF(0),VFR(4),o[1],0,0,0), C0,4); \
    KRD(GL,0); GAPB(o[0]=__builtin_amdgcn_mfma_f32_32x32x16_bf16(PAF(1),VFR(1),o[0],0,0,0), C0,8); \
    KRD(GL,1); GAPB(o[1]=__builtin_amdgcn_mfma_f32_32x32x16_bf16(PAF(1),VFR(5),o[1],0,0,0), C0,12); \
    KRD(GL,2); GAPB(o[0]=__builtin_amdgcn_mfma_f32_32x32x16_bf16(PAF(2),VFR(2),o[0],0,0,0), C1,0); \
    KRD(GL,3); GAPB(o[1]=__builtin_amdgcn_mfma_f32_32x32x16_bf16(PAF(2),VFR(6),o[1],0,0,0), C1,4); \
    GAPB(o[0]=__builtin_amdgcn_mfma_f32_32x32x16_bf16(PAF(3),VFR(3),o[0],0,0,0), C1,8); \
    GAPB(o[1]=__builtin_amdgcn_mfma_f32_32x32x16_bf16(PAF(3),VFR(7),o[1],0,0,0), C1,12); \
    }while(0)
  i32x2a vr8[2][4]; i32x8a pw8; int sc1_=0x7f7f7f7f, scv_=0x7c7c7c7c, scq_=0x7b7b7b7b; asm volatile("":"+v"(sc1_),"+v"(scv_),"+v"(scq_));
  #define PK4E(P,B) ({ int w_; asm("v_cvt_pk_fp8_f32 %0, %1, %2":"=v"(w_):"v"(P[B]),"v"(P[(B)+1])); asm("v_cvt_pk_fp8_f32 %0, %1, %2 op_sel:[0,0,1]":"+v"(w_):"v"(P[(B)+2]),"v"(P[(B)+3])); w_; })
  #define MF8A(j,CX) asm volatile("v_mfma_scale_f32_32x32x64_f8f6f4 %0, %1, %2, -4.0, %3, %4 op_sel_hi:[0,0,0]":"=&v"(CX):"v"(kf8[j]),"v"(qr8),"v"(sc1_),"v"(scq_))
  #define PK8E(P,B,M) do{ int w0_,w1_; asm("v_cvt_pk_fp8_f32 %0, %2, %3\n\tv_cvt_pk_fp8_f32 %1, %6, %7\n\tv_cvt_pk_fp8_f32 %0, %4, %5 op_sel:[0,0,1]\n\tv_cvt_pk_fp8_f32 %1, %8, %9 op_sel:[0,0,1]":"=&v"(w0_),"=&v"(w1_):"v"(P[B]),"v"(P[(B)+1]),"v"(P[(B)+2]),"v"(P[(B)+3]),"v"(P[(B)+4]),"v"(P[(B)+5]),"v"(P[(B)+6]),"v"(P[(B)+7])); pw8[M]=w0_; pw8[(M)+1]=w1_; }while(0)
  #define VTR8(p) __builtin_amdgcn_ds_read_tr8_b64_v2i32((__attribute__((address_space(3))) i32x2a*)(p))
  #define VB8(b) (i32x8a){vr8[b][0][0],vr8[b][0][1],vr8[b][1][0],vr8[b][1][1],vr8[b][2][0],vr8[b][2][1],vr8[b][3][0],vr8[b][3][1]}
  #define PVMF(b) do{ const i32x8a vb_op_=VB8(b); asm volatile("v_mfma_scale_f32_32x32x64_f8f6f4 %0, %1, %2, %0, %3, %4 op_sel_hi:[0,0,0]":"+v"(o[b]):"v"(pw8),"v"(vb_op_),"v"(sc1_),"v"(scv_)); }while(0)
  #define LMF8() asm volatile("v_mfma_scale_f32_16x16x128_f8f6f4 %0, %1, %2, %0, %3, %3 op_sel_hi:[0,0,0]":"+v"(lacc):"v"(pw8),"v"(ones8f),"v"(sc1_))
  #define G8A(MF,RD,W) do{ RD; SBAR(); MF; W; PIN(pw8); SBAR(); }while(0)
  #define STEP8(C0,C1,P0,P1,t,GK,GV,GL) do{ SBAR(); \
    const lds_cptr va_=vb8a+sl_prev, vb_=vb8b+sl_prev; \
    G8A(MF8A(0,C0), vr8[0][0]=VTR8(va_); vr8[0][1]=VTR8(va_+1024),      PK8E(P0,0,0)); \
    G8A((void)0,   vr8[0][2]=VTR8(va_+2048); vr8[0][3]=VTR8(va_+3072), PK8E(P0,8,2)); \
    G8A(MF8A(1,C1), vr8[1][0]=VTR8(vb_); vr8[1][1]=VTR8(vb_+1024),      PK8E(P1,0,4)); \
    G8A((void)0,   vr8[1][2]=VTR8(vb_+2048); vr8[1][3]=VTR8(vb_+3072), PK8E(P1,8,6)); \
    if(GK){DMA_K((t)+3,sl_cur);} if(GV){DMA_V((t)+1,sl_next);} \
    if(MODE!=2){ asm volatile("s_nop 15\n\ts_nop 15\n\ts_nop 15":"+v"(C0),"+v"(C1)); CMASK(C0,C1,t); }     \
    SBAR(); \
    GAPB(PVMF(0), C0,0); \
    GAPB((void)0, C0,4); \
    KRD(GL,0); GAPB(LMF8(), C0,8); \
    KRD(GL,1); GAPB((void)0, C0,12); \
    GAPB(PVMF(1), C1,0); \
    GAPB((void)0, C1,4); \
    GAPB((void)0, C1,8); \
    GAPB((void)0, C1,12); \
    }while(0)
  #define STEPX(C0,C1,P0,P1,t,GK,GV,GL) do{ if(QK8){ STEP8(C0,C1,P0,P1,t,GK,GV,GL); } else { STEP(C0,C1,P0,P1,t,GK,GV,GL); } }while(0)
  int t=1;
  for(;t+5<NT;t+=2){
    STEPX(pB0,pB1,pA0,pA1,t,true,true,true);     if(QK8){WAIT_BAR(1);}else{WAIT_BAR(2);} RESC(); ROT();
    STEPX(pA0,pA1,pB0,pB1,t+1,true,true,true);   if(QK8){WAIT_BAR(1);}else{WAIT_BAR(2);} RESC(); ROT();
  }
  #define ENDW(tt) do{ if(QK8){ if((tt)+3<NT){WAIT_BAR(1);} else {WAIT_BAR(0);} } else if((tt)+3<NT){WAIT_BAR(2);} else if((tt)+2<NT){WAIT_BAR(1);} else {WAIT_BAR(0);} }while(0)
  for(;t+1<NT;t+=2){
    STEPX(pB0,pB1,pA0,pA1,t,(t+3<NT),(t+1<NT),(t+1<NT));       ENDW(t);   RESC(); ROT();
    STEPX(pA0,pA1,pB0,pB1,t+1,(t+4<NT),(t+2<NT),(t+2<NT));     ENDW(t+1); RESC(); ROT();
  }
  if(QK8&&pre){
    const char*ksn=(const char*)Kn+(long)(t0n*KVBLK+lane)*(PITCH*2)+16*(wid&3);
    if(wid<4){ glds16(ksn,(unsigned)__builtin_amdgcn_readfirstlane(kdst)); glds16(ksn+(long)KVBLK*(PITCH*2),(unsigned)__builtin_amdgcn_readfirstlane(kdst+SLOTB)); glds16(ksn+(long)2*KVBLK*(PITCH*2),(unsigned)__builtin_amdgcn_readfirstlane(kdst+2*SLOTB)); }
    const char*qpn=(const char*)Qn+(long)(q0n+wrow+r32)*(PITCH*2)+whead+32*hi; const i32x4a qa=*(const i32x4a*)qpn, qb_=*(const i32x4a*)(qpn+16); *qnx=__builtin_shufflevector(qa,qb_,0,1,2,3,4,5,6,7); }
  STEPX(pB0,pB1,pA0,pA1,NT-1,false,false,false); RESC();
  { if(!LSUM_MFMA){ float sacc=pB0[0]+pB0[1]; _Pragma("unroll") for(int r=2;r<16;++r)sacc+=pB0[r]; _Pragma("unroll") for(int r=0;r<16;++r)sacc+=pB1[r]; l_reg+=sacc; }
    pw0=(u32x4){PKW(pB0,0),PKW(pB0,2),PKW(pB0,4),PKW(pB0,6)};pw1=(u32x4){PKW(pB0,8),PKW(pB0,10),PKW(pB0,12),PKW(pB0,14)};pw2=(u32x4){PKW(pB1,0),PKW(pB1,2),PKW(pB1,4),PKW(pB1,6)};pw3=(u32x4){PKW(pB1,8),PKW(pB1,10),PKW(pB1,12),PKW(pB1,14)};
    if(QK8){ PK8E(pB0,0,0); PK8E(pB0,8,2); PK8E(pB1,0,4); PK8E(pB1,8,6);
      const lds_cptr va_=vb8a+sl_cur, vb_=vb8b+sl_cur; _Pragma("unroll") for(int q_=0;q_<4;++q_){ vr8[0][q_]=VTR8(va_+q_*1024); vr8[1][q_]=VTR8(vb_+q_*1024); }
      LMF8(); PVMF(0); PVMF(1); asm volatile("s_nop 15\n\ts_nop 7":"+v"(o[0]),"+v"(o[1]),"+v"(lacc)); }
    else { LMF(0); LMF(1); LMF(2); LMF(3);
    SBAR(); pv(o,vb0+sl_cur,PAF(0),PAF(1),PAF(2),PAF(3)); } }
  #undef PKW
  #undef PAF
  #undef VFR
  #undef PIN
  #undef MX3
  #undef GAPA
  #undef MF8A
  #undef STEP8
  #undef STEPX
  #undef G8A
  #undef PK4E
  #undef PK8E
  #undef VTR8
  #undef VB8
  #undef PVMF
  #undef LMF8
  #undef QKMF
  #undef KLD8
  #undef MF8
  #undef LMF
  #undef GAPB
  #undef EX
  #undef VRD
  #undef KRD
  #undef STEP
  #undef ENDW
  if(LSUM_MFMA){ const float sk=(MODE==1)?__builtin_amdgcn_exp2f(sinkl2-(QK8?4.f:mhat)):0.f;
    if((lane&7)==0){ const int qb=((lane>>3)&1)*16+(lane>>4)*4; wsf[32+qb]=lacc[0]+sk; wsf[32+qb+1]=lacc[1]+sk; wsf[32+qb+2]=lacc[2]+sk; wsf[32+qb+3]=lacc[3]+sk; } }
  else{
  {auto rr=__builtin_amdgcn_permlane32_swap(__float_as_uint(l_reg),__float_as_uint(l_reg),false,false);l_reg=__uint_as_float(rr[0])+__uint_as_float(rr[1]);}
  if(MODE==1) l_reg+=__builtin_amdgcn_exp2f(sinkl2-mhat);
  if(hi==0)wsf[32+r32]=l_reg; }
  asm volatile("s_waitcnt lgkmcnt(0)":::"memory");
  float rli[16];
  #pragma unroll
  for(int r=0;r<16;++r)rli[r]=__builtin_amdgcn_rcpf(wsf[32+crow(r,hi)]);
  bf16*Ow=Ob+(long)(q0+wrow)*OPITCH+whead; unsigned char*Ow8=(unsigned char*)Ob+(long)(q0+wrow)*OPITCH+whead;
  if(O_FP8){ unsigned char*stg8=(unsigned char*)(shm+LDS_OST)+wid*4096;
    #pragma unroll
    for(int r=0;r<16;++r){const int orow=crow(r,hi); const float s16=rli[r]*16.f;
      const float a_=__builtin_amdgcn_fmed3f(o[0][r]*s16,-448.f,448.f), b_=__builtin_amdgcn_fmed3f(o[1][r]*s16,-448.f,448.f);
      const unsigned w_=(unsigned)__builtin_amdgcn_cvt_pk_fp8_f32(a_,b_,0,false);
      stg8[orow*64+r32]=(unsigned char)(w_&0xffu); stg8[orow*64+32+r32]=(unsigned char)((w_>>8)&0xffu);}
    asm volatile("s_waitcnt lgkmcnt(0)":::"memory");
    #pragma unroll
    for(int i=0;i<2;++i){const int row=i*16+(lane>>2),ch=lane&3; const u32x4 v=*(const u32x4*)(stg8+row*64+ch*16); ATTN_STORE16(Ow8+(long)row*OPITCH+ch*16,v);} }
  else   { bf16*stg=(bf16*)(shm+LDS_OST)+wid*2048;
    #pragma unroll
    for(int r=0;r<16;++r){const int orow=crow(r,hi);
      #pragma unroll
      for(int d0=0;d0<2;++d0)stg[orow*64+d0*32+r32]=__float2bfloat16(o[d0][r]*rli[r]);}
    asm volatile("s_waitcnt lgkmcnt(0)":::"memory");
    #pragma unroll
    for(int i=0;i<4;++i){const int row=i*8+(lane>>3),ch=lane&7; const u32x4 v=*(const u32x4*)(stg+row*64+ch*8); ATTN_STORE16(Ow+(long)row*OPITCH+ch*8,v);} }
  if(ATTN_PRIO_HALF && wid>=4) __builtin_amdgcn_s_setprio(0);
  asm volatile("s_waitcnt lgkmcnt(0)\n\ts_barrier":::"memory");
  #undef DMA_K
  #undef DMA_V
  #undef CMASK
  #undef START
  #undef RESC
  #undef ROT
}
constexpr int ATTN_LDS_BYTES=LDS_BYTES;
#undef SBAR
#undef WAIT_BAR
}

constexpr int NWAVES = 8;
constexpr int BATCH = 32, SEQ = 2048, DM = 1024, NTOK = BATCH * SEQ;
constexpr int EVEN_IN = 2304, ODD_IN = 1536, NE = 16, CAP = 256, DFF = 2048;
constexpr float RMS_EPS = 1e-6f, LOG2E = 1.4426950408889634f, QSCALE = 0.125f * 1.4426950408889634f;

constexpr size_t MiB = 1u << 20;
constexpr size_t WS_CTL = 0, CTL_ZERO_BYTES = 32768;
constexpr size_t WS_TAB = 1 * MiB;
constexpr size_t WS_WIN0 = 2 * MiB, WS_WOUT0 = 7 * MiB, WS_WIN1 = 9 * MiB, WS_WOUT1 = 12 * MiB;
constexpr size_t WS_SELROW = 14 * MiB, WS_GATE = 14 * MiB + 512 * 1024;
constexpr size_t WS_INV = 15 * MiB;
constexpr size_t WS_AFF = 19 * MiB;
constexpr size_t WS_WGU = 24 * MiB;
constexpr size_t WS_WD = 152 * MiB;
constexpr size_t WS_H = 216 * MiB;
constexpr size_t WS_QKV = 344 * MiB;
constexpr size_t WS_Y = 632 * MiB;
constexpr size_t WS_XB = 760 * MiB;
constexpr size_t WS_H8 = 888 * MiB;
constexpr size_t WS_END = 952 * MiB;
constexpr int CW_BAR = 4096;
constexpr int TAB_COS = 0, TAB_SIN = 65536, TAB_ACOS = 131072, TAB_ASIN = 131072 + 1024;

constexpr int RING_OFF = 0, RING_BYTES = 131072;
constexpr int BIAS_OFF = 86016, BIAS_PAD = 64;
constexpr int LDS_BYTES = 159744;
constexpr int LDSCTL_OFF = LDS_BYTES - 512, MISC_OFF = LDSCTL_OFF + 320;
constexpr int NA_SLOT = 16384, NA_XO = 9 * NA_SLOT, NA_XL = NA_XO + 8192, NA_BT = NA_XL + 1024;
static_assert(NA_BT + 2400 <= LDSCTL_OFF, "mixer A LDS map");
static_assert(MISC_OFF + 128 <= LDS_BYTES && attn_body::ATTN_LDS_BYTES <= BIAS_OFF && BIAS_OFF + 4 * (465 + 2 * BIAS_PAD + 64) <= RING_BYTES, "LDS map");

#define GAS __attribute__((address_space(1)))
#define LAS __attribute__((address_space(3)))
typedef unsigned short bf16;
typedef unsigned v4u __attribute__((ext_vector_type(4)));
typedef unsigned v2u __attribute__((ext_vector_type(2)));
typedef float f32x4 __attribute__((ext_vector_type(4)));
typedef GAS unsigned gu32;
#define RLX_AGENT __ATOMIC_RELAXED, __HIP_MEMORY_SCOPE_AGENT
#define LDS_WAIT() asm volatile("s_waitcnt lgkmcnt(0)" ::: "memory")
__device__ __forceinline__ unsigned f2bf(float f) { unsigned u = __builtin_bit_cast(unsigned, f); return (u + 0x7fffu + ((u >> 16) & 1u)) >> 16; }
__device__ __forceinline__ unsigned pk2(float lo, float hi) { return f2bf(lo) | (f2bf(hi) << 16); }
__device__ __forceinline__ float bf_lo(unsigned w) { return __builtin_bit_cast(float, w << 16); }
__device__ __forceinline__ float bf_hi(unsigned w) { return __builtin_bit_cast(float, w & 0xffff0000u); }

#define XB_TMO      128
#define XB_XCNT(j)  (256  + 64 * (j))
#define XB_XSUB(j)  (1280 + 64 * (j))
#define XB_XGEN(j)  (2304 + 64 * (j))
#define XB_TOP      3328
#define XB_TOPGEN   3392
#define XCD_BAR_WORDS 3456
#define XB_SPIN_CAP (1u << 18)

__device__ __forceinline__ unsigned xb_ld(unsigned* p)              { return __hip_atomic_load(p, __ATOMIC_RELAXED, __HIP_MEMORY_SCOPE_AGENT); }
__device__ __forceinline__ unsigned xb_add(unsigned* p, unsigned v) { return __hip_atomic_fetch_add(p, v, __ATOMIC_RELAXED, __HIP_MEMORY_SCOPE_AGENT); }
__device__ __forceinline__ unsigned xb_xcc_id() { return (unsigned)__builtin_amdgcn_s_getreg((3 << 11) | 20) & 0xFu; }
#define XB_SPIN(cond, bar) do { unsigned _sp = 0; while (cond) { __builtin_amdgcn_s_sleep(1); \
    if ((++_sp & 255u) == 0u) { if (xb_ld(&(bar)[XB_TMO])) break; if (_sp > XB_SPIN_CAP) { atomicAdd(&(bar)[XB_TMO], 1u); break; } } } } while (0)

struct XcdBarrier {
    unsigned* bar; unsigned x;
    volatile LAS unsigned* st;
};

__device__ __forceinline__ XcdBarrier xcd_barrier_post(unsigned* bar, volatile LAS unsigned* st) {
    XcdBarrier b; b.bar = bar; b.x = xb_xcc_id(); b.st = st;
    if (threadIdx.x == 0) (void)xb_add(&bar[XB_XCNT(b.x)], 1u);
    return b;
}
__device__ __forceinline__ void xcd_barrier_complete(unsigned* bar, unsigned x, unsigned& nloc, unsigned& nx) {
    const unsigned G = gridDim.x * gridDim.y * gridDim.z;
    unsigned sum, cnt, mine, sp = 0u;
    for (;;) {
        sum = 0u; cnt = 0u; mine = 0u;
#pragma unroll
        for (unsigned j = 0; j < 16; ++j) { const unsigned c = xb_ld(&bar[XB_XCNT(j)]); sum += c; cnt += (c > 0u) ? 1u : 0u; mine = (j == x) ? c : mine; }
        if (sum == G) break;
        __builtin_amdgcn_s_sleep(1);
        if ((++sp & 255u) == 0u) { if (xb_ld(&bar[XB_TMO])) break; if (sp > XB_SPIN_CAP) { atomicAdd(&bar[XB_TMO], 1u); break; } }
    }
    nloc = mine > 0u ? mine : 1u; nx = cnt > 0u ? cnt : 1u;
}

__device__ __forceinline__ void xcd_barrier(const XcdBarrier& b) {
    asm volatile("s_waitcnt vmcnt(0)" ::: "memory");
    __syncthreads();
    if (threadIdx.x == 0) {
        unsigned* bar = b.bar;
        __builtin_amdgcn_s_waitcnt(0);
        unsigned nloc = b.st[0], nx = b.st[1];
        if (nloc == 0u) { xcd_barrier_complete(bar, b.x, nloc, nx); b.st[0] = nloc; b.st[1] = nx; }
        const unsigned old = xb_add(&bar[XB_XSUB(b.x)], 1u);
        const unsigned gen = old / nloc;
        if (old + 1u == (gen + 1u) * nloc) {
            __builtin_amdgcn_fence(__ATOMIC_RELEASE, "agent");
            asm volatile("s_waitcnt vmcnt(0)" ::: "memory");
            const unsigned og = xb_add(&bar[XB_TOP], 1u);
            const unsigned tg = og / nx;
            if (og + 1u == (tg + 1u) * nx) xb_add(&bar[XB_TOPGEN], 1u);
            else XB_SPIN(xb_ld(&bar[XB_TOPGEN]) == tg, bar);
            __builtin_amdgcn_fence(__ATOMIC_ACQUIRE, "agent");
            xb_add(&bar[XB_XGEN(b.x)], 1u);
            asm volatile("s_waitcnt vmcnt(0)" ::: "memory");
        } else {
            XB_SPIN(xb_ld(&bar[XB_XGEN(b.x)]) == gen, bar);
            __builtin_amdgcn_fence(__ATOMIC_ACQUIRE, "agent");
            asm volatile("s_waitcnt vmcnt(0)" ::: "memory");
        }
    }
    __syncthreads();
}

struct Frame {
    LAS unsigned char* lds;
    int tid, lane, wave;
    int vcu, G;
};

__device__ __forceinline__ float wave_sum(float v) {
#pragma unroll
    for (int o = 1; o < 64; o <<= 1) v += __shfl_xor(v, o);
    return v;
}
__device__ __forceinline__ void transpose_item(const float* W, int K, int N, bf16* WT, int k0, int n0, int drow0, LAS float* scr, int lane, int hi_step = 16) {
#pragma unroll 8
    for (int i = 0; i < 32; ++i) { const int kk = 2 * i + (lane >> 5); scr[kk * 33 + (lane & 31)] = W[(size_t)(k0 + kk) * N + n0 + (lane & 31)]; }
    LDS_WAIT(); asm volatile("" ::: "memory");
    const int c = lane & 7;
#pragma unroll
    for (int j = 0; j < 4; ++j) { const int n = (lane >> 3) + 8 * j; const LAS float* s = scr + (8 * c) * 33 + n;
        v4u o; o.x = pk2(s[0 * 33], s[1 * 33]); o.y = pk2(s[2 * 33], s[3 * 33]); o.z = pk2(s[4 * 33], s[5 * 33]); o.w = pk2(s[6 * 33], s[7 * 33]);
        *(GAS v4u*)(WT + (size_t)(drow0 + (n & 15) + (n >> 4) * hi_step) * K + k0 + 8 * c) = o; }
    LDS_WAIT(); asm volatile("" ::: "memory");
}
__device__ __forceinline__ unsigned pk4_fp8(float a, float b, float c, float d) {
    a = __builtin_amdgcn_fmed3f(a, -448.f, 448.f); b = __builtin_amdgcn_fmed3f(b, -448.f, 448.f); c = __builtin_amdgcn_fmed3f(c, -448.f, 448.f); d = __builtin_amdgcn_fmed3f(d, -448.f, 448.f);
    int w = 0; w = __builtin_amdgcn_cvt_pk_fp8_f32(a, b, w, false); w = __builtin_amdgcn_cvt_pk_fp8_f32(c, d, w, true); return (unsigned)w; }
__device__ __forceinline__ void transpose_item8(const float* W, int K, int N, unsigned char* WT, int k0, int n0, int drow0, LAS float* scr, int lane, int hi_step = 16) {
#pragma unroll 8
    for (int i = 0; i < 32; ++i) { const int kk = 2 * i + (lane >> 5); scr[kk * 33 + (lane & 31)] = W[(size_t)(k0 + kk) * N + n0 + (lane & 31)]; }
    LDS_WAIT(); asm volatile("" ::: "memory");
    const int c = lane & 7;
#pragma unroll
    for (int j = 0; j < 4; ++j) { const int n = (lane >> 3) + 8 * j; const LAS float* s = scr + (8 * c) * 33 + n;
        v2u o; o.x = pk4_fp8(s[0 * 33] * 64.f, s[1 * 33] * 64.f, s[2 * 33] * 64.f, s[3 * 33] * 64.f); o.y = pk4_fp8(s[4 * 33] * 64.f, s[5 * 33] * 64.f, s[6 * 33] * 64.f, s[7 * 33] * 64.f);
        *(GAS v2u*)(WT + (size_t)(drow0 + (n & 15) + (n >> 4) * hi_step) * K + k0 + 8 * c) = o; }
    LDS_WAIT(); asm volatile("" ::: "memory");
}
__device__ __forceinline__ void prep_small_weights(Frame& F, const float* win0, const float* wout0, const float* win1, const float* wout1, unsigned char* ws) {
    int lane_ = F.lane, tid_ = F.tid; asm volatile("" : "+v"(lane_), "+v"(tid_));
    LAS float* scr = (LAS float*)(F.lds + RING_OFF + F.wave * 16384);
    const int gw = F.vcu * NWAVES + F.wave, NGW = F.G * NWAVES;
    constexpr int I0 = 16 * (EVEN_IN / 32), I1 = 16 * (DM / 32), I2 = 16 * (ODD_IN / 32), I3 = 16 * (DM / 32);
    for (int it = gw; it < I0 + I1 + I2 + I3; it += NGW) {
        int r = it; const float* W; bf16* WT; int N;
        if (r < I0) { W = win0; WT = (bf16*)(ws + WS_WIN0); N = EVEN_IN; }
        else if ((r -= I0) < I1) { W = wout0; WT = (bf16*)(ws + WS_WOUT0); N = DM; }
        else if ((r -= I1) < I2) { W = win1; WT = (bf16*)(ws + WS_WIN1); N = ODD_IN; }
        else { r -= I2; W = wout1; WT = (bf16*)(ws + WS_WOUT1); N = DM; }
        const int nblk = N / 32, kb = r / nblk, nb = r % nblk, n0 = 32 * nb;
        if (N == EVEN_IN) transpose_item8(W, DM, N, (unsigned char*)WT, 64 * kb, n0, (n0 & ~255) + 128 * ((n0 >> 5) & 1) + 32 * ((n0 >> 6) & 3), scr, lane_);
        else if (N == ODD_IN) transpose_item8(W, DM, N, (unsigned char*)WT, 64 * kb, n0, (n0 & ~255) + 32 * ((n0 >> 6) & 3) + 16 * ((n0 >> 5) & 1), scr, lane_, 128);
        else transpose_item8(W, DM, N, (unsigned char*)WT, 64 * kb, n0, n0, scr, lane_);
    }
}
__device__ __forceinline__ void xpose8_block(const float* W, int N, unsigned char* WT, int Kb, int k0, int n0, int drow0, int lane, const float sc = 64.f) {
    const int g = lane >> 4, c = lane & 15;
    const GAS f32x4* src = (const GAS f32x4*)(W + (size_t)(k0 + 16 * g) * N + n0 + 4 * c);
    f32x4 v[16];
#pragma unroll
    for (int i = 0; i < 16; ++i) v[i] = __builtin_nontemporal_load(&src[(size_t)i * (N / 4)]);
#pragma unroll
    for (int jn = 0; jn < 4; ++jn) { v4u w;
        w.x = pk4_fp8(v[0][jn] * sc, v[1][jn] * sc, v[2][jn] * sc, v[3][jn] * sc); w.y = pk4_fp8(v[4][jn] * sc, v[5][jn] * sc, v[6][jn] * sc, v[7][jn] * sc);
        w.z = pk4_fp8(v[8][jn] * sc, v[9][jn] * sc, v[10][jn] * sc, v[11][jn] * sc); w.w = pk4_fp8(v[12][jn] * sc, v[13][jn] * sc, v[14][jn] * sc, v[15][jn] * sc);
        *(GAS v4u*)(WT + (size_t)(drow0 + 4 * c + jn) * Kb + k0 + 16 * g) = w; }
}
__device__ __forceinline__ void prep_moe_weights(Frame& F, const float* wg, const float* wu, const float* wd, unsigned char* ws) {
    int lane_ = F.lane; asm volatile("" : "+v"(lane_));
    const int gw = F.vcu * NWAVES + F.wave, NGW = F.G * NWAVES;
    constexpr int IG = (DM / 64) * (DFF / 64), ID = (DFF / 64) * (DM / 64), IE = 2 * IG + ID;
    for (int it = gw; it < 2 * NE * IE; it += NGW) {
        const int e = it / IE; int r = it % IE;
        if (r < 2 * IG) { const int up = r >= IG; r -= up * IG; const int kb = r / (DFF / 64), nb = r % (DFF / 64), n0 = 64 * nb;
            xpose8_block((up ? wu : wg) + (size_t)e * DM * DFF, DFF, ws + WS_WGU + (size_t)e * 4096 * DM, DM, 64 * kb, n0, (n0 >> 7) * 256 + (n0 & 127) + up * 128, lane_, up ? -0.6931471805599453f * 64.f : -1.4426950408889634f * 64.f); }
        else { r -= 2 * IG; const int kb = r / (DM / 64), nb = r % (DM / 64);
            xpose8_block(wd + (size_t)e * DFF * DM, DM, ws + WS_WD + (size_t)e * DM * DFF, DFF, 64 * kb, 64 * nb, 64 * nb, lane_); }
    }
}
__device__ __forceinline__ void prep_moe_layer(Frame& F, const int LY, const float* wg, const float* wu, const float* wd, unsigned char* ws) {
    int lane_ = F.lane; asm volatile("" : "+v"(lane_));
    const int gw = F.vcu * NWAVES + F.wave, NGW = F.G * NWAVES;
    constexpr int IG = (DM / 64) * (DFF / 64), ID = (DFF / 64) * (DM / 64), IE = 2 * IG + ID;
    for (int it = LY * NE * IE + gw; it < (LY + 1) * NE * IE; it += NGW) {
        const int e = it / IE; int r = it % IE;
        if (r < 2 * IG) { const int up = r >= IG; r -= up * IG; const int kb = r / (DFF / 64), nb = r % (DFF / 64), n0 = 64 * nb;
            xpose8_block((up ? wu : wg) + (size_t)e * DM * DFF, DFF, ws + WS_WGU + (size_t)e * 4096 * DM, DM, 64 * kb, n0, (n0 >> 7) * 256 + (n0 & 127) + up * 128, lane_, up ? -0.6931471805599453f * 64.f : -1.4426950408889634f * 64.f); }
        else { r -= 2 * IG; const int kb = r / (DM / 64), nb = r % (DM / 64);
            xpose8_block(wd + (size_t)e * DFF * DM, DM, ws + WS_WD + (size_t)e * DM * DFF, DFF, 64 * kb, 64 * nb, 64 * nb, lane_); }
    }
}
__device__ __forceinline__ void prep_tables(Frame& F, float* tab) {
    int lane_ = F.lane, tid_ = F.tid; asm volatile("" : "+v"(lane_), "+v"(tid_));
    const int gt = F.vcu * (NWAVES * 64) + tid_, NGT = F.G * NWAVES * 64;
    for (int idx = gt; idx < SEQ * 32 + 64 * 16; idx += NGT) {
        if (idx < SEQ * 32) { const int pos = idx >> 5, i = idx & 31; const float inv = powf(10000.0f, -(float)i / 32.0f), ang = (float)pos * inv; ((unsigned*)tab)[idx] = pg8::cvt_pk_bf16(cosf(ang), sinf(ang)); }
        else { const int j = idx - SEQ * 32, pos = j >> 4, i = j & 15; const float inv = powf(10000.0f, -(float)i / 16.0f), ang = (float)pos * inv; ((unsigned*)tab)[65536 + j] = pg8::cvt_pk_bf16(cosf(ang), sinf(ang)); }
    }
}
__device__ __forceinline__ void norm_rows(Frame& F, const float* x, const float* gain, unsigned char* H8) {
    int lane_ = F.lane, tid_ = F.tid; asm volatile("" : "+v"(lane_), "+v"(tid_));
    const int gw = F.vcu * NWAVES + F.wave, NGW = F.G * NWAVES;
    f32x4 gv[4];
#pragma unroll
    for (int j = 0; j < 4; ++j) gv[j] = ((const f32x4*)gain)[lane_ + 64 * j];
    int m0 = 2 * gw; f32x4 nv[2][4];
#pragma unroll
    for (int q = 0; q < 2; ++q)
#pragma unroll
        for (int j = 0; j < 4; ++j) nv[q][j] = m0 < NTOK ? __builtin_nontemporal_load(&((const GAS f32x4*)(x + (size_t)(m0 + q) * DM) + lane_)[64 * j]) : (f32x4){0.f, 0.f, 0.f, 0.f};
    for (; m0 < NTOK; m0 += 2 * NGW) {
        f32x4 v[2][4]; const int mn = m0 + 2 * NGW;
#pragma unroll
        for (int q = 0; q < 2; ++q)
#pragma unroll
            for (int j = 0; j < 4; ++j) v[q][j] = nv[q][j];
        if (mn < NTOK) {
#pragma unroll
            for (int q = 0; q < 2; ++q)
#pragma unroll
                for (int j = 0; j < 4; ++j) nv[q][j] = __builtin_nontemporal_load(&((const GAS f32x4*)(x + (size_t)(mn + q) * DM) + lane_)[64 * j]); }
#pragma unroll
        for (int q = 0; q < 2; ++q) { float s = 0.f;
#pragma unroll
            for (int j = 0; j < 4; ++j) s += (v[q][j].x * v[q][j].x + v[q][j].y * v[q][j].y) + (v[q][j].z * v[q][j].z + v[q][j].w * v[q][j].w);
            const float r = rsqrtf(wave_sum(s) * (1.f / DM) + RMS_EPS);
            GAS unsigned* o4 = (GAS unsigned*)(H8 + (size_t)(m0 + q) * DM) + lane_;
#pragma unroll
            for (int j = 0; j < 4; ++j) { const f32x4 o = v[q][j] * r * gv[j]; o4[64 * j] = pk4_fp8(o.x, o.y, o.z, o.w); } }
    }
}
__device__ __forceinline__ void norm_router_phase(Frame& F, const bf16* x, const float* gain, const float* wr, unsigned char* H8, float* aff) {
    typedef short bf16x8 __attribute__((ext_vector_type(8)));
    int lane_ = F.lane, tid_ = F.tid; asm volatile("" : "+v"(lane_), "+v"(tid_));
    constexpr int WROW = 1032;
    LAS bf16* whi = (LAS bf16*)(F.lds + RING_OFF); LAS bf16* wlo = whi + 16 * WROW; LAS float* gl = (LAS float*)(wlo + 16 * WROW);
    { float wv[32], gk[32];
#pragma unroll
      for (int q = 0; q < 32; ++q) { const int i = tid_ + 512 * q; wv[q] = wr[i]; gk[q] = gain[i >> 4]; }
      const float g0_ = gain[tid_], g1_ = gain[tid_ + 512];
#pragma unroll
      for (int q = 0; q < 32; ++q) { const int i = tid_ + 512 * q, k = i >> 4, e = i & 15; const float w = wv[q] * gk[q]; const unsigned hb = f2bf(w); const float hf = __uint_as_float(hb << 16);
          whi[e * WROW + k] = (bf16)hb; wlo[e * WROW + k] = (bf16)f2bf(w - hf); }
      gl[tid_] = g0_; gl[tid_ + 512] = g1_; }
    LDS_WAIT(); __syncthreads();
    const int gw = F.vcu * NWAVES + F.wave, NGW = F.G * NWAVES, r_ = lane_ & 15, g_ = lane_ >> 4;
    for (int grp = gw; grp < NTOK / 16; grp += NGW) {
        asm volatile("" ::: "memory");
        const int m0 = grp * 16;
        const GAS v4u* xr = (const GAS v4u*)(x + (size_t)(m0 + r_) * DM + 8 * g_);
        v4u xf[32];
#pragma unroll
        for (int s2 = 0; s2 < 32; ++s2) xf[s2] = __builtin_nontemporal_load(&xr[4 * s2]);
        f32x4 acc = (f32x4){0.f, 0.f, 0.f, 0.f}; float ss = 0.f;
#pragma unroll
        for (int s2 = 0; s2 < 32; ++s2) { if ((s2 & 3) == 0) asm volatile("" ::: "memory");     const bf16x8 xa = __builtin_bit_cast(bf16x8, xf[s2]);
            const bf16x8 bh = *(const LAS bf16x8*)(whi + r_ * WROW + 32 * s2 + 8 * g_), bl = *(const LAS bf16x8*)(wlo + r_ * WROW + 32 * s2 + 8 * g_);
            acc = __builtin_amdgcn_mfma_f32_16x16x32_bf16(xa, bh, acc, 0, 0, 0); acc = __builtin_amdgcn_mfma_f32_16x16x32_bf16(xa, bl, acc, 0, 0, 0);
            const v4u w_ = xf[s2]; const unsigned w0 = w_.x, w1 = w_.y, w2 = w_.z, w3 = w_.w;
            const float a0 = bf_lo(w0), a1 = bf_hi(w0), a2 = bf_lo(w1), a3 = bf_hi(w1), a4 = bf_lo(w2), a5 = bf_hi(w2), a6 = bf_lo(w3), a7 = bf_hi(w3);
            ss += ((a0 * a0 + a1 * a1) + (a2 * a2 + a3 * a3)) + ((a4 * a4 + a5 * a5) + (a6 * a6 + a7 * a7)); }
#pragma unroll
        for (int s2 = 0; s2 < 32; ++s2) asm volatile("" : "+v"(xf[s2]));
        ss += __shfl_xor(ss, 16); ss += __shfl_xor(ss, 32);
        const float rr = rsqrtf(ss * (1.f / DM) + RMS_EPS);
        float pe[4], sm[4];
#pragma unroll
        for (int rg = 0; rg < 4; ++rg) { const float lg = acc[rg] * __shfl(rr, 4 * g_ + rg); float mx = lg;
#pragma unroll
            for (int o = 1; o <= 8; o <<= 1) mx = fmaxf(mx, __shfl_xor(mx, o));
            pe[rg] = expf(lg - mx); float su = pe[rg];
#pragma unroll
            for (int o = 1; o <= 8; o <<= 1) su += __shfl_xor(su, o);
            sm[rg] = su; }
        { const int b = m0 >> 11, sq = (m0 & (SEQ - 1)) + 4 * g_;
          *(GAS f32x4*)(aff + ((size_t)(b * NE + r_)) * SEQ + sq) = (f32x4){pe[0] / sm[0], pe[1] / sm[1], pe[2] / sm[2], pe[3] / sm[3]}; }
        GAS v2u* orow = (GAS v2u*)(H8 + (size_t)(m0 + r_) * DM + 8 * g_);
#pragma unroll
        for (int s2 = 0; s2 < 32; ++s2) { if ((s2 & 3) == 0) asm volatile("" ::: "memory"); const v4u w_ = xf[s2]; const unsigned w0 = w_.x, w1 = w_.y, w2 = w_.z, w3 = w_.w;
            const f32x4 g0 = *(const LAS f32x4*)(gl + 32 * s2 + 8 * g_), g1 = *(const LAS f32x4*)(gl + 32 * s2 + 8 * g_ + 4);
            v2u o; o.x = pk4_fp8(bf_lo(w0) * rr * g0.x, bf_hi(w0) * rr * g0.y, bf_lo(w1) * rr * g0.z, bf_hi(w1) * rr * g0.w);
            o.y = pk4_fp8(bf_lo(w2) * rr * g1.x, bf_hi(w2) * rr * g1.y, bf_lo(w3) * rr * g1.z, bf_hi(w3) * rr * g1.w);
            orow[4 * s2] = o; }
    }
    __syncthreads();
}
__device__ __forceinline__ void select_phase(Frame& F, const float* aff, int* selrow, float* gate, int* inv) {
    int lane_ = F.lane, tid_ = F.tid; asm volatile("" : "+v"(lane_), "+v"(tid_));
    LAS unsigned* hist = (LAS unsigned*)(F.lds + RING_OFF);
    LAS unsigned* bc = hist + 256;
    LAS unsigned* wsum = hist + 272;
    for (int u = F.vcu; u < BATCH * NE; u += F.G) {
        const int b = u >> 4, e = u & 15;
        const f32x4 a4 = ((const GAS f32x4*)(aff + (size_t)u * SEQ))[tid_];
        const float a0_ = a4[0], a1_ = a4[1], a2_ = a4[2], a3_ = a4[3];
        unsigned k[4] = {__float_as_uint(a0_), __float_as_uint(a1_), __float_as_uint(a2_), __float_as_uint(a3_)};
        unsigned prefix = 0u, need = CAP;
#pragma unroll
        for (int pass = 0; pass < 4; ++pass) { const int shift = 24 - 8 * pass;
            if (tid_ < 256) hist[tid_] = 0u;
            LDS_WAIT(); __syncthreads();
#pragma unroll
            for (int i = 0; i < 4; ++i) if (pass == 0 || (k[i] >> (shift + 8)) == prefix) __hip_atomic_fetch_add(&hist[(k[i] >> shift) & 255u], 1u, __ATOMIC_RELAXED, __HIP_MEMORY_SCOPE_WORKGROUP);
            LDS_WAIT(); __syncthreads();
            if (F.wave == 0) { unsigned c[4];
#pragma unroll
                for (int i = 0; i < 4; ++i) c[i] = hist[4 * lane_ + i];
                const unsigned sl = (c[0] + c[1]) + (c[2] + c[3]); unsigned suf = sl;
#pragma unroll
                for (int o = 1; o < 64; o <<= 1) { const unsigned t = __shfl_down(suf, o); if (lane_ + o < 64) suf += t; }
                unsigned run = suf - sl;
#pragma unroll
                for (int bi = 3; bi >= 0; --bi) { if (run < need && need <= run + c[bi]) { bc[0] = (prefix << 8) | (unsigned)(4 * lane_ + bi); bc[1] = need - run; } run += c[bi]; }
            }
            LDS_WAIT(); __syncthreads();
            prefix = bc[0]; need = bc[1];
        }
        unsigned cg = 0u, ce = 0u;
#pragma unroll
        for (int i = 0; i < 4; ++i) { cg += (k[i] > prefix) ? 1u : 0u; ce += (k[i] == prefix) ? 1u : 0u; }
        unsigned pk = cg | (ce << 16), inc = pk;
#pragma unroll
        for (int o = 1; o < 64; o <<= 1) { const unsigned t = __shfl_up(inc, o); if (lane_ >= o) inc += t; }
        if (lane_ == 63) wsum[F.wave] = inc;
        LDS_WAIT(); __syncthreads();
        unsigned base = 0u, tot = 0u;
#pragma unroll
        for (int w = 0; w < NWAVES; ++w) { const unsigned t = wsum[w]; if (w < F.wave) base += t; tot += t; }
        const unsigned ex = base + inc - pk; unsigned pg = ex & 0xffffu, pe = ex >> 16; const unsigned ngt = tot & 0xffffu;
#pragma unroll
        for (int i = 0; i < 4; ++i) { const int sq = 4 * tid_ + i; int slot = -1;
            if (k[i] > prefix) { slot = (int)pg; ++pg; } else if (k[i] == prefix) { if (pe < need) slot = (int)(ngt + pe); ++pe; }
            if (slot >= 0) { selrow[(e * BATCH + b) * CAP + slot] = b * SEQ + sq; gate[(e * BATCH + b) * CAP + slot] = __uint_as_float(k[i]); }
            inv[(size_t)(b * SEQ + sq) * NE + e] = slot; }
        LDS_WAIT(); __syncthreads();
    }
}
__device__ __forceinline__ void combine_phase(Frame& F, bf16* x, float* xout, const unsigned char* Y, const int* inv, const float* gain, unsigned char* H8, bool with_norm) {
    int lane_ = F.lane, tid_ = F.tid; asm volatile("" : "+v"(lane_), "+v"(tid_));
    const int gw = F.vcu * NWAVES + F.wave, NGW = F.G * NWAVES;
    f32x4 gv[4];
#pragma unroll
    for (int j = 0; j < 4; ++j) gv[j] = with_norm ? ((const f32x4*)gain)[lane_ + 64 * j] : (f32x4){0.f, 0.f, 0.f, 0.f};
    int m = gw; int niv = -1; v2u nv[4];
    if (m < NTOK) { niv = inv[(size_t)m * NE + (lane_ & 15)];
#pragma unroll
        for (int j = 0; j < 4; ++j) nv[j] = __builtin_nontemporal_load(&((const GAS v2u*)(x + (size_t)m * DM) + lane_)[64 * j]); }
    for (; m < NTOK; m += NGW) {
        const int b = m >> 11, iv = niv, mn = m + NGW;
        f32x4 v[4];
#pragma unroll
        for (int j = 0; j < 4; ++j) { const v2u w_ = nv[j]; v[j] = (f32x4){bf_lo(w_.x), bf_hi(w_.x), bf_lo(w_.y), bf_hi(w_.y)}; }
        if (mn < NTOK) { niv = inv[(size_t)mn * NE + (lane_ & 15)];
#pragma unroll
            for (int j = 0; j < 4; ++j) nv[j] = __builtin_nontemporal_load(&((const GAS v2u*)(x + (size_t)mn * DM) + lane_)[64 * j]); }
        unsigned mask = (unsigned)(__builtin_amdgcn_ballot_w64(iv >= 0) & 0xffffull);
        while (mask) {
            const int e0 = __builtin_ctz(mask); mask &= mask - 1; const bool two = mask != 0u; const int e1 = two ? __builtin_ctz(mask) : e0; if (two) mask &= mask - 1;
            const int s0 = __builtin_amdgcn_readlane(iv, e0), s1 = __builtin_amdgcn_readlane(iv, e1);
            const GAS unsigned* y0 = (const GAS unsigned*)(Y + ((size_t)((e0 * BATCH + b) * CAP + s0)) * DM) + lane_; const GAS unsigned* y1 = (const GAS unsigned*)(Y + ((size_t)((e1 * BATCH + b) * CAP + s1)) * DM) + lane_;
            unsigned w0[4], w1[4];
#pragma unroll
            for (int j = 0; j < 4; ++j) w0[j] = __builtin_nontemporal_load(&y0[64 * j]);
            if (two) {
#pragma unroll
                for (int j = 0; j < 4; ++j) w1[j] = __builtin_nontemporal_load(&y1[64 * j]); }
#pragma unroll
            for (int j = 0; j < 4; ++j) { const auto lo = __builtin_amdgcn_cvt_pk_f32_fp8((int)w0[j], false), hi = __builtin_amdgcn_cvt_pk_f32_fp8((int)w0[j], true);
                v[j].x += lo[0] * 0.0625f; v[j].y += lo[1] * 0.0625f; v[j].z += hi[0] * 0.0625f; v[j].w += hi[1] * 0.0625f; }
            if (two) {
#pragma unroll
                for (int j = 0; j < 4; ++j) { const auto lo = __builtin_amdgcn_cvt_pk_f32_fp8((int)w1[j], false), hi = __builtin_amdgcn_cvt_pk_f32_fp8((int)w1[j], true);
                    v[j].x += lo[0] * 0.0625f; v[j].y += lo[1] * 0.0625f; v[j].z += hi[0] * 0.0625f; v[j].w += hi[1] * 0.0625f; } }
        }
        float s = 0.f;
#pragma unroll
        for (int j = 0; j < 4; ++j) { if (with_norm) { v2u w_; w_.x = pk2(v[j].x, v[j].y); w_.y = pk2(v[j].z, v[j].w); __builtin_nontemporal_store(w_, &((GAS v2u*)(x + (size_t)m * DM) + lane_)[64 * j]); v[j] = (f32x4){bf_lo(w_.x), bf_hi(w_.x), bf_lo(w_.y), bf_hi(w_.y)}; }
            else __builtin_nontemporal_store(v[j], &((GAS f32x4*)(xout + (size_t)m * DM) + lane_)[64 * j]);
            s += (v[j].x * v[j].x + v[j].y * v[j].y) + (v[j].z * v[j].z + v[j].w * v[j].w); }
        if (with_norm) { const float r = rsqrtf(wave_sum(s) * (1.f / DM) + RMS_EPS); GAS unsigned* o4 = (GAS unsigned*)(H8 + (size_t)m * DM) + lane_;
#pragma unroll
            for (int j = 0; j < 4; ++j) { const f32x4 o = v[j] * r * gv[j]; o4[64 * j] = pk4_fp8(o.x, o.y, o.z, o.w); } }
    }
}

__device__ __forceinline__ void na_phase(Frame& F, const bf16* QKVp, bf16* Op, const float* rel_bias) {
    typedef short bf16x8 __attribute__((ext_vector_type(8))); typedef short s16x4 __attribute__((ext_vector_type(4)));
    int tid = F.tid; asm volatile("" : "+v"(tid));
    const int lane = tid & 63, wid = F.wave, g = lane >> 4, lq = lane & 15, iq = wid & 3, gq = wid >> 2;
    const int kb0 = iq < 2 ? 0 : 1;
    LAS unsigned char* L = F.lds; const unsigned ldsbase = (unsigned)(uintptr_t)F.lds;
    LAS float* nbt = (LAS float*)(L + NA_BT);
    const int qc = 16 * iq + lq; int cs = qc - 8; cs = cs < 0 ? 0 : (cs > 48 ? 48 : cs);
    const int dkey = 8 * wid + (lane >> 3), dchunk = (lane & 7) ^ (dkey & 7);
    const size_t dsrc = (size_t)dkey * EVEN_IN + dchunk * 8;
    const unsigned kc1 = (unsigned)(kb0 * 2048 + lq * 128 + ((g ^ (lq & 7)) * 16)), kc2 = (unsigned)(kb0 * 2048 + lq * 128 + (((4 + g) ^ (lq & 7)) * 16));
    unsigned vc[4]; { const int q_ = lq >> 2, p_ = lq & 3, keyl = (4 * g + q_) & 7;
#pragma unroll
        for (int dt = 0; dt < 4; ++dt) vc[dt] = (unsigned)(8192 + kb0 * 2048 + g * 512 + q_ * 128 + (((2 * dt + (p_ >> 1)) ^ keyl) * 16) + (p_ & 1) * 8); }
    const int bc = 16 * kb0 + 4 * g - qc + 15;
    float mk[3][4];
#pragma unroll
    for (int kbi = 0; kbi < 3; ++kbi)
#pragma unroll
        for (int rg = 0; rg < 4; ++rg) mk[kbi][rg] = ((unsigned)(16 * (kb0 + kbi) + 4 * g - cs + rg) < 16u) ? 0.f : -1.0e30f;
#define NA_BAR() asm volatile("s_waitcnt vmcnt(0) lgkmcnt(0)\n\ts_barrier" ::: "memory")
#define NA_BAR4() asm volatile("s_waitcnt vmcnt(4) lgkmcnt(0)\n\ts_barrier" ::: "memory")
#define NA_DMA(kr) do { const unsigned sl_ = (unsigned)__builtin_amdgcn_readfirstlane((int)(ldsbase + (unsigned)(((kr) % 9) * NA_SLOT) + (unsigned)wid * 1024u)); \
        attn_body::glds16(Kb + (size_t)(kr) * 64 * EVEN_IN + dsrc, sl_); attn_body::glds16(Vb + (size_t)(kr) * 64 * EVEN_IN + dsrc, sl_ + 8192u); } while (0)
#define NA_CLAMP(x) ((x) < 0 ? 0 : ((x) > 24 ? 24 : (x)))
#define NA_PAIR(pr) do { f32x4 sb[2]; bf16x8 kfr[2][2]; float bia[2][4]; s16x4 va[4][2]; int kcs[2]; \
          \
        _Pragma("unroll") for (int u2 = 0; u2 < 2; ++u2) { const int n = 2 * (pr) + u2, kri = n / 3, kbi = n % 3; const int kr = rs + kri, kb = kb0 + kbi; \
            const unsigned sk = (unsigned)((kr % 9) * NA_SLOT); const int key = 16 * kb + lq; \
            kfr[u2][0] = *(const LAS bf16x8*)(L + ((sk + kc1) + kbi * 2048)); kfr[u2][1] = *(const LAS bf16x8*)(L + ((sk + kc2) + kbi * 2048)); \
            kcs[u2] = 0; const LAS float* bp = nbt + 64 + (((kr - rq + 7) * 31 + bc) + 16 * kbi); \
            _Pragma("unroll") for (int rg = 0; rg < 4; ++rg) bia[u2][rg] = bp[rg]; \
            _Pragma("unroll") for (int dt = 0; dt < 4; ++dt) va[dt][u2] = attn_body::vtr((attn_body::lds_cptr)(L + ((sk + vc[dt]) + kbi * 2048))); } \
        _Pragma("unroll") for (int u2 = 0; u2 < 2; ++u2) { \
            f32x4 sv; _Pragma("unroll") for (int rg = 0; rg < 4; ++rg) sv[rg] = bia[u2][rg] + mk[(2 * (pr) + u2) % 3][rg];     \
            sv = __builtin_amdgcn_mfma_f32_16x16x32_bf16(kfr[u2][0], qf0, sv, 0, 0, 0); sv = __builtin_amdgcn_mfma_f32_16x16x32_bf16(kfr[u2][1], qf1, sv, 0, 0, 0); \
            _Pragma("unroll") for (int rg = 0; rg < 4; ++rg) sv[rg] = __builtin_amdgcn_exp2f(sv[rg]); \
            lsum4 += sv; sb[u2] = sv; } \
        bf16x8 pb; { const unsigned w0 = pg8::cvt_pk_bf16(sb[0][0], sb[0][1]), w1 = pg8::cvt_pk_bf16(sb[0][2], sb[0][3]), w2 = pg8::cvt_pk_bf16(sb[1][0], sb[1][1]), w3 = pg8::cvt_pk_bf16(sb[1][2], sb[1][3]); \
            pb = __builtin_bit_cast(bf16x8, (v4u){w0, w1, w2, w3}); } \
        _Pragma("unroll") for (int dt = 0; dt < 4; ++dt) { \
            const bf16x8 vf = (bf16x8){va[dt][0][0], va[dt][0][1], va[dt][0][2], va[dt][0][3], va[dt][1][0], va[dt][1][1], va[dt][1][2], va[dt][1][3]}; \
            oacc[dt] = __builtin_amdgcn_mfma_f32_16x16x32_bf16(vf, pb, oacc[dt], 0, 0, 0); } } while (0)
    for (int bh = F.vcu; bh < BATCH * 8; bh += F.G) {
        const int b = bh >> 3, h = bh & 7;
        const bf16* Qb = QKVp + (size_t)b * SEQ * EVEN_IN + 64 * h; const bf16* Kb = Qb + 512; const bf16* Vb = Qb + 1024;
        bf16* Ob = attn_body::O_FP8 ? (bf16*)((unsigned char*)Op + (size_t)b * SEQ * DM + 64 * h) : Op + (size_t)b * SEQ * DM + 64 * h;
        NA_BAR();
        if (tid < 465) nbt[64 + tid] = rel_bias[h * 465 + tid] * LOG2E;
#pragma unroll
        for (int kr = 0; kr < 8; ++kr) NA_DMA(kr);
        bf16x8 qn[2];
#pragma unroll
        for (int s2 = 0; s2 < 2; ++s2) qn[s2] = *(const GAS bf16x8*)(Qb + (size_t)(gq * 64 + qc) * EVEN_IN + 32 * s2 + 8 * g);
        NA_BAR();
        for (int t = 0; t < 16; ++t) {
            const int rq = 2 * t + gq, rs = NA_CLAMP(rq - 4);
            const bf16x8 qf0 = qn[0], qf1 = qn[1];
            f32x4 oacc[4]; f32x4 lsum4 = (f32x4){0.f, 0.f, 0.f, 0.f};
#pragma unroll
            for (int dt = 0; dt < 4; ++dt) oacc[dt] = (f32x4){0.f, 0.f, 0.f, 0.f};
            NA_PAIR(0); NA_PAIR(1); NA_PAIR(2);
            NA_BAR4();
            if (t + 1 < 16) { const int hi0 = NA_CLAMP(2 * t + 1 - 4) + 7, hi1 = NA_CLAMP(2 * t + 3 - 4) + 7;
                for (int kr = hi0 + 1; kr <= hi1; ++kr) NA_DMA(kr);
#pragma unroll
                for (int s2 = 0; s2 < 2; ++s2) qn[s2] = *(const GAS bf16x8*)(Qb + (size_t)((rq + 2) * 64 + qc) * EVEN_IN + 32 * s2 + 8 * g); }
            NA_PAIR(3); NA_PAIR(4); NA_PAIR(5); NA_PAIR(6); NA_PAIR(7); NA_PAIR(8); NA_PAIR(9); NA_PAIR(10); NA_PAIR(11);
            float lsum = (lsum4[0] + lsum4[1]) + (lsum4[2] + lsum4[3]); lsum += __shfl_xor(lsum, 16); lsum += __shfl_xor(lsum, 32);
            const float rl = __builtin_amdgcn_rcpf(lsum);
            if (attn_body::O_FP8) { unsigned char* orow8 = (unsigned char*)Ob + (size_t)(rq * 64 + qc) * DM + 4 * g; const float r16 = rl * 16.f;
#pragma unroll
                for (int dt = 0; dt < 4; ++dt) *(GAS unsigned*)(orow8 + 16 * dt) = pk4_fp8(oacc[dt][0] * r16, oacc[dt][1] * r16, oacc[dt][2] * r16, oacc[dt][3] * r16); }
            else { bf16* orow = Ob + (size_t)(rq * 64 + qc) * DM + 4 * g;
#pragma unroll
                for (int dt = 0; dt < 4; ++dt) { v2u ov; ov.x = pk2(oacc[dt][0] * rl, oacc[dt][1] * rl); ov.y = pk2(oacc[dt][2] * rl, oacc[dt][3] * rl); *(GAS v2u*)(orow + 16 * dt) = ov; } }
        }
    }
    NA_BAR();
#undef NA_PAIR
#undef NA_CLAMP
#undef NA_BAR
#undef NA_BAR4
#undef NA_DMA
}

struct Args { const float* in[20]; float* out; unsigned char* ws; };
__global__ void __launch_bounds__(NWAVES * 64, 2) mega_fwd(Args args) {
    extern __shared__ __attribute__((aligned(16))) unsigned char lds[];
    asm volatile("s_setreg_imm32_b32 hwreg(HW_REG_MODE, 23, 1), 1");
    bool sat_bad; { float big = 1000.f, nbig = -3.0e9f; asm volatile("" : "+v"(big), "+v"(nbig)); const int tw = __builtin_amdgcn_cvt_pk_fp8_f32(big, nbig, 0, false); sat_bad = (tw & 0xffff) != 0xfe7e; }
    Frame F;
    F.lds = (LAS unsigned char*)lds;
    volatile LAS unsigned* MISC = (volatile LAS unsigned*)(F.lds + MISC_OFF);
    F.tid = threadIdx.x; F.lane = F.tid & 63; F.wave = __builtin_amdgcn_readfirstlane(F.tid >> 6);
    F.G = gridDim.x; { const int bx = blockIdx.x; F.vcu = (F.G % 8 == 0) ? (bx % 8) * (F.G / 8) + bx / 8 : bx; }
    unsigned char* ws = args.ws;
    gu32* ctl = (gu32*)(ws + WS_CTL);
    for (int u = F.tid; u < (LDS_BYTES - LDSCTL_OFF) / 4; u += NWAVES * 64) ((LAS unsigned*)(F.lds + LDSCTL_OFF))[u] = 0u;
    __syncthreads();
    XcdBarrier bar = xcd_barrier_post((unsigned*)(ctl + CW_BAR), MISC + 8);
#define GRID_BAR() xcd_barrier(bar)
    const float* x_in = args.in[0]; float* xres = args.out; bf16* XB = (bf16*)(ws + WS_XB);
    bf16* Hb = (bf16*)(ws + WS_H); bf16* QKV = (bf16*)(ws + WS_QKV); unsigned char* HID = ws + WS_QKV; unsigned char* Yb = ws + WS_Y; unsigned char* H8 = ws + WS_H8;
    float* tab = (float*)(ws + WS_TAB); float* aff = (float*)(ws + WS_AFF); int* selrow = (int*)(ws + WS_SELROW); float* gate = (float*)(ws + WS_GATE); int* inv = (int*)(ws + WS_INV);

    prep_small_weights(F, args.in[2], args.in[9], args.in[11], args.in[14], ws);
    prep_tables(F, tab);
    norm_rows(F, x_in, args.in[1], H8);
#if PROBE & 2
    norm_rows(F, x_in, args.in[1], H8);
#endif
    GRID_BAR();

    { constexpr int L = 0;
        const int NQ = L == 0 ? EVEN_IN : ODD_IN;
        { pg8::Gemm g{(const bf16*)H8, (const bf16*)(ws + (L == 0 ? WS_WIN0 : WS_WIN1)), DM / 2, nullptr}; pg8::StaticOrder S; S.init(NTOK, NQ, F.G, (int)blockIdx.x);
          if (L == 0) { pg8::EpiQKV<0> E{QKV, NQ, tab, args.in[3], args.in[4], args.in[6], args.in[7], QSCALE};
            pg8::gemm_phase<pg8::EpiQKV<0>, pg8::StaticOrder, true, false, true>(F.lds + RING_OFF, g, S, E); }
          else { pg8::EpiQKV<1> E{QKV, NQ, tab, args.in[12], args.in[13], args.in[12], args.in[13], QSCALE};
            pg8::gemm_phase<pg8::EpiQKV<1>, pg8::StaticOrder, true, false, true>(F.lds + RING_OFF, g, S, E); } }

        GRID_BAR();
#define O_AT(off) (attn_body::O_FP8 ? (attn_body::bf16*)((unsigned char*)Hb + (off)) : (attn_body::bf16*)Hb + (off))
        if (L == 0) {
            const attn_body::lds_fptr btab = (attn_body::lds_fptr)(F.lds + BIAS_OFF) + BIAS_PAD;
            na_phase(F, QKV, Hb, args.in[5]);
            attn_body::i32x8a qnx_ = {0, 0, 0, 0, 0, 0, 0, 0};
            for (int n = F.vcu, ui_ = 0; n < BATCH * 8 * 8; n += F.G, ++ui_) {
                if (ui_ == 2 * (F.vcu & 3)) prep_moe_layer(F, 0, args.in[17], args.in[18], args.in[19], ws);
                const int grp = n >> 5, j = n & 31, b = grp >> 1, kvh = grp & 1, hp = j >> 4, qb = j & 15, hq = kvh * 4 + 2 * hp;
                const int t0 = 2 * qb - 2 < 0 ? 0 : 2 * qb - 2, t1 = 2 * qb + 3 > 31 ? 31 : 2 * qb + 3;
                const attn_body::bf16* base = (const attn_body::bf16*)QKV + (size_t)b * SEQ * EVEN_IN;
                const float* sk_ = args.in[8] + hq; const float sinkl2 = ((F.wave >> 2) ? sk_[1] : sk_[0]) * LOG2E;
                const int n2 = n + F.G; const bool pre = n2 < BATCH * 8 * 8;
                const int grp2 = n2 >> 5, j2 = n2 & 31, b2 = grp2 >> 1, kvh2 = grp2 & 1, hp2 = j2 >> 4, qb2 = j2 & 15, hq2 = kvh2 * 4 + 2 * hp2, t02 = 2 * qb2 - 2 < 0 ? 0 : 2 * qb2 - 2;
                const char* base2 = (const char*)((const attn_body::bf16*)QKV + (size_t)(pre ? b2 : b) * SEQ * EVEN_IN);
                attn_body::attn_unit<1, EVEN_IN, 8>(attn_body::QK_FP8 ? (const attn_body::bf16*)((const char*)base + 3072 + 64 * hq) : base + 1536 + 64 * hq, attn_body::QK_FP8 ? (const attn_body::bf16*)((const char*)base + 4096 + 64 * kvh) : base + 2048 + 64 * kvh,
                                                    attn_body::QK_FP8 ? (const attn_body::bf16*)((const char*)base + 4352 + 64 * kvh) : base + 2176 + 64 * kvh, O_AT((size_t)b * SEQ * DM + 512 + 64 * hq), 128 * qb, t0, t1 - t0 + 1,
                                                    sinkl2, btab, (char*)lds + RING_OFF, ui_ > 0, pre, (const attn_body::bf16*)(base2 + 3072 + 64 * hq2), (const attn_body::bf16*)(base2 + 4096 + 64 * kvh2), 128 * qb2, t02, &qnx_);
            }
        } else {
            const attn_body::lds_fptr btab = (attn_body::lds_fptr)(F.lds + BIAS_OFF) + BIAS_PAD;
            attn_body::i32x8a qnx_ = {0, 0, 0, 0, 0, 0, 0, 0};
            for (int n = F.vcu, ui_ = 0; n < BATCH * 16 * 8; n += F.G, ++ui_) {
                if (ui_ == 4 * (F.vcu & 3)) prep_moe_layer(F, 1, args.in[17], args.in[18], args.in[19], ws);
                const int grp = n >> 5, j = n & 31, b = grp >> 2, kvh = grp & 3, hq = kvh * 4 + (j >> 3), qb = j & 7;
                const attn_body::bf16* base = (const attn_body::bf16*)QKV + (size_t)b * SEQ * ODD_IN;
                const int n2 = n + F.G; const bool pre = n2 < BATCH * 16 * 8;
                const int grp2 = n2 >> 5, j2 = n2 & 31, b2 = grp2 >> 2, kvh2 = grp2 & 3, hq2 = kvh2 * 4 + (j2 >> 3), qb2 = j2 & 7;
                const char* base2 = (const char*)((const attn_body::bf16*)QKV + (size_t)(pre ? b2 : b) * SEQ * ODD_IN);
                attn_body::attn_unit<2, ODD_IN, 8>(attn_body::QK_FP8 ? (const attn_body::bf16*)((const char*)base + 64 * hq) : base + 64 * hq, attn_body::QK_FP8 ? (const attn_body::bf16*)((const char*)base + 2048 + 64 * kvh) : base + 1024 + 64 * kvh, attn_body::QK_FP8 ? (const attn_body::bf16*)((const char*)base + 2560 + 64 * kvh) : base + 1280 + 64 * kvh, O_AT((size_t)b * SEQ * DM + 64 * hq), 256 * qb, 0, 32, 0.f, btab, (char*)lds + RING_OFF,
                                                   ui_ > 0, pre, (const attn_body::bf16*)(base2 + 64 * hq2), (const attn_body::bf16*)(base2 + 2048 + 64 * kvh2), 256 * qb2, 0, &qnx_);
            }
        }

        GRID_BAR();
        { pg8::Gemm g{Hb, (const bf16*)(ws + (L == 0 ? WS_WOUT0 : WS_WOUT1)), DM / 2, nullptr, 0x7b7b7b7b}; pg8::StaticOrder S; S.init(NTOK, DM, F.G, (int)blockIdx.x);
          if (L == 0) { pg8::EpiRes<false> E{(const void*)x_in, XB, DM}; pg8::gemm_phase<pg8::EpiRes<false>, pg8::StaticOrder, true, false, true>(F.lds + RING_OFF, g, S, E); }
          else { pg8::EpiRes<true> E{(const void*)XB, XB, DM}; pg8::gemm_phase<pg8::EpiRes<true>, pg8::StaticOrder, true, false, true>(F.lds + RING_OFF, g, S, E); } }

        GRID_BAR();
        norm_router_phase(F, XB, args.in[15] + L * DM, args.in[16] + (size_t)L * DM * NE, H8, aff);
        GRID_BAR();
        select_phase(F, aff, selrow, gate, inv);


        GRID_BAR();
        { pg8::Gemm g{(const bf16*)H8, (const bf16*)(ws + WS_WGU + (size_t)L * NE * 4096 * DM), DM / 2, selrow}; pg8::StaticOrder S; S.init(NE * BATCH * CAP, 2 * DFF, F.G, (int)blockIdx.x, BATCH, BATCH, 0);
          pg8::EpiGU8 E{HID, DFF};
          pg8::gemm_phase<pg8::EpiGU8, pg8::StaticOrder, true, true, true>(F.lds + RING_OFF, g, S, E); }
        GRID_BAR();
        { pg8::Gemm g{(const bf16*)HID, (const bf16*)(ws + WS_WD + (size_t)L * NE * DM * DFF), DFF / 2, nullptr}; pg8::StaticOrder S; S.init(NE * BATCH * CAP, DM, F.G, (int)blockIdx.x, BATCH, BATCH, 0);
          pg8::EpiY E{Yb, DM, gate};
          pg8::gemm_phase<pg8::EpiY, pg8::StaticOrder, true, false, true>(F.lds + RING_OFF, g, S, E); }
        GRID_BAR();
        combine_phase(F, XB, xres, Yb, inv, args.in[10], H8, L == 0);
        if (L == 0) GRID_BAR();
    }
    if (sat_bad) { GRID_BAR(); if (blockIdx.x == 0 && threadIdx.x == 0) xres[0] = __builtin_nanf("");     }
    { constexpr int L = 1;
        const int NQ = L == 0 ? EVEN_IN : ODD_IN;
        { pg8::Gemm g{(const bf16*)H8, (const bf16*)(ws + (L == 0 ? WS_WIN0 : WS_WIN1)), DM / 2, nullptr}; pg8::StaticOrder S; S.init(NTOK, NQ, F.G, (int)blockIdx.x);
          if (L == 0) { pg8::EpiQKV<0> E{QKV, NQ, tab, args.in[3], args.in[4], args.in[6], args.in[7], QSCALE};
            pg8::gemm_phase<pg8::EpiQKV<0>, pg8::StaticOrder, true, false, true>(F.lds + RING_OFF, g, S, E); }
          else { pg8::EpiQKV<1> E{QKV, NQ, tab, args.in[12], args.in[13], args.in[12], args.in[13], QSCALE};
            pg8::gemm_phase<pg8::EpiQKV<1>, pg8::StaticOrder, true, false, true>(F.lds + RING_OFF, g, S, E); } }

        GRID_BAR();
#define O_AT(off) (attn_body::O_FP8 ? (attn_body::bf16*)((unsigned char*)Hb + (off)) : (attn_body::bf16*)Hb + (off))
        if (L == 0) {
            const attn_body::lds_fptr btab = (attn_body::lds_fptr)(F.lds + BIAS_OFF) + BIAS_PAD;
            na_phase(F, QKV, Hb, args.in[5]);
            attn_body::i32x8a qnx_ = {0, 0, 0, 0, 0, 0, 0, 0};
            for (int n = F.vcu, ui_ = 0; n < BATCH * 8 * 8; n += F.G, ++ui_) {
                if (ui_ == 2 * (F.vcu & 3)) prep_moe_layer(F, 0, args.in[17], args.in[18], args.in[19], ws);
                const int grp = n >> 5, j = n & 31, b = grp >> 1, kvh = grp & 1, hp = j >> 4, qb = j & 15, hq = kvh * 4 + 2 * hp;
                const int t0 = 2 * qb - 2 < 0 ? 0 : 2 * qb - 2, t1 = 2 * qb + 3 > 31 ? 31 : 2 * qb + 3;
                const attn_body::bf16* base = (const attn_body::bf16*)QKV + (size_t)b * SEQ * EVEN_IN;
                const float* sk_ = args.in[8] + hq; const float sinkl2 = ((F.wave >> 2) ? sk_[1] : sk_[0]) * LOG2E;
                const int n2 = n + F.G; const bool pre = n2 < BATCH * 8 * 8;
                const int grp2 = n2 >> 5, j2 = n2 & 31, b2 = grp2 >> 1, kvh2 = grp2 & 1, hp2 = j2 >> 4, qb2 = j2 & 15, hq2 = kvh2 * 4 + 2 * hp2, t02 = 2 * qb2 - 2 < 0 ? 0 : 2 * qb2 - 2;
                const char* base2 = (const char*)((const attn_body::bf16*)QKV + (size_t)(pre ? b2 : b) * SEQ * EVEN_IN);
                attn_body::attn_unit<1, EVEN_IN, 8>(attn_body::QK_FP8 ? (const attn_body::bf16*)((const char*)base + 3072 + 64 * hq) : base + 1536 + 64 * hq, attn_body::QK_FP8 ? (const attn_body::bf16*)((const char*)base + 4096 + 64 * kvh) : base + 2048 + 64 * kvh,
                                                    attn_body::QK_FP8 ? (const attn_body::bf16*)((const char*)base + 4352 + 64 * kvh) : base + 2176 + 64 * kvh, O_AT((size_t)b * SEQ * DM + 512 + 64 * hq), 128 * qb, t0, t1 - t0 + 1,
                                                    sinkl2, btab, (char*)lds + RING_OFF, ui_ > 0, pre, (const attn_body::bf16*)(base2 + 3072 + 64 * hq2), (const attn_body::bf16*)(base2 + 4096 + 64 * kvh2), 128 * qb2, t02, &qnx_);
            }
        } else {
            const attn_body::lds_fptr btab = (attn_body::lds_fptr)(F.lds + BIAS_OFF) + BIAS_PAD;
            attn_body::i32x8a qnx_ = {0, 0, 0, 0, 0, 0, 0, 0};
            for (int n = F.vcu, ui_ = 0; n < BATCH * 16 * 8; n += F.G, ++ui_) {
                if (ui_ == 4 * (F.vcu & 3)) prep_moe_layer(F, 1, args.in[17], args.in[18], args.in[19], ws);
                const int grp = n >> 5, j = n & 31, b = grp >> 2, kvh = grp & 3, hq = kvh * 4 + (j >> 3), qb = j & 7;
                const attn_body::bf16* base = (const attn_body::bf16*)QKV + (size_t)b * SEQ * ODD_IN;
                const int n2 = n + F.G; const bool pre = n2 < BATCH * 16 * 8;
                const int grp2 = n2 >> 5, j2 = n2 & 31, b2 = grp2 >> 2, kvh2 = grp2 & 3, hq2 = kvh2 * 4 + (j2 >> 3), qb2 = j2 & 7;
                const char* base2 = (const char*)((const attn_body::bf16*)QKV + (size_t)(pre ? b2 : b) * SEQ * ODD_IN);
                attn_body::attn_unit<2, ODD_IN, 8>(attn_body::QK_FP8 ? (const attn_body::bf16*)((const char*)base + 64 * hq) : base + 64 * hq, attn_body::QK_FP8 ? (const attn_body::bf16*)((const char*)base + 2048 + 64 * kvh) : base + 1024 + 64 * kvh, attn_body::QK_FP8 ? (const attn_body::bf16*)((const char*)base + 2560 + 64 * kvh) : base + 1280 + 64 * kvh, O_AT((size_t)b * SEQ * DM + 64 * hq), 256 * qb, 0, 32, 0.f, btab, (char*)lds + RING_OFF,
                                                   ui_ > 0, pre, (const attn_body::bf16*)(base2 + 64 * hq2), (const attn_body::bf16*)(base2 + 2048 + 64 * kvh2), 256 * qb2, 0, &qnx_);
            }
        }

        GRID_BAR();
        { pg8::Gemm g{Hb, (const bf16*)(ws + (L == 0 ? WS_WOUT0 : WS_WOUT1)), DM / 2, nullptr, 0x7b7b7b7b}; pg8::StaticOrder S; S.init(NTOK, DM, F.G, (int)blockIdx.x);
          if (L == 0) { pg8::EpiRes<false> E{(const void*)x_in, XB, DM}; pg8::gemm_phase<pg8::EpiRes<false>, pg8::StaticOrder, true, false, true>(F.lds + RING_OFF, g, S, E); }
          else { pg8::EpiRes<true> E{(const void*)XB, XB, DM}; pg8::gemm_phase<pg8::EpiRes<true>, pg8::StaticOrder, true, false, true>(F.lds + RING_OFF, g, S, E); } }

        GRID_BAR();
        norm_router_phase(F, XB, args.in[15] + L * DM, args.in[16] + (size_t)L * DM * NE, H8, aff);
        GRID_BAR();
        select_phase(F, aff, selrow, gate, inv);


        GRID_BAR();
        { pg8::Gemm g{(const bf16*)H8, (const bf16*)(ws + WS_WGU + (size_t)L * NE * 4096 * DM), DM / 2, selrow}; pg8::StaticOrder S; S.init(NE * BATCH * CAP, 2 * DFF, F.G, (int)blockIdx.x, BATCH, BATCH, 0);
          pg8::EpiGU8 E{HID, DFF};
          pg8::gemm_phase<pg8::EpiGU8, pg8::StaticOrder, true, true, true>(F.lds + RING_OFF, g, S, E); }
        GRID_BAR();
        { pg8::Gemm g{(const bf16*)HID, (const bf16*)(ws + WS_WD + (size_t)L * NE * DM * DFF), DFF / 2, nullptr}; pg8::StaticOrder S; S.init(NE * BATCH * CAP, DM, F.G, (int)blockIdx.x, BATCH, BATCH, 0);
          pg8::EpiY E{Yb, DM, gate};
          pg8::gemm_phase<pg8::EpiY, pg8::StaticOrder, true, false, true>(F.lds + RING_OFF, g, S, E); }
        GRID_BAR();
        combine_phase(F, XB, xres, Yb, inv, args.in[10], H8, L == 0);
        if (L == 0) GRID_BAR();
    }
    if (sat_bad) { GRID_BAR(); if (blockIdx.x == 0 && threadIdx.x == 0) xres[0] = __builtin_nanf("");     }
#undef GRID_BAR
}

extern "C" void kernel_launch(void* const* d_in, const int* in_sizes, int n_in, void* d_out, int out_size, void* d_ws, size_t ws_size, hipStream_t stream) {
    static int grid = 0;
    if (grid == 0) {
        if (n_in != 20 || in_sizes[0] != NTOK * DM || out_size != NTOK * DM || ws_size < WS_END) { fprintf(stderr, "kernel_launch: unexpected shapes (n_in %d, in0 %d, out %d, ws %zu); nothing launched\n", n_in, n_in > 0 ? in_sizes[0] : -1, out_size, ws_size); grid = -1; return; }
        int dev = 0, cus = 0, per_cu = 0;
        if (hipGetDevice(&dev) != hipSuccess || hipDeviceGetAttribute(&cus, hipDeviceAttributeMultiprocessorCount, dev) != hipSuccess) { fprintf(stderr, "kernel_launch: device query failed\n"); grid = -1; return; }
        if (hipFuncSetAttribute((const void*)mega_fwd, hipFuncAttributeMaxDynamicSharedMemorySize, LDS_BYTES) != hipSuccess) { fprintf(stderr, "kernel_launch: hipFuncSetAttribute failed\n"); grid = -1; return; }
        if (hipOccupancyMaxActiveBlocksPerMultiprocessor(&per_cu, (const void*)mega_fwd, NWAVES * 64, LDS_BYTES) != hipSuccess || per_cu < 1)
            fprintf(stderr, "kernel_launch: note: occupancy query reports %d workgroups per CU\n", per_cu);
        (void)hipGetLastError();
        grid = cus;
    }
    if (grid < 0) return;
    if (hipMemsetAsync((char*)d_ws + WS_CTL, 0, CTL_ZERO_BYTES, stream) != hipSuccess) { fprintf(stderr, "kernel_launch: memset failed\n"); return; }
    Args a{};
    for (int i = 0; i < 20; ++i) a.in[i] = (const float*)d_in[i];
    a.out = (float*)d_out; a.ws = (unsigned char*)d_ws;
    hipLaunchKernelGGL(mega_fwd, dim3(grid), dim3(NWAVES * 64), LDS_BYTES, stream, a);
    const hipError_t le = hipPeekAtLastError();
    if (le != hipSuccess) fprintf(stderr, "kernel_launch: launch failed: %s\n", hipGetErrorName(le));
}
```
